# Optimizing an MI355X kernel written in HIP

```python
import math
import jax, jax.numpy as jnp
from jax import lax
import numpy as np

D_MODEL = 1024
BATCH = 4
SEQ = 8192
DEPTH = 2

GRID_W = 64
CTX_LEN = 256
CHUNK = 128
Q_BLOCK = 128
EPS = 1e-6
ROPE_BASE = 10000.0
ML_HEADS = 4
ML_DQK = D_MODEL // (2 * ML_HEADS)
ML_DV = D_MODEL // (2 * ML_HEADS)
RET_HEADS = 4
RET_DQK = D_MODEL // (2 * RET_HEADS)
RET_DV = D_MODEL // (2 * RET_HEADS)
DA_HEADS = 8
DA_DHEAD = D_MODEL // (2 * DA_HEADS)
DA_DV = 2 * DA_DHEAD
N_GROUPS = 4
EXPERTS_PER_GROUP = 8
N_EXPERTS = N_GROUPS * EXPERTS_PER_GROUP
TOP_K = 2
D_EXPERT = D_MODEL // 2
MOE_BLOCK = 256
N_EVEN = (DEPTH + 1) // 2
N_ODD = DEPTH // 2
EVEN_SPLITS = (ML_HEADS * ML_DQK, ML_HEADS * ML_DQK, ML_HEADS * ML_DV, ML_HEADS * ML_DV,
               2 * ML_HEADS, 2 * ML_HEADS,
               RET_HEADS * RET_DQK, RET_HEADS * RET_DQK, RET_HEADS * RET_DV, RET_HEADS * RET_DV)
EVEN_IN = sum(EVEN_SPLITS)
EVEN_SPLIT_IDX = tuple(int(s) for s in np.cumsum(EVEN_SPLITS)[:-1])
EVEN_MIX_W = ML_HEADS * ML_DV + RET_HEADS * RET_DV
ODD_IN = 4 * DA_HEADS * DA_DHEAD + DA_HEADS * DA_DV
ODD_MIX_W = DA_HEADS * DA_DV

kernel_name = 'hybrid_mlstm_retention_diffattn_hmoe_dit'

F32 = jnp.float32


def rms_norm(x, g):
    xf = x.astype(F32)
    y = xf * lax.rsqrt(jnp.mean(xf * xf, -1, keepdims=True) + EPS)
    return (y * g.astype(F32)).astype(x.dtype)


def adaln(h, g, shift, scale):
    return rms_norm(h, g) * (1 + scale) + shift


def head_layer_norm(x, g):
    xf = x.astype(F32)
    mu = jnp.mean(xf, -1, keepdims=True)
    var = jnp.mean(jnp.square(xf - mu), -1, keepdims=True)
    return ((xf - mu) * lax.rsqrt(var + EPS) * g[:, None, :].astype(F32)).astype(x.dtype)


def head_rms_norm(x, g):
    xf = x.astype(F32)
    y = xf * lax.rsqrt(jnp.mean(xf * xf, -1, keepdims=True) + EPS)
    return (y * g[:, None, :].astype(F32)).astype(x.dtype)


def modulation(cond, w, b):
    m = jax.nn.silu(cond) @ w + b
    return m.reshape(*cond.shape[:-1], 6, D_MODEL)


def rope_angles(pos, n_freq):
    inv = ROPE_BASE ** (-jnp.arange(n_freq, dtype=F32) / n_freq)
    return pos.astype(F32)[:, None] * inv[None, :]


def apply_rotary(x, ang):
    x1, x2 = jnp.split(x.astype(F32), 2, axis=-1)
    cos, sin = jnp.cos(ang), jnp.sin(ang)
    return jnp.concatenate([x1 * cos - x2 * sin, x1 * sin + x2 * cos], -1).astype(x.dtype)


def rope_2d(x, rows, cols):
    half = x.shape[-1] // 2
    nf = half // 2
    return jnp.concatenate([apply_rotary(x[..., :half], rope_angles(rows, nf)),
                            apply_rotary(x[..., half:], rope_angles(cols, nf))], -1)


def to_chunks(a):
    B, H, T = a.shape[:3]
    return jnp.moveaxis(a.reshape(B, H, T // CHUNK, CHUNK, *a.shape[3:]), 2, 0)


def from_chunks(a):
    a = jnp.moveaxis(a, 0, 2)
    return a.reshape(a.shape[0], a.shape[1], -1, a.shape[-1])


def mlstm_scan(q, k, v, ig, lf, state):
    xs = tuple(to_chunks(a.astype(F32)) for a in (q, k, v, ig, lf))
    causal = jnp.tril(jnp.ones((CHUNK, CHUNK), bool))

    def step(carry, inp):
        C, n, m = carry
        qc, kc, vc, ic, fc = inp
        b = jnp.cumsum(fc, -1)
        dlog = jnp.where(causal, b[..., :, None] - b[..., None, :] + ic[..., None, :], -jnp.inf)
        inter = b + m[..., None]
        m_t = jnp.maximum(inter, jnp.max(dlog, -1))
        s = jnp.einsum('bhtk,bhsk->bhts', qc, kc) * jnp.exp(dlog - m_t[..., None])
        w_inter = jnp.exp(inter - m_t)
        numer = jnp.einsum('bhts,bhsv->bhtv', s, vc) + w_inter[..., None] * jnp.einsum('bhtk,bhvk->bhtv', qc, C)
        denom = jnp.sum(s, -1) + w_inter * jnp.einsum('bhtk,bhk->bht', qc, n)
        h = numer / jnp.maximum(jnp.abs(denom), jnp.exp(-m_t))[..., None]
        b_last = b[..., -1]
        w_log = b_last[..., None] - b + ic
        m_new = jnp.maximum(b_last + m, jnp.max(w_log, -1))
        decay = jnp.exp(b_last + m - m_new)
        w = jnp.exp(w_log - m_new[..., None])
        C = decay[..., None, None] * C + jnp.einsum('bhsv,bhsk->bhvk', vc * w[..., None], kc)
        n = decay[..., None] * n + jnp.einsum('bhs,bhsk->bhk', w, kc)
        return (C, n, m_new), h

    state, h = lax.scan(step, state, xs)
    return from_chunks(h).astype(q.dtype), state


def retention_scan(q, k, v, log_gamma, R):
    xs = tuple(to_chunks(a.astype(F32)) for a in (q, k, v))
    lg = log_gamma.astype(F32)
    idx = jnp.arange(CHUNK, dtype=F32)
    causal = jnp.tril(jnp.ones((CHUNK, CHUNK), bool))
    dist = jnp.maximum(idx[:, None] - idx[None, :], 0.0)
    intra = jnp.where(causal, jnp.exp(lg[:, None, None] * dist), 0.0)
    q_decay = jnp.exp(lg[:, None] * (idx + 1.0))
    k_decay = jnp.exp(lg[:, None] * (CHUNK - 1.0 - idx))
    chunk_decay = jnp.exp(lg * CHUNK)

    def step(R, inp):
        qc, kc, vc = inp
        s = jnp.einsum('bhtk,bhsk->bhts', qc, kc) * intra
        o = jnp.einsum('bhts,bhsv->bhtv', s, vc) + q_decay[..., None] * jnp.einsum('bhtk,bhkv->bhtv', qc, R)
        R = chunk_decay[:, None, None] * R + jnp.einsum('bhsk,bhsv->bhkv', kc * k_decay[..., None], vc)
        return R, o

    R, o = lax.scan(step, R, xs)
    return from_chunks(o).astype(q.dtype), R


def mlstm_retention_mixer(u_ctx, u_lat, w_in, gate_b, ml_g, ret_ld, ret_g, w_out):
    B, L, _ = u_ctx.shape
    S = u_lat.shape[1]

    def project(u, pos):
        T = u.shape[1]
        mq, mk, mv, mo, mi, mf, rq, rk, rv, rg = jnp.split(u @ w_in, EVEN_SPLIT_IDX, axis=-1)
        heads = lambda a, H: a.reshape(B, T, H, -1).transpose(0, 2, 1, 3)
        ang = rope_angles(pos, RET_DQK // 2)
        ig = (mi.reshape(B, T, 2, ML_HEADS) + gate_b[:, 0]).astype(F32).transpose(2, 0, 3, 1)
        lf = jax.nn.log_sigmoid((mf.reshape(B, T, 2, ML_HEADS) + gate_b[:, 1]).astype(F32)).transpose(2, 0, 3, 1)
        return dict(mq=heads(mq, ML_HEADS), mk=heads(mk, ML_HEADS) * (ML_DQK ** -0.5), mv=heads(mv, ML_HEADS),
                    mo=jax.nn.sigmoid(heads(mo, ML_HEADS)), mi=ig, mf=lf,
                    rq=apply_rotary(heads(rq, RET_HEADS), ang),
                    rk=apply_rotary(heads(rk, RET_HEADS), ang) * (RET_DQK ** -0.5),
                    rv=heads(rv, RET_HEADS), rg=rg)

    pc = project(u_ctx, jnp.arange(L))
    pl = project(u_lat, L + jnp.arange(S))
    ml_c = ml_l = ret_c = ret_l = 0.0
    for d in range(2):
        fl = (lambda a: a) if d == 0 else (lambda a: jnp.flip(a, 2))
        st0 = (jnp.zeros((B, ML_HEADS, ML_DV, ML_DQK), F32), jnp.zeros((B, ML_HEADS, ML_DQK), F32),
               jnp.zeros((B, ML_HEADS), F32))
        hc, st = mlstm_scan(fl(pc['mq']), fl(pc['mk']), fl(pc['mv']), fl(pc['mi'][d]), fl(pc['mf'][d]), st0)
        hl, _ = mlstm_scan(fl(pl['mq']), fl(pl['mk']), fl(pl['mv']), fl(pl['mi'][d]), fl(pl['mf'][d]), st)
        ml_c = ml_c + fl(hc)
        ml_l = ml_l + fl(hl)
        R0 = jnp.zeros((B, RET_HEADS, RET_DQK, RET_DV), F32)
        oc, R = retention_scan(fl(pc['rq']), fl(pc['rk']), fl(pc['rv']), ret_ld[d], R0)
        ol, _ = retention_scan(fl(pl['rq']), fl(pl['rk']), fl(pl['rv']), ret_ld[d], R)
        ret_c = ret_c + fl(oc)
        ret_l = ret_l + fl(ol)

    def merge(p, ml, ret):
        T = ml.shape[2]
        ml = head_layer_norm(p['mo'] * ml, ml_g).transpose(0, 2, 1, 3).reshape(B, T, -1)
        ret = jax.nn.silu(p['rg']) * head_layer_norm(ret, ret_g).transpose(0, 2, 1, 3).reshape(B, T, -1)
        return jnp.concatenate([ml, ret], -1) @ w_out

    return merge(pc, ml_c, ret_c), merge(pl, ml_l, ret_l)


def diff_attend(q, k, v, lam):
    B, H, _, T, d = q.shape
    nb = T // Q_BLOCK
    qb = jnp.moveaxis(q.reshape(B, H, 2, nb, Q_BLOCK, d), 3, 0)
    scale = d ** -0.5

    def block(qi):
        s = jnp.einsum('bhmqd,bhmkd->bhmqk', qi, k).astype(F32) * scale
        p = jax.nn.softmax(s, -1)
        a = p[:, :, 0] - lam * p[:, :, 1]
        return jnp.einsum('bhqk,bhkv->bhqv', a.astype(v.dtype), v)

    o = lax.map(block, qb)
    return jnp.moveaxis(o, 0, 2).reshape(B, H, T, -1)


def diff_attention_mixer(u_ctx, u_lat, rows, cols, w_in, lam_p, norm_g, w_out, lam_init, with_ctx):
    B = u_ctx.shape[0]

    def project(u):
        T = u.shape[1]
        q, k, v = jnp.split(u @ w_in, [2 * DA_HEADS * DA_DHEAD, 4 * DA_HEADS * DA_DHEAD], axis=-1)
        q = q.reshape(B, T, DA_HEADS, 2, DA_DHEAD).transpose(0, 2, 3, 1, 4)
        k = k.reshape(B, T, DA_HEADS, 2, DA_DHEAD).transpose(0, 2, 3, 1, 4)
        v = v.reshape(B, T, DA_HEADS, DA_DV).transpose(0, 2, 1, 3)
        return q, k, v

    qc, kc, vc = project(u_ctx)
    ql, kl, vl = project(u_lat)
    ql = rope_2d(ql, rows, cols)
    kl = rope_2d(kl, rows, cols)
    lp = lam_p.astype(F32)
    lam = jnp.exp(jnp.sum(lp[0] * lp[1])) - jnp.exp(jnp.sum(lp[2] * lp[3])) + lam_init

    def finish(o):
        T = o.shape[2]
        o = head_rms_norm(o, norm_g) * (1.0 - lam_init)
        return o.transpose(0, 2, 1, 3).reshape(B, T, -1) @ w_out

    y_lat = finish(diff_attend(ql, jnp.concatenate([kl, kc], 3), jnp.concatenate([vl, vc], 2), lam))
    y_ctx = finish(diff_attend(qc, kc, vc, lam)) if with_ctx else None
    return y_ctx, y_lat


def routed_experts(x, e, g, w1, w3, w2):
    N, D = x.shape
    A = e.shape[0]
    nblk = -(-A // MOE_BLOCK) + N_EXPERTS
    P = nblk * MOE_BLOCK
    tok = jnp.repeat(jnp.arange(N, dtype=jnp.int32), TOP_K)
    order = jnp.argsort(e)
    e_s = e[order]
    counts = jnp.bincount(e, length=N_EXPERTS)
    padded = (counts + MOE_BLOCK - 1) // MOE_BLOCK * MOE_BLOCK
    start = jnp.cumsum(counts) - counts
    pend = jnp.cumsum(padded)
    dest = (pend - padded)[e_s] + jnp.arange(A) - start[e_s]
    buf_tok = jnp.full((P,), N, jnp.int32).at[dest].set(tok[order])
    buf_g = jnp.zeros((P,), x.dtype).at[dest].set(g[order].astype(x.dtype))
    blk_expert = jnp.clip(jnp.searchsorted(pend, jnp.arange(nblk) * MOE_BLOCK, side='right'), 0, N_EXPERTS - 1)
    xp = jnp.concatenate([x, jnp.zeros((1, D), x.dtype)], 0)
    xb = xp[buf_tok].reshape(nblk, MOE_BLOCK, D)

    def expert_block(args):
        xi, ei = args
        return (jax.nn.silu(xi @ w1[ei]) * (xi @ w3[ei])) @ w2[ei]

    yb = lax.map(expert_block, (xb, blk_expert)).reshape(P, D)
    out = jnp.zeros((N + 1, D), x.dtype).at[buf_tok].add(yb * buf_g[:, None])
    return out[:N]


def hmoe(x, wg, bg, we, be, w1, w3, w2):
    N = x.shape[0]
    pg = jax.nn.softmax((x @ wg).astype(F32) + bg.astype(F32), -1)
    pg_top, grp = lax.top_k(pg, 1)
    le = ((x @ we).astype(F32) + be.astype(F32)).reshape(N, N_GROUPS, EXPERTS_PER_GROUP)
    le = jnp.take_along_axis(le, grp[:, :, None], 1)[:, 0]
    pe_top, e_in = lax.top_k(jax.nn.softmax(le, -1), TOP_K)
    gate = pg_top * pe_top / jnp.sum(pe_top, -1, keepdims=True)
    expert = grp * EXPERTS_PER_GROUP + e_in
    return routed_experts(x, expert.reshape(-1).astype(jnp.int32), gate.reshape(-1), w1, w3, w2)


def setup_inputs(seed: int = 0) -> dict:
    key = jax.random.key(seed)
    ks = iter(jax.random.split(key, 32))
    nrm = lambda shape, s: jax.random.normal(next(ks), shape, F32) * s
    D = D_MODEL
    x = nrm((BATCH, SEQ, D), 1.0)
    c = nrm((BATCH, D), 1.0)
    ctx = nrm((BATCH, CTX_LEN, D), 1.0)
    c_ctx = nrm((D,), 1.0)
    w_mod = nrm((DEPTH, D, 6 * D), 0.5 * D ** -0.5)
    b_mod = nrm((DEPTH, 6 * D), 0.02)
    norm1_g = 1.0 + nrm((DEPTH, D), 0.05)
    norm2_g = 1.0 + nrm((DEPTH, D), 0.05)
    w_in_even = nrm((N_EVEN, D, EVEN_IN), D ** -0.5)
    gate_base = jnp.stack([jnp.zeros((ML_HEADS,), F32), jnp.linspace(3.0, 6.0, ML_HEADS)])
    ml_gate_b = gate_base[None, None] + nrm((N_EVEN, 2, 2, ML_HEADS), 0.1)
    ml_norm_g = 1.0 + nrm((N_EVEN, ML_HEADS, ML_DV), 0.05)
    base_ld = jnp.log1p(-(2.0 ** (-jnp.linspace(5.0, 12.0, RET_HEADS))))
    ret_log_decay = base_ld[None, None, :] * jnp.exp(nrm((N_EVEN, 2, RET_HEADS), 0.1))
    ret_norm_g = 1.0 + nrm((N_EVEN, RET_HEADS, RET_DV), 0.05)
    w_out_even = nrm((N_EVEN, EVEN_MIX_W, D), EVEN_MIX_W ** -0.5)
    w_in_odd = nrm((N_ODD, D, ODD_IN), D ** -0.5)
    da_lambda = nrm((N_ODD, 4, DA_DHEAD), 0.1)
    da_norm_g = 1.0 + nrm((N_ODD, DA_HEADS, DA_DV), 0.05)
    w_out_odd = nrm((N_ODD, ODD_MIX_W, D), ODD_MIX_W ** -0.5)
    router_g_w = nrm((DEPTH, D, N_GROUPS), D ** -0.5)
    router_g_b = nrm((DEPTH, N_GROUPS), 0.01)
    router_e_w = nrm((DEPTH, D, N_EXPERTS), D ** -0.5)
    router_e_b = nrm((DEPTH, N_EXPERTS), 0.01)
    w1 = nrm((DEPTH, N_EXPERTS, D, D_EXPERT), D ** -0.5)
    w3 = nrm((DEPTH, N_EXPERTS, D, D_EXPERT), D ** -0.5)
    w2 = nrm((DEPTH, N_EXPERTS, D_EXPERT, D), D_EXPERT ** -0.5)
    final_norm_g = 1.0 + nrm((D,), 0.05)
    return {'x': x, 'c': c, 'ctx': ctx, 'c_ctx': c_ctx, 'w_mod': w_mod, 'b_mod': b_mod,
            'norm1_g': norm1_g, 'norm2_g': norm2_g, 'w_in_even': w_in_even, 'ml_gate_b': ml_gate_b,
            'ml_norm_g': ml_norm_g, 'ret_log_decay': ret_log_decay, 'ret_norm_g': ret_norm_g,
            'w_out_even': w_out_even, 'w_in_odd': w_in_odd, 'da_lambda': da_lambda, 'da_norm_g': da_norm_g,
            'w_out_odd': w_out_odd, 'router_g_w': router_g_w, 'router_g_b': router_g_b,
            'router_e_w': router_e_w, 'router_e_b': router_e_b, 'w1': w1, 'w3': w3, 'w2': w2,
            'final_norm_g': final_norm_g}


def reference(x, c, ctx, c_ctx, w_mod, b_mod, norm1_g, norm2_g, w_in_even, ml_gate_b, ml_norm_g,
              ret_log_decay, ret_norm_g, w_out_even, w_in_odd, da_lambda, da_norm_g, w_out_odd,
              router_g_w, router_g_b, router_e_w, router_e_b, w1, w3, w2, final_norm_g):
    B, S, D = x.shape
    L = ctx.shape[1]
    t = jnp.arange(S)
    rows, cols = t // GRID_W, t % GRID_W
    h_lat, h_ctx = x, ctx
    for l in range(DEPTH):
        last = l == DEPTH - 1
        j = l // 2
        m_lat = modulation(c, w_mod[l], b_mod[l])[:, :, None, :]
        m_ctx = modulation(c_ctx, w_mod[l], b_mod[l])
        u_lat = adaln(h_lat, norm1_g[l], m_lat[:, 0], m_lat[:, 1])
        u_ctx = adaln(h_ctx, norm1_g[l], m_ctx[0], m_ctx[1])
        if l % 2 == 0:
            y_ctx, y_lat = mlstm_retention_mixer(u_ctx, u_lat, w_in_even[j], ml_gate_b[j], ml_norm_g[j],
                                                 ret_log_decay[j], ret_norm_g[j], w_out_even[j])
        else:
            lam_init = 0.8 - 0.6 * math.exp(-0.3 * l)
            y_ctx, y_lat = diff_attention_mixer(u_ctx, u_lat, rows, cols, w_in_odd[j], da_lambda[j],
                                                da_norm_g[j], w_out_odd[j], lam_init, not last)
        h_lat = h_lat + m_lat[:, 2] * y_lat
        v_lat = adaln(h_lat, norm2_g[l], m_lat[:, 3], m_lat[:, 4])
        moe_w = (router_g_w[l], router_g_b[l], router_e_w[l], router_e_b[l], w1[l], w3[l], w2[l])
        if last:
            h_lat = h_lat + m_lat[:, 5] * hmoe(v_lat.reshape(-1, D), *moe_w).reshape(B, S, D)
        else:
            h_ctx = h_ctx + m_ctx[2] * y_ctx
            v_ctx = adaln(h_ctx, norm2_g[l], m_ctx[3], m_ctx[4])
            y = hmoe(jnp.concatenate([v_ctx.reshape(-1, D), v_lat.reshape(-1, D)], 0), *moe_w)
            n_ctx = B * L
            h_ctx = h_ctx + m_ctx[5] * y[:n_ctx].reshape(B, L, D)
            h_lat = h_lat + m_lat[:, 5] * y[n_ctx:].reshape(B, S, D)
    return rms_norm(h_lat, final_norm_g)
```

```cpp
#include <hip/hip_runtime.h>
#include <cstdio>
#include <cstdint>

#define LAS __attribute__((address_space(3)))
typedef unsigned short u16;
using bf16x8 = __attribute__((ext_vector_type(8))) short;
using s16x4  = __attribute__((ext_vector_type(4))) short;
typedef short v4i16_t __attribute__((ext_vector_type(4)));
using f32x4  = __attribute__((ext_vector_type(4))) float;
using f32x16 = __attribute__((ext_vector_type(16))) float;
using u32x4  = __attribute__((ext_vector_type(4))) unsigned;
using u32x2  = __attribute__((ext_vector_type(2))) unsigned;
typedef __bf16 bf16x2_t __attribute__((ext_vector_type(2)));
typedef float f32x2_t __attribute__((ext_vector_type(2)));

#ifndef SPLIT_LAUNCH
#define SPLIT_LAUNCH 0
#endif

constexpr int D = 1024, NB = 4, SEQ = 8192, CTXL = 256;
constexpr int NCTX = NB * CTXL, NLAT = NB * SEQ, NROW = NCTX + NLAT;
constexpr int NCH = 66;
constexpr int NE = 32;
constexpr int NTHR = 512;
constexpr float EPS = 1e-6f;
constexpr float LOG2E = 1.4426950408889634f;
constexpr float LAM_INIT = 0.35550906f;

constexpr size_t al256(size_t x) { return (x + 255) / 256 * 256; }
constexpr size_t WS_CTL = 0, CTL_BYTES = 32768;
constexpr int CW_BAR = 0;
constexpr int CW_KMAX = 5120;
constexpr int CW_CNT = 4096;
constexpr size_t WS_MOD   = CTL_BYTES;
constexpr size_t WS_ROPE1 = WS_MOD + al256(2 * 5 * 6144 * 4);
constexpr size_t WS_ROPE2 = WS_ROPE1 + al256((size_t)8448 * 64 * 8);
constexpr size_t WS_GATEW = WS_ROPE2 + al256(128 * 16 * 8);
constexpr size_t WS_GATES = WS_GATEW + al256(16 * 1024 * 4);
constexpr size_t WS_HCTX  = WS_GATES + al256((size_t)NROW * 16 * 4);
constexpr size_t WS_STATS = WS_HCTX + al256((size_t)NCTX * D * 4);
constexpr size_t WS_MST   = WS_STATS + al256(32 * NCH * 2 * 4);
constexpr size_t WS_NV    = WS_MST + al256(32 * NCH * 4);
constexpr size_t WS_ASGE  = WS_NV + al256((size_t)32 * NCH * 128 * 4);
constexpr size_t WS_ASGR  = WS_ASGE + al256((size_t)NROW * 2 * 4);
constexpr size_t WS_ASGG  = WS_ASGR + al256((size_t)NROW * 2 * 4);
constexpr size_t WS_LIST  = WS_ASGG + al256((size_t)NROW * 2 * 4);
constexpr size_t WS_WINE  = WS_LIST + al256((size_t)NE * NROW * 4);
constexpr size_t WS_WOUTE = WS_WINE + (size_t)4096 * 1024 * 2;
constexpr size_t WS_WINO  = WS_WOUTE + (size_t)1024 * 1024 * 2;
constexpr size_t WS_WOUTO = WS_WINO + (size_t)3072 * 1024 * 2;
constexpr size_t WS_X1    = WS_WOUTO + (size_t)1024 * 1024 * 2;
constexpr size_t WS_PROJ  = WS_X1 + (size_t)NROW * 1024 * 2;
constexpr size_t PROJ_BYTES = (size_t)NROW * 4096 * 2;
constexpr int    HROWS = 2 * NROW + 256;
constexpr size_t WS_H     = WS_PROJ;
constexpr size_t WS_YB    = WS_H + (size_t)HROWS * 512 * 2;
static_assert(WS_YB + (size_t)HROWS * 1024 * 2 <= WS_PROJ + PROJ_BYTES, "moe buffers fit in proj");
constexpr size_t WS_STATES = WS_PROJ + PROJ_BYTES;
constexpr size_t STATES_BYTES = (size_t)64 * NCH * 16384 * 2;
constexpr size_t WS_W13   = WS_STATES;
constexpr size_t WS_W2    = WS_W13 + (size_t)NE * 1024 * 1024 * 2;
static_assert(WS_W2 + (size_t)NE * 1024 * 512 * 2 <= WS_STATES + STATES_BYTES, "moe weights fit in states");
constexpr size_t WS_END   = WS_STATES + STATES_BYTES;

constexpr int LDS_TOTAL = 163840;
constexpr int LDS_MISC  = LDS_TOTAL - 64;

struct Params { const float* in[26]; float* out; unsigned char* ws; };

__device__ __forceinline__ unsigned cvtpk(float lo, float hi) { f32x2_t v = {lo, hi}; bf16x2_t b = __builtin_convertvector(v, bf16x2_t); return __builtin_bit_cast(unsigned, b); }
__device__ __forceinline__ u16 f2bf(float x) { __bf16 b = (__bf16)x; return __builtin_bit_cast(u16, b); }
__device__ __forceinline__ float bf2f(u16 x) { return __uint_as_float(((unsigned)x) << 16); }
__device__ __forceinline__ float bflo(unsigned w) { return __uint_as_float(w << 16); }
__device__ __forceinline__ float bfhi(unsigned w) { return __uint_as_float(w & 0xffff0000u); }
template <int CTRL> __device__ __forceinline__ float dpp_f(float v) { return __builtin_bit_cast(float, __builtin_amdgcn_update_dpp(0, __builtin_bit_cast(int, v), CTRL, 0xf, 0xf, true)); }
__device__ __forceinline__ float row_sum16(float v) { v += dpp_f<0xB1>(v); v += dpp_f<0x4E>(v); v += dpp_f<0x141>(v); v += dpp_f<0x140>(v); return v; }
__device__ __forceinline__ float row_max16(float v) { v = fmaxf(v, dpp_f<0xB1>(v)); v = fmaxf(v, dpp_f<0x4E>(v)); v = fmaxf(v, dpp_f<0x141>(v)); v = fmaxf(v, dpp_f<0x140>(v)); return v; }
__device__ __forceinline__ float swap16_add(float v) { auto rr = __builtin_amdgcn_permlane16_swap(__float_as_uint(v), __float_as_uint(v), false, false); return __uint_as_float(rr[0]) + __uint_as_float(rr[1]); }
__device__ __forceinline__ float swap16_max(float v) { auto rr = __builtin_amdgcn_permlane16_swap(__float_as_uint(v), __float_as_uint(v), false, false); return fmaxf(__uint_as_float(rr[0]), __uint_as_float(rr[1])); }
__device__ __forceinline__ float swap32_add(float v) { auto rr = __builtin_amdgcn_permlane32_swap(__float_as_uint(v), __float_as_uint(v), false, false); return __uint_as_float(rr[0]) + __uint_as_float(rr[1]); }
__device__ __forceinline__ float swap32_max(float v) { auto rr = __builtin_amdgcn_permlane32_swap(__float_as_uint(v), __float_as_uint(v), false, false); return fmaxf(__uint_as_float(rr[0]), __uint_as_float(rr[1])); }
__device__ __forceinline__ float wave_sum(float v) { return swap32_add(swap16_add(row_sum16(v))); }
__device__ __forceinline__ float wave_max(float v) { return swap32_max(swap16_max(row_max16(v))); }
__device__ __forceinline__ float half_sum(float v) { return swap16_add(row_sum16(v)); }
__device__ __forceinline__ float sigmoidf_(float x) { return 1.f / (1.f + __expf(-x)); }
__device__ __forceinline__ float siluf_(float x) { return x / (1.f + __expf(-x)); }
__device__ __forceinline__ int crow(int r, int hi) { return (r & 3) + 8 * (r >> 2) + 4 * hi; }
__device__ __forceinline__ float swap_add(float v) { auto rr = __builtin_amdgcn_permlane32_swap(__float_as_uint(v), __float_as_uint(v), false, false); return __uint_as_float(rr[0]) + __uint_as_float(rr[1]); }
__device__ __forceinline__ float swap_max(float v) { auto rr = __builtin_amdgcn_permlane32_swap(__float_as_uint(v), __float_as_uint(v), false, false); return fmaxf(__uint_as_float(rr[0]), __uint_as_float(rr[1])); }
__device__ __forceinline__ void glds16(const void* g, LAS unsigned char* l) { __builtin_amdgcn_global_load_lds((const unsigned*)g, (LAS unsigned*)l, 16, 0, 0); }
#define WAIT_V(n) asm volatile("s_waitcnt vmcnt(" #n ")" ::: "memory")
#define WAIT_L(n) asm volatile("s_waitcnt lgkmcnt(" #n ")" ::: "memory")
#define BAR() __builtin_amdgcn_s_barrier()
#define SBAR() __builtin_amdgcn_sched_barrier(0)

__device__ __forceinline__ int row_modvec(int r) { return r < NCTX ? 4 : ((r - NCTX) >> 13); }
__device__ __forceinline__ int row_pos(int r) { return r < NCTX ? (r & 255) : 256 + ((r - NCTX) & 8191); }
__device__ __forceinline__ int chunk_row0(int b, int ch) { return ch < 2 ? b * 256 + ch * 128 : NCTX + b * SEQ + (ch - 2) * 128; }

#define XB_TMO      128
#define XB_XCNT(j)  (256  + 64 * (j))
#define XB_XSUB(j)  (1280 + 64 * (j))
#define XB_XGEN(j)  (2304 + 64 * (j))
#define XB_TOP      3328
#define XB_TOPGEN   3392
#define XCD_BAR_WORDS 3456
#define XB_SPIN_CAP (1u << 18)
__device__ __forceinline__ unsigned xb_ld(unsigned* p)              { return __hip_atomic_load(p, __ATOMIC_RELAXED, __HIP_MEMORY_SCOPE_AGENT); }
__device__ __forceinline__ unsigned xb_add(unsigned* p, unsigned v) { return __hip_atomic_fetch_add(p, v, __ATOMIC_RELAXED, __HIP_MEMORY_SCOPE_AGENT); }
__device__ __forceinline__ unsigned xb_xcc_id() { return (unsigned)__builtin_amdgcn_s_getreg((3 << 11) | 20) & 0xFu; }
#define XB_SPIN(cond, bar) do { unsigned _sp = 0; while (cond) { __builtin_amdgcn_s_sleep(1); \
    if ((++_sp & 255u) == 0u) { if (xb_ld(&(bar)[XB_TMO])) break; if (_sp > XB_SPIN_CAP) { atomicAdd(&(bar)[XB_TMO], 1u); break; } } } } while (0)
struct XcdBarrier { unsigned* bar; unsigned x; volatile LAS unsigned* st; };
__device__ __forceinline__ XcdBarrier xcd_barrier_post(unsigned* bar, volatile LAS unsigned* st) {
    XcdBarrier b; b.bar = bar; b.x = xb_xcc_id(); b.st = st;
    if (threadIdx.x == 0) (void)xb_add(&bar[XB_XCNT(b.x)], 1u);
    return b;
}
__device__ __forceinline__ void xcd_barrier_complete(unsigned* bar, unsigned x, unsigned& nloc, unsigned& nx) {
    const unsigned G = gridDim.x * gridDim.y * gridDim.z;
    unsigned sum, cnt, mine, sp = 0u;
    for (;;) {
        sum = 0u; cnt = 0u; mine = 0u;
#pragma unroll
        for (unsigned j = 0; j < 16; ++j) { const unsigned c = xb_ld(&bar[XB_XCNT(j)]); sum += c; cnt += (c > 0u) ? 1u : 0u; mine = (j == x) ? c : mine; }
        if (sum == G) break;
        __builtin_amdgcn_s_sleep(1);
        if ((++sp & 255u) == 0u) { if (xb_ld(&bar[XB_TMO])) break; if (sp > XB_SPIN_CAP) { atomicAdd(&bar[XB_TMO], 1u); break; } }
    }
    nloc = mine > 0u ? mine : 1u; nx = cnt > 0u ? cnt : 1u;
}
__device__ __forceinline__ void xcd_barrier(const XcdBarrier& b) {
    asm volatile("s_waitcnt vmcnt(0)" ::: "memory");
    __syncthreads();
    if (threadIdx.x == 0) {
        unsigned* bar = b.bar;
        __builtin_amdgcn_s_waitcnt(0);
        unsigned nloc = b.st[0], nx = b.st[1];
        if (nloc == 0u) { xcd_barrier_complete(bar, b.x, nloc, nx); b.st[0] = nloc; b.st[1] = nx; }
        const unsigned old = xb_add(&bar[XB_XSUB(b.x)], 1u);
        const unsigned gen = old / nloc;
        if (old + 1u == (gen + 1u) * nloc) {
            __builtin_amdgcn_fence(__ATOMIC_RELEASE, "agent");
            asm volatile("s_waitcnt vmcnt(0)" ::: "memory");
            const unsigned og = xb_add(&bar[XB_TOP], 1u);
            const unsigned tg = og / nx;
            if (og + 1u == (tg + 1u) * nx) xb_add(&bar[XB_TOPGEN], 1u);
            else XB_SPIN(xb_ld(&bar[XB_TOPGEN]) == tg, bar);
            __builtin_amdgcn_fence(__ATOMIC_ACQUIRE, "agent");
            xb_add(&bar[XB_XGEN(b.x)], 1u);
            asm volatile("s_waitcnt vmcnt(0)" ::: "memory");
        } else {
            XB_SPIN(xb_ld(&bar[XB_XGEN(b.x)]) == gen, bar);
            __builtin_amdgcn_fence(__ATOMIC_ACQUIRE, "agent");
            asm volatile("s_waitcnt vmcnt(0)" ::: "memory");
        }
    }
    __syncthreads();
}

struct ConvJob { const float* src; u16* dst; int ldn, ldk; float scale; };
__device__ __forceinline__ void conv_load(const ConvJob& j, f32x4 (&r)[4]) {
#pragma unroll
    for (int i = 0; i < 2; ++i) { const int idx = threadIdx.x + i * NTHR, kp = idx >> 4, n4 = idx & 15; const float* s = j.src + (size_t)(2 * kp) * j.ldn + n4 * 4;
        r[2 * i] = *(const f32x4*)s; r[2 * i + 1] = *(const f32x4*)(s + j.ldn); }
}
__device__ __forceinline__ void conv_store(const ConvJob& j, const f32x4 (&r)[4], LAS unsigned char* lds) {
    LAS unsigned* scr = (LAS unsigned*)lds;
#pragma unroll
    for (int i = 0; i < 2; ++i) { const int idx = threadIdx.x + i * NTHR, kp = idx >> 4, n4 = idx & 15;
#pragma unroll
        for (int e = 0; e < 4; ++e) scr[(n4 * 4 + e) * 65 + kp] = cvtpk(r[2 * i][e] * j.scale, r[2 * i + 1][e] * j.scale); }
    __syncthreads();
    { const int n = threadIdx.x >> 3, c8 = threadIdx.x & 7; const LAS unsigned* q = scr + n * 65 + c8 * 8;
      u32x4 w0 = {q[0], q[1], q[2], q[3]}, w1 = {q[4], q[5], q[6], q[7]};
      u16* o = j.dst + (size_t)n * j.ldk + c8 * 16; *(u32x4*)o = w0; *(u32x4*)(o + 8) = w1; }
    __syncthreads();
}
template <class JobFn>
__device__ __forceinline__ void conv_stream(int first, int stride, int total, const JobFn& jf, LAS unsigned char* lds) {
    if (first >= total) return;
    const int last = first + ((total - 1 - first) / stride) * stride;
    ConvJob ja = jf(first), jb = jf(first + stride <= last ? first + stride : last), jc = ja;
    f32x4 ra[4], rb[4], rc[4]; conv_load(ja, ra); conv_load(jb, rb);
    int u = first;
    for (; u + 2 * stride <= last; u += 3 * stride) {
        { const int n2 = u + 2 * stride; jc = jf(n2); conv_load(jc, rc); conv_store(ja, ra, lds); }
        { const int n2 = u + 3 * stride; ja = jf(n2 <= last ? n2 : last); conv_load(ja, ra); conv_store(jb, rb, lds); }
        { const int n2 = u + 4 * stride; jb = jf(n2 <= last ? n2 : last); conv_load(jb, rb); conv_store(jc, rc, lds); }
    }
    if (u <= last) { conv_store(ja, ra, lds); if (u + stride <= last) conv_store(jb, rb, lds); }
}
constexpr int MOE_CONV_UNITS = NE * 192;
struct MoeJob { const Params* p; int l;
    __device__ __forceinline__ ConvJob operator()(int u) const {
        const int e = u / 192, j = u % 192; ConvJob c; c.scale = 1.f;
        if (j < 128) { const int nt16 = j >> 3, kt = j & 7, pn = nt16 >> 2, part = (nt16 >> 1) & 1, half = nt16 & 1;
            c.src = (part ? p->in[23] : p->in[22]) + ((size_t)l * NE + e) * 1024 * 512 + (size_t)(kt * 128) * 512 + pn * 128 + half * 64; c.ldn = 512;
            c.dst = (u16*)(p->ws + WS_W13) + (size_t)e * 1024 * 1024 + (size_t)(nt16 * 64) * 1024 + kt * 128; c.ldk = 1024;
        } else { const int jj = j - 128, nt16 = jj >> 2, kt = jj & 3;
            c.src = p->in[24] + ((size_t)l * NE + e) * 512 * 1024 + (size_t)(kt * 128) * 1024 + nt16 * 64; c.ldn = 1024;
            c.dst = (u16*)(p->ws + WS_W2) + (size_t)e * 1024 * 512 + (size_t)(nt16 * 64) * 512 + kt * 128; c.ldk = 512; }
        return c; }
};
struct P0Job { const Params* p;
    __device__ __forceinline__ ConvJob operator()(int u) const { ConvJob c; c.scale = 1.f; c.ldk = 1024;
        if (u < 512) {
            const int nt = u >> 3, kt = u & 7, n0 = nt * 64, grp = n0 >> 9, w = n0 & 511;
            int s0 = n0; if (grp == 4 || grp == 5) s0 = grp * 512 + (2 * (w >> 8) + ((w >> 6) & 1)) * 128 + 64 * ((w >> 7) & 1);
            c.src = p->in[8] + (size_t)(kt * 128) * 4112 + s0 + (s0 >= 2048 ? 16 : 0); c.ldn = 4112; c.dst = (u16*)(p->ws + WS_WINE) + (size_t)n0 * 1024 + kt * 128;
            c.scale = (grp == 1 || grp == 5) ? 0.08838834764831845f : 1.f;
        } else if (u < 640) { const int v = u - 512; c.src = p->in[13] + (size_t)((v & 7) * 128) * 1024 + (v >> 3) * 64; c.ldn = 1024; c.dst = (u16*)(p->ws + WS_WOUTE) + (size_t)((v >> 3) * 64) * 1024 + (v & 7) * 128;
        } else if (u < 1024) { const int v = u - 640; c.src = p->in[14] + (size_t)((v & 7) * 128) * 3072 + (v >> 3) * 64; c.ldn = 3072; c.dst = (u16*)(p->ws + WS_WINO) + (size_t)((v >> 3) * 64) * 1024 + (v & 7) * 128;
        } else { const int v = u - 1024; c.src = p->in[17] + (size_t)((v & 7) * 128) * 1024 + (v >> 3) * 64; c.ldn = 1024; c.dst = (u16*)(p->ws + WS_WOUTO) + (size_t)((v >> 3) * 64) * 1024 + (v & 7) * 128; }
        return c; }
};
constexpr int P0_CONV = 512 + 128 + 384 + 128, P0_GATEW = P0_CONV, P0_MOD = P0_GATEW + 1, P0_ROPE1 = P0_MOD + 384, P0_ROPE2 = P0_ROPE1 + 132, P0_UNITS = P0_ROPE2 + 1;
__device__ __forceinline__ void phase0(const Params& p, LAS unsigned char* lds, int bid, int nblk) {
    const int tid = threadIdx.x;
    { P0Job jf{&p}; conv_stream(bid, nblk, P0_CONV, jf, lds); }
    for (int u = P0_CONV + bid; u < P0_UNITS; u += nblk) {
        if (u == P0_GATEW) {
            float* gw = (float*)(p.ws + WS_GATEW);
            for (int i = tid; i < 16 * 1024; i += NTHR) { int k = i >> 4, j = i & 15; gw[j * 1024 + k] = p.in[8][(size_t)k * 4112 + 2048 + j]; }
        } else if (u < P0_ROPE1) {
            const int v0 = u - P0_MOD, l = v0 / 192, cb = v0 % 192;
            LAS float* sc = (LAS float*)lds;
            LAS float* part = sc + 5 * 1024;
            for (int i = tid; i < 5 * 1024; i += NTHR) { int v = i >> 10, k = i & 1023; float c = v < 4 ? p.in[1][v * 1024 + k] : p.in[3][k]; sc[i] = siluf_(c); }
            __syncthreads();
            const int col = tid & 31, kq = tid >> 5;
            const float* w = p.in[4] + (size_t)l * 1024 * 6144 + cb * 32 + col;
            float a0 = 0, a1 = 0, a2 = 0, a3 = 0, a4 = 0;
#pragma unroll 16
            for (int k = kq * 64; k < kq * 64 + 64; ++k) { float wv = w[(size_t)k * 6144]; a0 += sc[k] * wv; a1 += sc[1024 + k] * wv; a2 += sc[2048 + k] * wv; a3 += sc[3072 + k] * wv; a4 += sc[4096 + k] * wv; }
            part[(kq * 5 + 0) * 32 + col] = a0; part[(kq * 5 + 1) * 32 + col] = a1; part[(kq * 5 + 2) * 32 + col] = a2; part[(kq * 5 + 3) * 32 + col] = a3; part[(kq * 5 + 4) * 32 + col] = a4;
            __syncthreads();
            if (tid < 5 * 32) { const int v = tid >> 5, c = tid & 31; float s = 0.f;
#pragma unroll
                for (int q = 0; q < 16; ++q) s += part[(q * 5 + v) * 32 + c];
                ((float*)(p.ws + WS_MOD))[((size_t)l * 5 + v) * 6144 + cb * 32 + c] = s + p.in[5][l * 6144 + cb * 32 + c]; }
            __syncthreads();
        } else if (u < P0_ROPE2) {
            const int v0 = u - P0_ROPE1; float2* tb = (float2*)(p.ws + WS_ROPE1);
            for (int j = 0; j < 8; ++j) { int e = v0 * 4096 + j * 512 + tid; int pos = e >> 6, f = e & 63;
                float inv = powf(10000.f, -(float)f / 64.f); float ang = (float)pos * inv; tb[e] = make_float2(cosf(ang), sinf(ang)); }
        } else {
            float2* tb = (float2*)(p.ws + WS_ROPE2);
            for (int e = tid; e < 128 * 16; e += NTHR) { int pos = e >> 4, f = e & 15; float inv = powf(10000.f, -(float)f / 16.f); float ang = (float)pos * inv; tb[e] = make_float2(cosf(ang), sinf(ang)); }
        }
    }
}

__device__ __forceinline__ void load_row(const float* rp, int lane, f32x4 (&x)[4]) {
#pragma unroll
    for (int i = 0; i < 4; ++i) x[i] = *(const f32x4*)(rp + i * 256 + lane * 4);
}
__device__ __forceinline__ float row_rstd(const f32x4 (&x)[4]) {
    float ss = 0;
#pragma unroll
    for (int i = 0; i < 4; ++i) ss += x[i][0] * x[i][0] + x[i][1] * x[i][1] + x[i][2] * x[i][2] + x[i][3] * x[i][3];
    ss = wave_sum(ss);
    return rsqrtf(ss * (1.f / 1024.f) + EPS);
}
__device__ __forceinline__ void adaln_row(f32x4 (&x)[4], float rstd, const float* g, const float* shift, const float* scale, int lane) {
#pragma unroll
    for (int i = 0; i < 4; ++i) { f32x4 gv = *(const f32x4*)(g + i * 256 + lane * 4), sh = *(const f32x4*)(shift + i * 256 + lane * 4), sc = *(const f32x4*)(scale + i * 256 + lane * 4);
#pragma unroll
        for (int e = 0; e < 4; ++e) x[i][e] = x[i][e] * rstd * gv[e] * (1.f + sc[e]) + sh[e]; }
}
struct AdaC { f32x4 g[4], sh[4], sc[4]; };
__device__ __forceinline__ void adac_load(AdaC& c, const float* g, const float* shift, const float* scale, int lane) {
#pragma unroll
    for (int i = 0; i < 4; ++i) { c.g[i] = *(const f32x4*)(g + i * 256 + lane * 4); c.sh[i] = *(const f32x4*)(shift + i * 256 + lane * 4); c.sc[i] = *(const f32x4*)(scale + i * 256 + lane * 4); }
}
__device__ __forceinline__ void adaln_apply(f32x4 (&x)[4], float rstd, const AdaC& c) {
#pragma unroll
    for (int i = 0; i < 4; ++i)
#pragma unroll
        for (int e = 0; e < 4; ++e) x[i][e] = x[i][e] * rstd * c.g[i][e] * (1.f + c.sc[i][e]) + c.sh[i][e];
}
__device__ __forceinline__ void store_row_bf16(u16* rp, int lane, const f32x4 (&x)[4]) {
#pragma unroll
    for (int i = 0; i < 4; ++i) { u32x2 w = {cvtpk(x[i][0], x[i][1]), cvtpk(x[i][2], x[i][3])}; *(u32x2*)(rp + i * 256 + lane * 4) = w; }
}
__device__ __forceinline__ const float* l0_in_row(const Params& p, int r) { return r < NCTX ? p.in[2] + (size_t)r * D : p.in[0] + (size_t)(r - NCTX) * D; }
__device__ __forceinline__ float* h_row(const Params& p, int r) { return r < NCTX ? (float*)(p.ws + WS_HCTX) + (size_t)r * D : p.out + (size_t)(r - NCTX) * D; }

__device__ __forceinline__ void phase1(const Params& p, LAS unsigned char* lds, int bid, int nblk) {
    const int tid = threadIdx.x, wid = tid >> 6, lane = tid & 63;
    LAS float* gw = (LAS float*)lds;
    { const float* src = (const float*)(p.ws + WS_GATEW); for (int i = tid; i < 16 * 1024 / 4; i += NTHR) *(LAS f32x4*)(gw + i * 4) = *(const f32x4*)(src + i * 4); }
    __syncthreads();
    const float* mod = (const float*)(p.ws + WS_MOD);
    const int gwv = bid * 8 + __builtin_amdgcn_readfirstlane(wid), nwv = nblk * 8, rs = (int)(((long)gwv * NROW) / nwv), re = (int)(((long)(gwv + 1) * NROW) / nwv);
    AdaC ac; int curmv = -1;
    f32x4 gbias;
    { const int q = lane >> 4, dir = q & 1, kind = q >> 1;
#pragma unroll
      for (int h = 0; h < 4; ++h) gbias[h] = p.in[9][dir * 8 + kind * 4 + h]; }
    f32x4 xa[4], xb[4], xc[4];
    if (rs < re) load_row(l0_in_row(p, rs), lane, xa);
    if (rs + 1 < re) load_row(l0_in_row(p, rs + 1), lane, xb);
#define P1_STEP(R, x, PF) do { const int r = (R); if (r + 2 < re) load_row(l0_in_row(p, r + 2), lane, PF); \
        const int mv = row_modvec(r); \
        if (mv != curmv) { const float* m = mod + (size_t)(0 * 5 + mv) * 6144; adac_load(ac, p.in[6], m, m + 1024, lane); curmv = mv; } \
        const float rstd = row_rstd(x); \
        adaln_apply(x, rstd, ac); \
        store_row_bf16((u16*)(p.ws + WS_X1) + (size_t)r * D, lane, x); \
        float a[16]; \
        _Pragma("unroll") for (int j = 0; j < 16; ++j) { float s = 0.f; \
            _Pragma("unroll") for (int i = 0; i < 4; ++i) { const f32x4 w = *(const LAS f32x4*)(gw + j * 1024 + i * 256 + lane * 4); s += x[i][0] * w[0] + x[i][1] * w[1] + x[i][2] * w[2] + x[i][3] * w[3]; } \
            a[j] = s; if ((j & 3) == 3) SBAR(); } \
        float s8[8], t4[4]; \
        _Pragma("unroll") for (int j = 0; j < 8; ++j) { auto rr = __builtin_amdgcn_permlane32_swap(__float_as_uint(a[j]), __float_as_uint(a[j + 8]), false, false); s8[j] = __uint_as_float(rr[0]) + __uint_as_float(rr[1]); } \
        _Pragma("unroll") for (int j = 0; j < 4; ++j) { auto rr = __builtin_amdgcn_permlane16_swap(__float_as_uint(s8[j]), __float_as_uint(s8[j + 4]), false, false); t4[j] = row_sum16(__uint_as_float(rr[0]) + __uint_as_float(rr[1])); } \
        if ((lane & 15) == 0) { const int q = lane >> 4; f32x4 o; \
            _Pragma("unroll") for (int h = 0; h < 4; ++h) { const float z = t4[h] + gbias[h]; o[h] = (q < 2) ? z : fminf(z, 0.f) - log1pf(__expf(-fabsf(z))); } \
            *(f32x4*)((float*)(p.ws + WS_GATES) + (size_t)r * 16 + q * 4) = o; } } while (0)
    for (int r0 = rs; r0 < re; r0 += 3) {
        P1_STEP(r0, xa, xc);
        if (r0 + 1 < re) P1_STEP(r0 + 1, xb, xa);
        if (r0 + 2 < re) P1_STEP(r0 + 2, xc, xb);
    }
#undef P1_STEP
}

namespace pg {
constexpr int BM = 256, BK = 64, HALF = 128, HTB = HALF * BK * 2, NXCD = 8, WGM = 8;
__device__ __forceinline__ int lds_byte(int r, int c) { const int st = (r >> 4) * 2 + (c >> 5), rr = r & 15, cc = c & 31, ob = rr * 64 + cc * 2; return st * 1024 + (ob ^ (((ob >> 9) & 1) << 5)); }
__device__ __forceinline__ void stage_rc(int b, int& R, int& C) { const int st = b / 1024, sb = b % 1024, swz = sb ^ (((sb >> 9) & 1) << 5); R = (st >> 1) * 16 + swz / 64; C = (st & 1) * 32 + (swz % 64) / 2; }
__device__ __forceinline__ int perm32(int rho) { const int n = rho >> 4, i = rho & 15; return 8 * (i >> 2) + 4 * n + (i & 3); }
struct Unit { int pm, pn, e, nv, off; };
__device__ __forceinline__ int xcd_remap(int wgid, int nwg) { const int q = nwg / NXCD, r = nwg % NXCD, xcd = wgid % NXCD, off = wgid / NXCD; return (xcd < r ? xcd * (q + 1) : r * (q + 1) + (xcd - r) * q) + off; }

struct DenseSched {
    static constexpr bool GATHER = false;
    const char* A; const char* Bt; int pm0, nM, nN, nwg, G, c; size_t tstep;
    __device__ __forceinline__ void init(const void* A_, const void* Bt_, int K, int pm0_, int nM_, int nN_, int G_, int c_) { A = (const char*)A_; Bt = (const char*)Bt_; pm0 = pm0_; nM = nM_; nN = nN_; nwg = nM * nN; G = G_; c = c_; tstep = (size_t)BM * K * 2; }
    __device__ __forceinline__ bool next(int i, Unit& u) const {
        const long L = (long)i * G + c; if (L >= nwg) return false;
        const int wgid = xcd_remap((int)L, nwg);
        const int nig = WGM * nN, gid = wgid / nig, fm = gid * WGM, gsz = (nM - fm) < WGM ? (nM - fm) : WGM;
        u.pm = pm0 + fm + ((wgid % nig) % gsz); u.pn = (wgid % nig) / gsz; u.e = 0; u.nv = 256; u.off = 0; return true;
    }
    __device__ __forceinline__ const char* abase(const Unit& u) const { return A + (size_t)u.pm * tstep; }
    __device__ __forceinline__ const char* bbase(const Unit& u) const { return Bt + (size_t)u.pn * tstep; }
    __device__ __forceinline__ void stage_rows(const Unit&) const {}
    __device__ __forceinline__ void aoffs(unsigned (&o)[2][2], int K) const {
#pragma unroll
        for (int h = 0; h < 2; ++h)
#pragma unroll
            for (int i = 0; i < 2; ++i) { int R, C; stage_rc(threadIdx.x * 16 + i * 8192, R, C); o[h][i] = (unsigned)((h * HALF + R) * K + C) * 2u; } }
};
template <bool GATHER_> struct MoeSched {
    static constexpr bool GATHER = GATHER_;
    const char* A; const char* Bt; const LAS int* CNT; const LAS int* OFF; const LAS int* TIL; LAS int* RIDX; const int* list; int nwg, G, c, K, fallback;
    __device__ __forceinline__ bool next(int i, Unit& u) const {
        const long L = (long)i * G + c; if (L >= nwg) return false;
        const int wgid = __builtin_amdgcn_readfirstlane(xcd_remap((int)L, nwg)), tile = wgid >> 2; int e = 0;
#pragma unroll
        for (int j = 1; j < 32; ++j) e += (TIL[j] <= tile) ? 1 : 0;
        e = __builtin_amdgcn_readfirstlane(e);
        u.e = e; u.pm = __builtin_amdgcn_readfirstlane(tile - TIL[e]); u.pn = wgid & 3; const int left = __builtin_amdgcn_readfirstlane(CNT[e]) - u.pm * 256; u.nv = left < 256 ? left : 256;
        u.off = __builtin_amdgcn_readfirstlane(OFF[e]); return true;
    }
    __device__ __forceinline__ const char* abase(const Unit& u) const { return GATHER ? A : A + (size_t)(u.off + u.pm * 256) * K * 2; }
    __device__ __forceinline__ const char* bbase(const Unit& u) const { return Bt + ((size_t)u.e * 1024 + u.pn * 256) * K * 2; }
    __device__ __forceinline__ void stage_rows(const Unit& u) const {
        if (GATHER) { const int t = threadIdx.x; if (t < 256) RIDX[t] = t < u.nv ? list[(size_t)u.e * NROW + u.pm * 256 + t] : fallback; } }
    __device__ __forceinline__ void aoffs(unsigned (&o)[2][2], int K_) const {
#pragma unroll
        for (int h = 0; h < 2; ++h)
#pragma unroll
            for (int i = 0; i < 2; ++i) { int R, C; int tz = threadIdx.x; asm volatile("" : "+v"(tz)); stage_rc(tz * 16 + i * 8192, R, C); const int rr = h * HALF + R;
                if (GATHER) o[h][i] = (unsigned)(RIDX[rr] * K_ + C) * 2u; else o[h][i] = (unsigned)(rr * K_ + C) * 2u; } }
};

template <bool PERM, class Sched, class Epi>
__device__ __forceinline__ void gemm_phase(LAS unsigned char* lds, const int K, const Sched& S, const Epi& E) {
    const int tid = threadIdx.x, wid = __builtin_amdgcn_readfirstlane(tid >> 6), lane = tid & 63, wr = wid >> 2, wc = wid & 3, fr = lane & 15, fq = lane >> 4;
    const int nt = K / BK;
    unsigned voffB[2];
#pragma unroll
    for (int i = 0; i < 2; ++i) { int R, C; stage_rc(tid * 16 + i * 8192, R, C); const int Rb = PERM ? ((R & ~31) + perm32(R & 31)) : R; voffB[i] = (unsigned)(Rb * K + C) * 2u; }
    const size_t kstep = (size_t)(BK * 2);
    const size_t hstep = (size_t)HALF * K * 2;
    const unsigned ldsw = (unsigned)wid * 1024u;
    const int aoff = lds_byte(wr * 64 + fr, fq * 8), boff = lds_byte(wc * 32 + fr, fq * 8);
#define PG_SA(b, h) (((b) * 2 + (h)) * HTB)
#define PG_SB(b, h) ((4 + (b) * 2 + (h)) * HTB)
#define PG_STG(bufoff, gbase, o0, o1) do { __builtin_amdgcn_global_load_lds((const unsigned*)((const char*)(gbase) + (o0)), (LAS unsigned*)(lds + (bufoff) + ldsw), 16, 0, 0); \
        __builtin_amdgcn_global_load_lds((const unsigned*)((const char*)(gbase) + (o1)), (LAS unsigned*)(lds + (bufoff) + ldsw + 8192), 16, 0, 0); } while (0)
#define PG_STGB(bufoff, gbase) PG_STG(bufoff, gbase, voffB[0], voffB[1])
#define PG_LDA(dst, b, h) do { _Pragma("unroll") for (int m = 0; m < 4; ++m) _Pragma("unroll") for (int k = 0; k < 2; ++k) dst[m][k] = *(const LAS bf16x8*)(lds + PG_SA(b, h) + aoff + m * 2048 + k * 1024); } while (0)
#define PG_LDB(dst, b, h) do { _Pragma("unroll") for (int n = 0; n < 2; ++n) _Pragma("unroll") for (int k = 0; k < 2; ++k) dst[n][k] = *(const LAS bf16x8*)(lds + PG_SB(b, h) + boff + n * 2048 + k * 1024); } while (0)
#define PG_MMA(ai, bj, At, Bt) do { __builtin_amdgcn_s_setprio(1); _Pragma("unroll") for (int m = 0; m < 4; ++m) _Pragma("unroll") for (int n = 0; n < 2; ++n) _Pragma("unroll") for (int k = 0; k < 2; ++k) \
        acc[ai][bj][m][n] = __builtin_amdgcn_mfma_f32_16x16x32_bf16(Bt[n][k], At[m][k], acc[ai][bj][m][n], 0, 0, 0); __builtin_amdgcn_s_setprio(0); } while (0)
#define PG_BAR __builtin_amdgcn_s_barrier()
#define PG_SCHED __builtin_amdgcn_sched_barrier(0)
    Unit cur, nxt; int ui = 0;
    if (!S.next(0, cur)) return;
    f32x4 acc[2][2][4][2];
#pragma unroll
    for (int a = 0; a < 2; ++a)
#pragma unroll
        for (int b = 0; b < 2; ++b)
#pragma unroll
            for (int m = 0; m < 4; ++m)
#pragma unroll
                for (int n = 0; n < 2; ++n) acc[a][b][m][n] = (f32x4){0.f, 0.f, 0.f, 0.f};
    bf16x8 At[4][2], B0[2][2], B1[2][2];
    const char* cA = S.abase(cur); const char* cB = S.bbase(cur);
    unsigned oc[2][2];
    if (Sched::GATHER) { S.stage_rows(cur); __syncthreads(); }
    S.aoffs(oc, K);
    PG_STGB(PG_SB(0, 0), cB); PG_STGB(PG_SB(0, 1), cB + hstep); PG_STG(PG_SA(0, 0), cA, oc[0][0], oc[0][1]); PG_STG(PG_SA(0, 1), cA, oc[1][0], oc[1][1]);
    if (wr == 1) PG_BAR;
    WAIT_V(2); PG_BAR;
    PG_STGB(PG_SB(1, 0), cB + kstep); PG_STG(PG_SA(1, 0), cA + kstep, oc[0][0], oc[0][1]); PG_STGB(PG_SB(1, 1), cB + hstep + kstep);
    WAIT_V(6); PG_BAR;
    for (;;) {
        const bool has_next = S.next(ui + 1, nxt);
        const char* nA = cA; const char* nB = cB;
        if (has_next) { nA = S.abase(nxt); nB = S.bbase(nxt); if (Sched::GATHER) S.stage_rows(nxt); }
        for (int t = 0; t < nt; t += 2) {
            const bool last = (t == nt - 2);
            const char* a1 = cA + (size_t)(t + 1) * kstep;
            const char* a2 = last ? nA : cA + (size_t)(t + 2) * kstep; const char* b2 = last ? nB : cB + (size_t)(t + 2) * kstep;
            const char* a3 = a2 + kstep; const char* b3 = b2 + kstep;
            PG_LDB(B0, 0, 0); PG_LDB(B1, 0, 1); PG_SCHED; PG_LDA(At, 0, 0); PG_STG(PG_SA(1, 1), a1, oc[1][0], oc[1][1]);
            if (Sched::GATHER) { if (last && has_next) S.aoffs(oc, K); }
            WAIT_V(8); WAIT_L(0); PG_BAR; PG_MMA(0, 0, At, B0); PG_MMA(0, 1, At, B1); PG_BAR; PG_SCHED;
            PG_LDA(At, 0, 1); PG_STGB(PG_SB(0, 0), b2); PG_STGB(PG_SB(0, 1), b2 + hstep); PG_STG(PG_SA(0, 0), a2, oc[0][0], oc[0][1]);
            WAIT_V(8); WAIT_L(0); PG_BAR; PG_MMA(1, 0, At, B0); PG_MMA(1, 1, At, B1); PG_BAR; PG_SCHED;
            PG_LDB(B0, 1, 0); PG_LDB(B1, 1, 1); PG_SCHED; PG_LDA(At, 1, 0); PG_STG(PG_SA(0, 1), a2, oc[1][0], oc[1][1]);
            WAIT_V(8); WAIT_L(0); PG_BAR; PG_MMA(0, 0, At, B0); PG_MMA(0, 1, At, B1); PG_BAR; PG_SCHED;
            PG_LDA(At, 1, 1); PG_STGB(PG_SB(1, 0), b3); PG_STGB(PG_SB(1, 1), b3 + hstep); PG_STG(PG_SA(1, 0), a3, oc[0][0], oc[0][1]);
            WAIT_V(8); WAIT_L(0); PG_BAR; PG_MMA(1, 0, At, B0); PG_MMA(1, 1, At, B1); PG_BAR; PG_SCHED;
        }
        if (wr == 0) PG_BAR;
        E(acc, cur, wr, wc, fr, fq);
        if (!has_next) break;
#pragma unroll
        for (int a = 0; a < 2; ++a)
#pragma unroll
            for (int b = 0; b < 2; ++b)
#pragma unroll
                for (int m = 0; m < 4; ++m)
#pragma unroll
                    for (int n = 0; n < 2; ++n) acc[a][b][m][n] = (f32x4){0.f, 0.f, 0.f, 0.f};
        cur = nxt; cA = nA; cB = nB; ++ui;
        if (wr == 1) PG_BAR;
    }
    WAIT_V(0);
    PG_BAR;
#undef PG_SA
#undef PG_SB
#undef PG_STG
#undef PG_STGB
#undef PG_LDA
#undef PG_LDB
#undef PG_MMA
#undef PG_BAR
#undef PG_SCHED
}
}

__device__ __forceinline__ u32x4 pack8(const f32x4& a, const f32x4& b) { return (u32x4){cvtpk(a[0], a[1]), cvtpk(a[2], a[3]), cvtpk(b[0], b[1]), cvtpk(b[2], b[3])}; }

struct EpiIn0 { u16* O; const float2* rope;
    __device__ __forceinline__ void operator()(const f32x4 (&acc)[2][2][4][2], const pg::Unit& u, int wr_, int wc_, int fr_, int fq_) const {
        int tz = threadIdx.x; asm volatile("" : "+v"(tz)); const int wr = tz >> 8, wc = (tz >> 6) & 3, fr = tz & 15, fq = (tz >> 4) & 3;
        const int g8 = u.pn >> 1, row0 = u.pm * 256 + wr * 64 + fr, qq0 = wc * 32 + fq * 8;
        if (g8 == 4 || g8 == 5) {
            const int head = 2 * (u.pn & 1) + (qq0 >> 6), f0 = qq0 & 63;
#pragma unroll
            for (int ai = 0; ai < 2; ++ai)
#pragma unroll
                for (int m = 0; m < 4; ++m) { const int row = row0 + ai * 128 + m * 16; const f32x4* tb = (const f32x4*)(rope + (size_t)row_pos(row) * 64 + f0);
                    const f32x4 t0 = tb[0], t1 = tb[1], t2 = tb[2], t3 = tb[3];
                    const f32x4 xa = acc[ai][0][m][0], xb = acc[ai][0][m][1], ya = acc[ai][1][m][0], yb = acc[ai][1][m][1];
                    f32x4 o1a = {xa[0] * t0[0] - ya[0] * t0[1], xa[1] * t0[2] - ya[1] * t0[3], xa[2] * t1[0] - ya[2] * t1[1], xa[3] * t1[2] - ya[3] * t1[3]};
                    f32x4 o1b = {xb[0] * t2[0] - yb[0] * t2[1], xb[1] * t2[2] - yb[1] * t2[3], xb[2] * t3[0] - yb[2] * t3[1], xb[3] * t3[2] - yb[3] * t3[3]};
                    f32x4 o2a = {xa[0] * t0[1] + ya[0] * t0[0], xa[1] * t0[3] + ya[1] * t0[2], xa[2] * t1[1] + ya[2] * t1[0], xa[3] * t1[3] + ya[3] * t1[2]};
                    f32x4 o2b = {xb[0] * t2[1] + yb[0] * t2[0], xb[1] * t2[3] + yb[1] * t2[2], xb[2] * t3[1] + yb[2] * t3[0], xb[3] * t3[3] + yb[3] * t3[2]};
                    u16* op = O + (size_t)row * 4096 + g8 * 512 + head * 128 + f0;
                    *(u32x4*)op = pack8(o1a, o1b); *(u32x4*)(op + 64) = pack8(o2a, o2b); }
        } else {
#pragma unroll
            for (int ai = 0; ai < 2; ++ai)
#pragma unroll
                for (int m = 0; m < 4; ++m)
#pragma unroll
                    for (int bj = 0; bj < 2; ++bj) { f32x4 v0 = acc[ai][bj][m][0], v1 = acc[ai][bj][m][1];
                        if (g8 == 3) {
#pragma unroll
                            for (int e = 0; e < 4; ++e) { v0[e] = sigmoidf_(v0[e]); v1[e] = sigmoidf_(v1[e]); } }
                        else if (g8 == 7) {
#pragma unroll
                            for (int e = 0; e < 4; ++e) { v0[e] = siluf_(v0[e]); v1[e] = siluf_(v1[e]); } }
                        *(u32x4*)(O + (size_t)(row0 + ai * 128 + m * 16) * 4096 + u.pn * 256 + bj * 128 + qq0) = pack8(v0, v1); }
        }
    }
};
struct EpiIn1 { u16* O; const float2* rope; unsigned* kmax;
    __device__ __forceinline__ void operator()(const f32x4 (&acc)[2][2][4][2], const pg::Unit& u, int wr_, int wc_, int fr_, int fq_) const {
        int tz = threadIdx.x; asm volatile("" : "+v"(tz)); const int wr = tz >> 8, wc = (tz >> 6) & 3, fr = tz & 15, fq = (tz >> 4) & 3;
        const int row0 = u.pm * 256 + wr * 64 + fr; const bool rot = (u.pn < 8) && (u.pm >= 4);
        if (u.pn >= 4 && u.pn < 8) {
            float mx0 = 0.f, mx1 = 0.f;
#pragma unroll
            for (int ai = 0; ai < 2; ++ai)
#pragma unroll
                for (int m = 0; m < 4; ++m) {
                    float s0 = 0.f, s1 = 0.f;
#pragma unroll
                    for (int n = 0; n < 2; ++n)
#pragma unroll
                        for (int e = 0; e < 4; ++e) { s0 += acc[ai][0][m][n][e] * acc[ai][0][m][n][e]; s1 += acc[ai][1][m][n][e] * acc[ai][1][m][n][e]; }
                    s0 = swap32_add(swap16_add(s0)); s1 = swap32_add(swap16_add(s1)); mx0 = fmaxf(mx0, s0); mx1 = fmaxf(mx1, s1); }
            mx0 = row_max16(mx0); mx1 = row_max16(mx1);
            if ((tz & 63) == 0) { const int b = u.pm < 4 ? u.pm : ((u.pm - 4) >> 5), hd = 2 * (u.pn - 4);
                atomicMax(kmax + (b * 8 + hd) * 4 + wc, __float_as_uint(mx0)); atomicMax(kmax + (b * 8 + hd + 1) * 4 + wc, __float_as_uint(mx1)); }
        }
#pragma unroll
        for (int ai = 0; ai < 2; ++ai)
#pragma unroll
            for (int m = 0; m < 4; ++m) { const int row = row0 + ai * 128 + m * 16; u16* op = O + (size_t)row * 3072 + u.pn * 256 + wc * 32 + fq * 4;
                f32x4 t0 = {1.f, 0.f, 1.f, 0.f}, t1 = {1.f, 0.f, 1.f, 0.f};
                if (rot) { const int t = (row - NCTX) & 8191, pos = (wc & 1) ? (t & 63) : (t >> 6); const f32x4* tb = (const f32x4*)(rope + pos * 16 + fq * 4); t0 = tb[0]; t1 = tb[1]; }
#pragma unroll
                for (int bj = 0; bj < 2; ++bj) { const f32x4 x = acc[ai][bj][m][0], y = acc[ai][bj][m][1];
                    f32x4 o1 = {x[0] * t0[0] - y[0] * t0[1], x[1] * t0[2] - y[1] * t0[3], x[2] * t1[0] - y[2] * t1[1], x[3] * t1[2] - y[3] * t1[3]};
                    f32x4 o2 = {x[0] * t0[1] + y[0] * t0[0], x[1] * t0[3] + y[1] * t0[2], x[2] * t1[1] + y[2] * t1[0], x[3] * t1[3] + y[3] * t1[2]};
                    *(u32x2*)(op + bj * 128) = (u32x2){cvtpk(o1[0], o1[1]), cvtpk(o1[2], o1[3])}; *(u32x2*)(op + bj * 128 + 16) = (u32x2){cvtpk(o2[0], o2[1]), cvtpk(o2[2], o2[3])}; } }
    }
};
template <int L> struct EpiOut { const Params* p;
    __device__ __forceinline__ void operator()(const f32x4 (&acc)[2][2][4][2], const pg::Unit& u, int wr_, int wc_, int fr_, int fq_) const {
        int tz = threadIdx.x; asm volatile("" : "+v"(tz)); const int wr = tz >> 8, wc = (tz >> 6) & 3, fr = tz & 15, fq = (tz >> 4) & 3;
        const int row0 = u.pm * 256 + wr * 64 + fr, c0 = u.pn * 256 + wc * 32 + fq * 8;
        const float* gate = (const float*)(p->ws + WS_MOD) + (size_t)(L * 5 + row_modvec(u.pm * 256)) * 6144 + 2 * 1024 + c0;
        const f32x4 g00 = *(const f32x4*)gate, g01 = *(const f32x4*)(gate + 4), g10 = *(const f32x4*)(gate + 128), g11 = *(const f32x4*)(gate + 132);
#pragma unroll
        for (int ai = 0; ai < 2; ++ai)
#pragma unroll
            for (int m = 0; m < 4; ++m) { const int r = row0 + ai * 128 + m * 16;
                const float* src = (L == 0 ? l0_in_row(*p, r) : (const float*)h_row(*p, r)) + c0; float* dst = h_row(*p, r) + c0;
                *(f32x4*)dst = *(const f32x4*)src + g00 * acc[ai][0][m][0]; *(f32x4*)(dst + 4) = *(const f32x4*)(src + 4) + g01 * acc[ai][0][m][1];
                *(f32x4*)(dst + 128) = *(const f32x4*)(src + 128) + g10 * acc[ai][1][m][0]; *(f32x4*)(dst + 132) = *(const f32x4*)(src + 132) + g11 * acc[ai][1][m][1]; }
    }
};
struct EpiUp { u16* H; const LAS int* OFF;
    __device__ __forceinline__ void operator()(const f32x4 (&acc)[2][2][4][2], const pg::Unit& u, int wr_, int wc_, int fr_, int fq_) const {
        int tz = threadIdx.x; asm volatile("" : "+v"(tz)); const int wr = tz >> 8, wc = (tz >> 6) & 3, fr = tz & 15, fq = (tz >> 4) & 3;
        const int rl0 = wr * 64 + fr; u16* base = H + (size_t)(u.off + u.pm * 256) * 512 + u.pn * 128 + wc * 32 + fq * 8;
#pragma unroll
        for (int ai = 0; ai < 2; ++ai)
#pragma unroll
            for (int m = 0; m < 4; ++m) { const int rl = rl0 + ai * 128 + m * 16;
                if (rl < u.nv) { f32x4 a = acc[ai][0][m][0], b = acc[ai][0][m][1]; const f32x4 c = acc[ai][1][m][0], d = acc[ai][1][m][1];
#pragma unroll
                    for (int e = 0; e < 4; ++e) { a[e] = siluf_(a[e]) * c[e]; b[e] = siluf_(b[e]) * d[e]; }
                    *(u32x4*)(base + (size_t)rl * 512) = pack8(a, b); } }
    }
};
struct EpiDown { u16* Y; const LAS int* OFF;
    __device__ __forceinline__ void operator()(const f32x4 (&acc)[2][2][4][2], const pg::Unit& u, int wr_, int wc_, int fr_, int fq_) const {
        int tz = threadIdx.x; asm volatile("" : "+v"(tz)); const int wr = tz >> 8, wc = (tz >> 6) & 3, fr = tz & 15, fq = (tz >> 4) & 3;
        const int rl0 = wr * 64 + fr; u16* base = Y + (size_t)(u.off + u.pm * 256) * 1024 + u.pn * 256 + wc * 32 + fq * 8;
#pragma unroll
        for (int ai = 0; ai < 2; ++ai)
#pragma unroll
            for (int m = 0; m < 4; ++m) { const int rl = rl0 + ai * 128 + m * 16;
                if (rl < u.nv) {
#pragma unroll
                    for (int bj = 0; bj < 2; ++bj) *(u32x4*)(base + (size_t)rl * 1024 + bj * 128) = pack8(acc[ai][bj][m][0], acc[ai][bj][m][1]); } }
    }
};

__device__ __forceinline__ void phase2(const Params& p, LAS unsigned char* lds, int bid, int nblk) {
    pg::DenseSched S; S.init(p.ws + WS_X1, p.ws + WS_WINE, 1024, 0, 132, 16, nblk, bid);
    EpiIn0 E{(u16*)(p.ws + WS_PROJ), (const float2*)(p.ws + WS_ROPE1)};
    pg::gemm_phase<true>(lds, 1024, S, E);
}
__device__ __forceinline__ void phase_inproj1(const Params& p, LAS unsigned char* lds, int bid, int nblk) {
    pg::DenseSched S; S.init(p.ws + WS_X1, p.ws + WS_WINO, 1024, 0, 132, 12, nblk, bid);
    EpiIn1 E{(u16*)(p.ws + WS_PROJ), (const float2*)(p.ws + WS_ROPE2), (unsigned*)(p.ws + WS_CTL) + CW_KMAX};
    pg::gemm_phase<false>(lds, 1024, S, E);
}
template <int L> __device__ __forceinline__ void phase_outproj(const Params& p, LAS unsigned char* lds, int bid, int nblk) {
    pg::DenseSched S; S.init(p.ws + WS_X1, p.ws + (L == 0 ? WS_WOUTE : WS_WOUTO), 1024, L == 0 ? 0 : 4, L == 0 ? 132 : 128, 4, nblk, bid);
    EpiOut<L> E{&p};
    pg::gemm_phase<true>(lds, 1024, S, E);
    __syncthreads();
    const int ngemm = (L == 0 ? 132 : 128) * 4, extra = ngemm % nblk;
    const int nconv = nblk - extra, cid = bid - extra;
    if (cid >= 0) { MoeJob jf{&p, L}; conv_stream(cid, nconv, MOE_CONV_UNITS, jf, lds); }
}

#define KSWZ(row, colB) ((row) * 256 + ((colB) ^ (((row) & 15) << 4)))
__device__ __forceinline__ int v_st(int k, int c) { const int kk = (k & ~0xC) | ((k & 4) << 1) | ((k & 8) >> 1); return ((kk >> 3) * 4 + (c >> 5)) * 512 + ((kk & 7) * 32 + (c & 31)) * 2; }
__device__ __forceinline__ int v_rd_base(int lane) { return ((lane & 3) << 3) | (((lane >> 2) & 3) << 6) | (((lane >> 4) & 1) << 5) | (((lane >> 5) & 1) << 8); }
__device__ __forceinline__ s16x4 tr_rd(const LAS unsigned char* a) { return __builtin_bit_cast(s16x4, __builtin_amdgcn_ds_read_tr16_b64_v4i16((LAS v4i16_t*)a)); }
__device__ __forceinline__ bf16x8 tr_frag(const LAS unsigned char* a, int d0, int ks) {
    const s16x4 l = tr_rd(a + d0 * 512 + ks * 4096), h = tr_rd(a + d0 * 512 + ks * 4096 + 2048);
    return (bf16x8){l[0], l[1], l[2], l[3], h[0], h[1], h[2], h[3]};
}
#define PK4(P, BASE, OUT) do { unsigned a0 = cvtpk(P[BASE + 0], P[BASE + 1]), a1 = cvtpk(P[BASE + 2], P[BASE + 3]);   \
    unsigned b0 = cvtpk(P[BASE + 4], P[BASE + 5]), b1 = cvtpk(P[BASE + 6], P[BASE + 7]);                              \
    auto r0 = __builtin_amdgcn_permlane32_swap(a0, b0, false, false); auto r1 = __builtin_amdgcn_permlane32_swap(a1, b1, false, false); \
    u32x4 w = {r0[0], r1[0], r0[1], r1[1]}; OUT = __builtin_bit_cast(bf16x8, w); } while (0)
__device__ __forceinline__ void pv_tile(f32x16 (&o)[4], const LAS unsigned char* vb, bf16x8 pa0, bf16x8 pa1, bf16x8 pa2, bf16x8 pa3) {
#pragma unroll
    for (int d0 = 0; d0 < 4; ++d0) {
        { const bf16x8 b0 = tr_frag(vb, d0, 0), b1 = tr_frag(vb, d0, 1);
          o[d0] = __builtin_amdgcn_mfma_f32_32x32x16_bf16(pa0, b0, o[d0], 0, 0, 0);
          o[d0] = __builtin_amdgcn_mfma_f32_32x32x16_bf16(pa1, b1, o[d0], 0, 0, 0); }
        { const bf16x8 b2 = tr_frag(vb, d0, 2), b3 = tr_frag(vb, d0, 3);
          o[d0] = __builtin_amdgcn_mfma_f32_32x32x16_bf16(pa2, b2, o[d0], 0, 0, 0);
          o[d0] = __builtin_amdgcn_mfma_f32_32x32x16_bf16(pa3, b3, o[d0], 0, 0, 0); }
    }
}
template <int OFF> __device__ __forceinline__ s16x4 tr_asm(unsigned vb) { s16x4 r; asm volatile("ds_read_b64_tr_b16 %0, %1 offset:%2" : "=&v"(r) : "v"(vb), "i"(OFF) : "memory"); return r; }
template <int G> __device__ __forceinline__ void pv_rd(unsigned vb, s16x4 (&r)[4]) {
    constexpr int B = (G >> 1) * 512 + (G & 1) * 8192;
    r[0] = tr_asm<B>(vb); r[1] = tr_asm<B + 2048>(vb); r[2] = tr_asm<B + 4096>(vb); r[3] = tr_asm<B + 6144>(vb);
}
#define PV_WAIT(N, R) asm volatile("s_waitcnt lgkmcnt(" #N ")" : "+v"(R[0]), "+v"(R[1]), "+v"(R[2]), "+v"(R[3]) :: "memory")
#define PKLH(L, H) (bf16x8){L[0], L[1], L[2], L[3], H[0], H[1], H[2], H[3]}
#define PV_MMA(G, R, PA, PB) do { o[(G) >> 1] = __builtin_amdgcn_mfma_f32_32x32x16_bf16(PA, PKLH(R[0], R[1]), o[(G) >> 1], 0, 0, 0); \
                                  o[(G) >> 1] = __builtin_amdgcn_mfma_f32_32x32x16_bf16(PB, PKLH(R[2], R[3]), o[(G) >> 1], 0, 0, 0); } while (0)
__device__ __forceinline__ void pv_tile_asm(f32x16 (&o)[4], unsigned vb, bf16x8 pa0, bf16x8 pa1, bf16x8 pa2, bf16x8 pa3) {
    s16x4 rA[4], rB[4], rC[4];
    pv_rd<0>(vb, rA); pv_rd<1>(vb, rB); pv_rd<2>(vb, rC);
    PV_WAIT(8, rA); PV_MMA(0, rA, pa0, pa1); pv_rd<3>(vb, rA);
    PV_WAIT(8, rB); PV_MMA(1, rB, pa2, pa3); pv_rd<4>(vb, rB);
    PV_WAIT(8, rC); PV_MMA(2, rC, pa0, pa1); pv_rd<5>(vb, rC);
    PV_WAIT(8, rA); PV_MMA(3, rA, pa2, pa3); pv_rd<6>(vb, rA);
    PV_WAIT(8, rB); PV_MMA(4, rB, pa0, pa1); pv_rd<7>(vb, rB);
    PV_WAIT(8, rC); PV_MMA(5, rC, pa2, pa3);
    PV_WAIT(4, rA); PV_MMA(6, rA, pa0, pa1);
    PV_WAIT(0, rB); PV_MMA(7, rB, pa2, pa3);
}
#undef PV_WAIT
#undef PV_MMA
#undef PKLH
template <bool SUFFIX, bool MAXOP> __device__ __forceinline__ float scan128(const LAS float* a, int t) {
    float acc = MAXOP ? -3.0e38f : 0.f;
#pragma unroll 4
    for (int r4 = 0; r4 < 32; ++r4) { const f32x4 v = *(const LAS f32x4*)(a + r4 * 4);
#pragma unroll
        for (int e = 0; e < 4; ++e) { const int r = r4 * 4 + e; const bool in = SUFFIX ? (r >= t) : (r <= t); if (MAXOP) acc = in ? fmaxf(acc, v[e]) : acc; else acc += in ? v[e] : 0.f; } }
    return acc;
}
constexpr int SC_ARR = 131072;

__device__ __forceinline__ void s1_unit(const Params& p, LAS unsigned char* lds, int u) {
    const int tid = threadIdx.x, wid = tid >> 6, lane = tid & 63, r32 = lane & 31, hi = lane >> 5;
    const int ch = u % NCH, t1 = u / NCH, h = t1 & 3, b = (t1 >> 2) & 3, mx = t1 >> 4;
    const int row0 = chunk_row0(b, ch);
    LAS unsigned char* KIMG = lds; LAS unsigned char* VF = lds + 32768; LAS unsigned char* VB = lds + 65536;
    LAS float* arr = (LAS float*)(lds + SC_ARR);
    LAS float *IF = arr, *IB = arr + 128, *FF = arr + 256, *FB = arr + 384, *WF = arr + 512, *WB = arr + 640, *SCL = arr + 768, *RED = arr + 1024;
    const u16* proj = (const u16*)(p.ws + WS_PROJ);
    const int kcol = (mx ? 2560 : 512) + h * 128, vcol = (mx ? 3072 : 1024) + h * 128;
    if (mx == 0) {
        if (tid < 128) { const float* g = (const float*)(p.ws + WS_GATES) + (size_t)(row0 + tid) * 16; IF[tid] = g[h]; IB[tid] = g[4 + h]; FF[tid] = g[8 + h]; FB[tid] = g[12 + h]; }
        __syncthreads();
        if (tid < 128) { const float bf = scan128<false, false>(FF, tid), bb = scan128<true, false>(FB, tid), Bf = scan128<false, false>(FF, 127), Bb = scan128<true, false>(FB, 0);
            float wlf = Bf - bf + IF[tid], wlb = Bb - bb + IB[tid];
            WF[tid] = wlf; WB[tid] = wlb;
            if (tid == 0) { SCL[0] = Bf; SCL[1] = Bb; } }
        __syncthreads();
        if (wid < 2) { LAS float* W = wid ? WB : WF; float m = wave_max(fmaxf(W[lane], W[lane + 64])); if (lane == 0) SCL[2 + wid] = m; }
        __syncthreads();
        const float af = SCL[2], ab = SCL[3];
        if (tid == 0) { float* st = (float*)(p.ws + WS_STATS); const int c0 = (b * 4 + h) * 2;
            st[((size_t)(c0 + 0) * NCH + ch) * 2 + 0] = SCL[0]; st[((size_t)(c0 + 0) * NCH + ch) * 2 + 1] = af;
            st[((size_t)(c0 + 1) * NCH + ch) * 2 + 0] = SCL[1]; st[((size_t)(c0 + 1) * NCH + ch) * 2 + 1] = ab; }
        __syncthreads();
        if (tid < 128) { float a = WF[tid], c = WB[tid]; WF[tid] = __expf(a - af); WB[tid] = __expf(c - ab); }
    } else {
        const float lgf = p.in[11][h], lgb = p.in[11][4 + h];
        if (tid < 128) { WF[tid] = __expf(lgf * (float)(127 - tid)); WB[tid] = __expf(lgb * (float)tid); }
    }
    __syncthreads();
#pragma unroll
    for (int i = 0; i < 4; ++i) { const int pi = tid + i * NTHR, s = pi >> 4, c8 = (pi & 15) * 8;
        const u16* rp = proj + (size_t)(row0 + s) * 4096;
        const u32x4 kv = *(const u32x4*)(rp + kcol + c8), vv = *(const u32x4*)(rp + vcol + c8);
        const int off = (s >> 6) * 16384 + v_st(s & 63, c8);
        *(LAS u32x4*)(KIMG + off) = kv;
        const float wf = WF[s], wb = WB[s]; u32x4 of, ob;
#pragma unroll
        for (int e = 0; e < 4; ++e) { float lo = bflo(vv[e]), hh = bfhi(vv[e]); of[e] = cvtpk(lo * wf, hh * wf); ob[e] = cvtpk(lo * wb, hh * wb); }
        *(LAS u32x4*)(VF + off) = of; *(LAS u32x4*)(VB + off) = ob; }
    __syncthreads();
    {   const int dir = wid >> 2, kblk = wid & 3; const int vrb = v_rd_base(lane);
        const LAS unsigned char* ka = KIMG + vrb; const LAS unsigned char* va = (dir ? VB : VF) + vrb;
        f32x16 acc[4] = {};
#pragma unroll
        for (int ks16 = 0; ks16 < 8; ++ks16) { const int tile = ks16 >> 2, ks = ks16 & 3;
            const bf16x8 a = tr_frag(ka + tile * 16384, kblk, ks);
#pragma unroll
            for (int d0 = 0; d0 < 4; ++d0) { const bf16x8 bb = tr_frag(va + tile * 16384, d0, ks); acc[d0] = __builtin_amdgcn_mfma_f32_32x32x16_bf16(a, bb, acc[d0], 0, 0, 0); } }
        const int chain = ((mx * 4 + b) * 4 + h) * 2 + dir;
        u16* base = (u16*)(p.ws + WS_STATES) + ((size_t)chain * NCH + ch) * 16384;
#pragma unroll
        for (int d0 = 0; d0 < 4; ++d0)
#pragma unroll
            for (int g = 0; g < 4; ++g) { u32x2 w = {cvtpk(acc[d0][4 * g], acc[d0][4 * g + 1]), cvtpk(acc[d0][4 * g + 2], acc[d0][4 * g + 3])};
                *(u32x2*)(base + (d0 * 32 + r32) * 128 + kblk * 32 + 8 * g + 4 * hi) = w; }
    }
    if (mx == 0) {
        const int dir = tid >> 8, k = tid & 127, half = (tid >> 7) & 1; LAS float* W = dir ? WB : WF; float s = 0;
#pragma unroll 16
        for (int i = 0; i < 64; ++i) { const int t = half * 64 + i; s += W[t] * bf2f(*(const LAS u16*)(KIMG + half * 16384 + v_st(i, k))); }
        RED[(dir * 2 + half) * 128 + k] = s;
        __syncthreads();
        if (half == 0) { const int chain = (b * 4 + h) * 2 + dir; ((float*)(p.ws + WS_NV))[((size_t)chain * NCH + ch) * 128 + k] = RED[(dir * 2) * 128 + k] + RED[(dir * 2 + 1) * 128 + k]; }
    }
    __syncthreads();
}

__device__ __forceinline__ int chain_chunk(int dir, int i) { return dir == 0 ? i : (i < 2 ? 1 - i : 67 - i); }

__device__ __forceinline__ void phase_s2(const Params& p, int bid, int nblk) {
    const float* st = (const float*)(p.ws + WS_STATS);
    for (int gid = bid * NTHR + threadIdx.x; gid < 64 * 2048; gid += nblk * NTHR) {
        const int chain = gid >> 11, v = (gid >> 4) & 127, kc = gid & 15, dir = chain & 1, mx = chain >> 5, h = (chain >> 1) & 3;
        u16* base = (u16*)(p.ws + WS_STATES) + (size_t)chain * NCH * 16384 + v * 128 + kc * 8;
        float c[8] = {0, 0, 0, 0, 0, 0, 0, 0}; float nvc[8] = {0, 0, 0, 0, 0, 0, 0, 0};
        float m = 0.f; const float rdec = mx ? __expf(128.f * p.in[11][dir * 4 + h]) : 1.f;
        const bool do_n = (mx == 0 && v == 0);
        for (int i0 = 0; i0 < NCH; i0 += 6) {
            u32x4 dd[6]; float Bv[6], av[6];
#pragma unroll
            for (int k = 0; k < 6; ++k) { const int ch = chain_chunk(dir, i0 + k); dd[k] = *(const u32x4*)(base + (size_t)ch * 16384);
                if (mx == 0) { Bv[k] = st[((size_t)chain * NCH + ch) * 2]; av[k] = st[((size_t)chain * NCH + ch) * 2 + 1]; } else { Bv[k] = 0.f; av[k] = 0.f; } }
#pragma unroll
            for (int k = 0; k < 6; ++k) {
                const int ch = chain_chunk(dir, i0 + k);
                float dec, sc;
                if (mx == 0) { const float mn = fmaxf(Bv[k] + m, av[k]); dec = __expf(Bv[k] + m - mn); sc = __expf(av[k] - mn);
                    if (v == 0 && kc == 0) ((float*)(p.ws + WS_MST))[(size_t)chain * NCH + ch] = m;
                    m = mn;
                } else { dec = rdec; sc = 1.f; }
                const u32x4 d = dd[k];
                *(u32x4*)(base + (size_t)ch * 16384) = (u32x4){cvtpk(c[0], c[1]), cvtpk(c[2], c[3]), cvtpk(c[4], c[5]), cvtpk(c[6], c[7])};
#pragma unroll
                for (int e = 0; e < 4; ++e) { c[2 * e] = dec * c[2 * e] + sc * bflo(d[e]); c[2 * e + 1] = dec * c[2 * e + 1] + sc * bfhi(d[e]); }
                if (do_n) { float* nq = (float*)(p.ws + WS_NV) + ((size_t)chain * NCH + ch) * 128 + kc * 8;
#pragma unroll
                    for (int e = 0; e < 8; ++e) { float dn = nq[e]; nq[e] = nvc[e]; nvc[e] = dec * nvc[e] + sc * dn; } }
            }
        }
    }
}

template <int NQ>
__device__ __forceinline__ void qkt_init(f32x16& p0, f32x16& p1, const LAS unsigned char* Ks, const bf16x8* qr, int r32, int hi, int colB0, const f32x16& ini) {
    {   const int cb = colB0 + (hi * 8) * 2;
        const bf16x8 b0 = *(const LAS bf16x8*)(Ks + KSWZ(r32, cb)), b1 = *(const LAS bf16x8*)(Ks + KSWZ(32 + r32, cb));
        p0 = __builtin_amdgcn_mfma_f32_32x32x16_bf16(b0, qr[0], ini, 0, 0, 0);
        p1 = __builtin_amdgcn_mfma_f32_32x32x16_bf16(b1, qr[0], ini, 0, 0, 0); }
#pragma unroll
    for (int d0 = 1; d0 < NQ; ++d0) { const int cb = colB0 + (d0 * 16 + hi * 8) * 2;
        const bf16x8 b0 = *(const LAS bf16x8*)(Ks + KSWZ(r32, cb)), b1 = *(const LAS bf16x8*)(Ks + KSWZ(32 + r32, cb));
        p0 = __builtin_amdgcn_mfma_f32_32x32x16_bf16(b0, qr[d0], p0, 0, 0, 0);
        p1 = __builtin_amdgcn_mfma_f32_32x32x16_bf16(b1, qr[d0], p1, 0, 0, 0); }
}
template <int NQ>
__device__ __forceinline__ void qkt(f32x16& p0, f32x16& p1, const LAS unsigned char* Ks, const bf16x8* qr, int r32, int hi, int colB0) {
    p0 = f32x16{}; p1 = f32x16{};
#pragma unroll
    for (int d0 = 0; d0 < NQ; ++d0) { const int cb = colB0 + (d0 * 16 + hi * 8) * 2;
        const bf16x8 b0 = *(const LAS bf16x8*)(Ks + KSWZ(r32, cb)), b1 = *(const LAS bf16x8*)(Ks + KSWZ(32 + r32, cb));
        p0 = __builtin_amdgcn_mfma_f32_32x32x16_bf16(b0, qr[d0], p0, 0, 0, 0);
        p1 = __builtin_amdgcn_mfma_f32_32x32x16_bf16(b1, qr[d0], p1, 0, 0, 0); }
}

__device__ __forceinline__ void s3_unit(const Params& p, LAS unsigned char* lds, int u) {
    const int tid = threadIdx.x, wid = tid >> 6, lane = tid & 63, r32 = lane & 31, hi = lane >> 5;
    const int ch = u % NCH, t1 = u / NCH, h = t1 & 3, b = (t1 >> 2) & 3, mx = t1 >> 4;
    const int row0 = chunk_row0(b, ch);
    LAS unsigned char* KT = lds; LAS unsigned char* VI = lds + 32768; LAS unsigned char* CT = lds + 65536;
    LAS float* arr = (LAS float*)(lds + SC_ARR);
    LAS float *U = arr, *MXA = arr + 256, *WI = arr + 512, *FL = arr + 768, *NVL = arr + 1024, *HS = arr + 1280  , *TMP = arr + 1536  ;
    const u16* proj = (const u16*)(p.ws + WS_PROJ);
    const int qcol = (mx ? 2048 : 0) + h * 128, kcol = qcol + 512, vcol = qcol + 1024, gcol = qcol + 1536;
    const int chain0 = ((mx * 4 + b) * 4 + h) * 2;
    if (mx == 0) {
        LAS float *IF = TMP, *IB = TMP + 128, *FF = TMP + 256, *FB = TMP + 384, *BF = TMP + 512, *BB = TMP + 640;
        if (tid < 128) { const float* g = (const float*)(p.ws + WS_GATES) + (size_t)(row0 + tid) * 16; IF[tid] = g[h]; IB[tid] = g[4 + h]; FF[tid] = g[8 + h]; FB[tid] = g[12 + h]; }
        if (tid >= 256) { const int d = (tid >> 7) & 1, k = tid & 127; NVL[d * 128 + k] = ((const float*)(p.ws + WS_NV))[((size_t)(chain0 - 0 + d) * NCH + ch) * 128 + k]; }
        __syncthreads();
        if (tid < 128) { const float bf = scan128<false, false>(FF, tid), bb = scan128<true, false>(FB, tid);
            BF[tid] = bf; BB[tid] = bb; U[tid] = IF[tid] - bf; U[128 + tid] = IB[tid] - bb; }
        __syncthreads();
        if (tid < 128) { const float pf = scan128<false, true>(U, tid), pb = scan128<true, true>(U + 128, tid);
            const float mf = ((const float*)(p.ws + WS_MST))[(size_t)chain0 * NCH + ch], mb = ((const float*)(p.ws + WS_MST))[(size_t)(chain0 + 1) * NCH + ch];
            const float Mf = fmaxf(mf, pf), Mb = fmaxf(mb, pb);
            MXA[tid] = Mf; MXA[128 + tid] = Mb; WI[tid] = __expf(mf - Mf); WI[128 + tid] = __expf(mb - Mb);
            FL[tid] = __expf(-(BF[tid] + Mf)); FL[128 + tid] = __expf(-(BB[tid] + Mb)); }
    } else {
        const float lgf = p.in[11][h], lgb = p.in[11][4 + h];
        if (tid < 128) { const float t = (float)tid; U[tid] = -lgf * t; MXA[tid] = -lgf * t; WI[tid] = __expf(lgf * (t + 1.f));
            U[128 + tid] = lgb * t; MXA[128 + tid] = lgb * t; WI[128 + tid] = __expf(lgb * (128.f - t)); FL[tid] = 0.f; FL[128 + tid] = 0.f; }
        if (tid >= 256) NVL[tid - 256] = 0.f;
    }
    const u16* cf = (const u16*)(p.ws + WS_STATES) + ((size_t)chain0 * NCH + ch) * 16384;
    const u16* cbp = (const u16*)(p.ws + WS_STATES) + ((size_t)(chain0 + 1) * NCH + ch) * 16384;
#pragma unroll
    for (int i = 0; i < 4; ++i) { const int pi = tid + i * NTHR, s = pi >> 4, c8 = (pi & 15) * 8;
        const u16* rp = proj + (size_t)(row0 + s) * 4096;
        *(LAS u32x4*)(KT + KSWZ(s, c8 * 2)) = *(const u32x4*)(rp + kcol + c8);
        *(LAS u32x4*)(VI + (s >> 6) * 16384 + v_st(s & 63, c8)) = *(const u32x4*)(rp + vcol + c8);
        *(LAS u32x4*)(CT + KSWZ(s, c8 * 2)) = *(const u32x4*)(cf + s * 128 + c8);
        *(LAS u32x4*)(CT + 32768 + KSWZ(s, c8 * 2)) = *(const u32x4*)(cbp + s * 128 + c8); }
    const int dir = wid >> 2, tb = wid & 3, t = tb * 32 + r32;
    bf16x8 qr[8];
    { const u16* qp = proj + (size_t)(row0 + t) * 4096 + qcol + hi * 8;
#pragma unroll
      for (int d0 = 0; d0 < 8; ++d0) qr[d0] = *(const bf16x8*)(qp + d0 * 16); }
    __syncthreads();
    f32x16 o[4] = {};
    {
        const LAS unsigned char* C = CT + dir * 32768;
#pragma unroll
        for (int dv = 0; dv < 4; ++dv)
#pragma unroll
            for (int d0 = 0; d0 < 8; ++d0) { const bf16x8 bb = *(const LAS bf16x8*)(C + KSWZ(dv * 32 + r32, (d0 * 16 + hi * 8) * 2)); o[dv] = __builtin_amdgcn_mfma_f32_32x32x16_bf16(qr[d0], bb, o[dv], 0, 0, 0); }
#pragma unroll
        for (int r = 0; r < 16; ++r) { const float w = WI[dir * 128 + tb * 32 + crow(r, hi)];
#pragma unroll
            for (int dv = 0; dv < 4; ++dv) o[dv][r] *= w; }
    }
    float qn = 0.f;
#pragma unroll
    for (int d0 = 0; d0 < 8; ++d0)
#pragma unroll
        for (int j = 0; j < 8; ++j) qn += bf2f((u16)qr[d0][j]) * NVL[dir * 128 + d0 * 16 + hi * 8 + j];
    qn = swap_add(qn);
    float rs = 0.f; const float Mt = MXA[dir * 128 + t];
    const int vrb = v_rd_base(lane);
#pragma unroll 1
    for (int kt = 0; kt < 2; ++kt) {
        f32x16 p0, p1; qkt<8>(p0, p1, KT + kt * 64 * 256, qr, r32, hi, 0);
#pragma unroll
        for (int r = 0; r < 16; ++r) { const int s0 = kt * 64 + crow(r, hi), s1 = s0 + 32;
            const bool v0 = dir ? (s0 >= t) : (s0 <= t), v1 = dir ? (s1 >= t) : (s1 <= t);
            const float f0 = v0 ? __builtin_amdgcn_exp2f((U[dir * 128 + s0] - Mt) * LOG2E) : 0.f, f1 = v1 ? __builtin_amdgcn_exp2f((U[dir * 128 + s1] - Mt) * LOG2E) : 0.f;
            p0[r] *= f0; p1[r] *= f1; rs += p0[r] + p1[r]; }
        bf16x8 pa0, pa1, pa2, pa3; PK4(p0, 0, pa0); PK4(p0, 8, pa1); PK4(p1, 0, pa2); PK4(p1, 8, pa3);
        pv_tile(o, VI + kt * 16384 + vrb, pa0, pa1, pa2, pa3);
    }
    rs = swap_add(rs);
    if (mx == 0) { const float den = rs + WI[dir * 128 + t] * qn; const float hs = 1.f / fmaxf(fabsf(den), FL[dir * 128 + t]);
        if (hi == 0) HS[wid * 32 + r32] = hs;
        WAIT_L(0);
#pragma unroll
        for (int r = 0; r < 16; ++r) { const float s = HS[wid * 32 + crow(r, hi)];
#pragma unroll
            for (int dv = 0; dv < 4; ++dv) o[dv][r] *= s; } }
    __syncthreads();
    LAS float* T = (LAS float*)lds;
    if (dir == 1) {
#pragma unroll
        for (int dv = 0; dv < 4; ++dv)
#pragma unroll
            for (int r = 0; r < 16; ++r) T[(tb * 32 + crow(r, hi)) * 132 + dv * 32 + r32] = o[dv][r]; }
    __syncthreads();
    if (dir == 0) {
#pragma unroll
        for (int dv = 0; dv < 4; ++dv)
#pragma unroll
            for (int r = 0; r < 16; ++r) T[(tb * 32 + crow(r, hi)) * 132 + dv * 32 + r32] += o[dv][r]; }
    __syncthreads();
    {
        const int tt = tid >> 2, sg = tid & 3, row = row0 + tt;
        const float* G = (mx ? p.in[12] : p.in[10]) + h * 128 + sg * 32;
        const u16* gp = proj + (size_t)row * 4096 + gcol + sg * 32;
        u32x4 gw[4];
#pragma unroll
        for (int i = 0; i < 4; ++i) gw[i] = *(const u32x4*)(gp + i * 8);
        float x[32], s1 = 0.f, s2 = 0.f;
#pragma unroll
        for (int i = 0; i < 8; ++i) { const f32x4 v = *(const LAS f32x4*)(T + tt * 132 + sg * 32 + i * 4); x[4 * i] = v[0]; x[4 * i + 1] = v[1]; x[4 * i + 2] = v[2]; x[4 * i + 3] = v[3]; }
        float gt[32];
#pragma unroll
        for (int i = 0; i < 4; ++i)
#pragma unroll
            for (int e = 0; e < 4; ++e) { gt[i * 8 + 2 * e] = bflo(gw[i][e]); gt[i * 8 + 2 * e + 1] = bfhi(gw[i][e]); }
#pragma unroll
        for (int i = 0; i < 32; ++i) { if (mx == 0) x[i] *= gt[i]; s1 += x[i]; s2 += x[i] * x[i]; }
        s1 += dpp_f<0xB1>(s1); s1 += dpp_f<0x4E>(s1); s2 += dpp_f<0xB1>(s2); s2 += dpp_f<0x4E>(s2);
        const float mu = s1 * (1.f / 128.f), var = fmaxf(s2 * (1.f / 128.f) - mu * mu, 0.f), rstd = rsqrtf(var + EPS);
        u16* op = (u16*)(p.ws + WS_X1) + (size_t)row * 1024 + mx * 512 + h * 128 + sg * 32;
#pragma unroll
        for (int i = 0; i < 4; ++i) { const f32x4 g0 = *(const f32x4*)(G + i * 8), g1 = *(const f32x4*)(G + i * 8 + 4); float y[8];
#pragma unroll
            for (int e = 0; e < 8; ++e) { y[e] = (x[i * 8 + e] - mu) * rstd * (e < 4 ? g0[e] : g1[e - 4]); if (mx) y[e] *= gt[i * 8 + e]; }
            *(u32x4*)(op + i * 8) = (u32x4){cvtpk(y[0], y[1]), cvtpk(y[2], y[3]), cvtpk(y[4], y[5]), cvtpk(y[6], y[7])}; }
    }
    __syncthreads();
}

constexpr int R_WT = 0;
constexpr int R_PITCH = 1028;
constexpr int MOE_ARR = 148480;
__device__ __forceinline__ void reduce36(float (&a)[36], float (&t)[9]) {
    float s[18];
#pragma unroll
    for (int j = 0; j < 18; ++j) { auto rr = __builtin_amdgcn_permlane32_swap(__float_as_uint(a[j]), __float_as_uint(a[j + 18]), false, false); s[j] = __uint_as_float(rr[0]) + __uint_as_float(rr[1]); }
#pragma unroll
    for (int j = 0; j < 9; ++j) { auto rr = __builtin_amdgcn_permlane16_swap(__float_as_uint(s[j]), __float_as_uint(s[j + 9]), false, false); t[j] = row_sum16(__uint_as_float(rr[0]) + __uint_as_float(rr[1])); }
}
template <int L>
__device__ __forceinline__ void route_row(const Params& p, const LAS float* lg, int r, int slot, LAS int* LCNT, LAS int* SLOT, int lane) {
    const float g0 = lg[0], g1 = lg[1], g2 = lg[2], g3 = lg[3];
    int grp = 0; float gm = g0; if (g1 > gm) { gm = g1; grp = 1; } if (g2 > gm) { gm = g2; grp = 2; } if (g3 > gm) { gm = g3; grp = 3; }
    const float pg = 1.f / (__expf(g0 - gm) + __expf(g1 - gm) + __expf(g2 - gm) + __expf(g3 - gm));
    int i0 = 0, i1 = -1; float m0 = -3.0e38f, m1 = -3.0e38f;
#pragma unroll
    for (int j = 0; j < 8; ++j) { const float v = lg[4 + grp * 8 + j];
        if (v > m0) { m1 = m0; i1 = i0; m0 = v; i0 = j; } else if (v > m1) { m1 = v; i1 = j; } }
    const float e1 = __expf(m1 - m0), den = 1.f / (1.f + e1);
    const float w0 = pg * den, w1 = pg * e1 * den;
    if (lane == 0) { const int ea = grp * 8 + i0, eb = grp * 8 + i1;
        const int la = (int)__hip_atomic_fetch_add((LAS unsigned*)&LCNT[ea], 1u, __ATOMIC_RELAXED, __HIP_MEMORY_SCOPE_WORKGROUP), lb = (int)__hip_atomic_fetch_add((LAS unsigned*)&LCNT[eb], 1u, __ATOMIC_RELAXED, __HIP_MEMORY_SCOPE_WORKGROUP);
        LAS int* sl = SLOT + slot * 4; sl[0] = ea; sl[1] = eb; sl[2] = la; sl[3] = lb;
        int* asge = (int*)(p.ws + WS_ASGE); float* asgg = (float*)(p.ws + WS_ASGG);
        asge[2 * r] = ea; asge[2 * r + 1] = eb; asgg[2 * r] = w0; asgg[2 * r + 1] = w1; }
}
template <int L>
__device__ __forceinline__ void phase_router(const Params& p, LAS unsigned char* lds, int bid, int nblk) {
    const int tid = threadIdx.x, wid = tid >> 6, lane = tid & 63;
    LAS float* wt = (LAS float*)(lds + R_WT);
    for (int i = tid; i < 4 * 1024; i += NTHR) { const int k = i >> 2, j = i & 3; wt[j * R_PITCH + k] = p.in[18][(size_t)L * 4096 + i]; }
    for (int i = tid; i < 32 * 1024; i += NTHR) { const int k = i >> 5, j = i & 31; wt[(4 + j) * R_PITCH + k] = p.in[20][(size_t)L * 32768 + i]; }
    const float* mod = (const float*)(p.ws + WS_MOD);
    unsigned* cnt = (unsigned*)(p.ws + WS_CTL) + CW_CNT + L * 64;
    int* asgr = (int*)(p.ws + WS_ASGR); int* list = (int*)(p.ws + WS_LIST);
    LAS int* LCNT = (LAS int*)(lds + MOE_ARR); LAS int* LBASE = LCNT + 32; LAS int* SLOT = LCNT + 64;
    LAS float* LG = (LAS float*)(lds + MOE_ARR + 4096) + wid * 80;
    if (tid < 32) LCNT[tid] = 0;
    __syncthreads();
    const int base = (L == 0 ? 0 : NCTX), nr = NROW - base, gwv = bid * 8 + __builtin_amdgcn_readfirstlane(wid), nwv = nblk * 8;
    const int rs = base + (int)(((long)gwv * nr) / nwv), re = base + (int)(((long)(gwv + 1) * nr) / nwv);
    float bias_q[9];
    const int qperm = ((lane >> 4) == 1) ? 2 : ((lane >> 4) == 2) ? 1 : (lane >> 4);
#pragma unroll
    for (int g = 0; g < 9; ++g) { const int lgi = 4 * g + qperm; bias_q[g] = lgi < 4 ? p.in[19][L * 4 + lgi] : p.in[21][L * 32 + lgi - 4]; }
    AdaC ac; int curmv = -1;
    f32x4 xa[4], xb[4], xc[4];
    if (rs < re) load_row(h_row(p, rs), lane, xa);
    if (rs + 1 < re) load_row(h_row(p, rs + 1), lane, xb);
#define R_DOT(j, x) ({ float s_ = 0.f; _Pragma("unroll") for (int i = 0; i < 4; ++i) { const f32x4 w = *(const LAS f32x4*)(wt + (j) * R_PITCH + i * 256 + lane * 4); \
        s_ += x[i][0] * w[0] + x[i][1] * w[1] + x[i][2] * w[2] + x[i][3] * w[3]; } s_; })
#define R_STEP(R, x, PF) do { const int r = (R); if (r + 2 < re) load_row(h_row(p, r + 2), lane, PF); \
        const int mv = row_modvec(r); \
        if (mv != curmv) { const float* m = mod + (size_t)(L * 5 + mv) * 6144; adac_load(ac, p.in[7] + L * 1024, m + 3 * 1024, m + 4 * 1024, lane); curmv = mv; } \
        { const float rstd = row_rstd(x); adaln_apply(x, rstd, ac); store_row_bf16((u16*)(p.ws + WS_X1) + (size_t)r * D, lane, x); } \
        _Pragma("unroll") for (int g = 0; g < 9; ++g) { \
            const float a0 = R_DOT(4 * g, x), a1 = R_DOT(4 * g + 1, x), a2 = R_DOT(4 * g + 2, x), a3 = R_DOT(4 * g + 3, x); \
            auto r01 = __builtin_amdgcn_permlane32_swap(__float_as_uint(a0), __float_as_uint(a1), false, false); const float s01 = __uint_as_float(r01[0]) + __uint_as_float(r01[1]); \
            auto r23 = __builtin_amdgcn_permlane32_swap(__float_as_uint(a2), __float_as_uint(a3), false, false); const float s23 = __uint_as_float(r23[0]) + __uint_as_float(r23[1]); \
            auto rq = __builtin_amdgcn_permlane16_swap(__float_as_uint(s01), __float_as_uint(s23), false, false); const float tg = row_sum16(__uint_as_float(rq[0]) + __uint_as_float(rq[1])); \
            if ((lane & 15) == 0) LG[4 * g + qperm] = tg + bias_q[g]; if (g % 3 == 2) SBAR(); } \
        route_row<L>(p, LG, r, (r - rs) * 8 + wid, LCNT, SLOT, lane); } while (0)
    for (int r0 = rs; r0 < re; r0 += 3) {
        R_STEP(r0, xa, xc);
        if (r0 + 1 < re) R_STEP(r0 + 1, xb, xa);
        if (r0 + 2 < re) R_STEP(r0 + 2, xc, xb);
    }
#undef R_STEP
#undef R_DOT
    __syncthreads();
    if (tid < 32) { const unsigned n = (unsigned)LCNT[tid]; LBASE[tid] = n ? (int)atomicAdd(&cnt[tid], n) : 0; }
    __syncthreads();
    for (int r = rs; r < re; ++r) if (lane < 2) {
        const LAS int* sl = SLOT + ((r - rs) * 8 + wid) * 4; const int e = sl[lane], rank = LBASE[e] + sl[2 + lane];
        list[(size_t)e * NROW + rank] = r; asgr[2 * r + lane] = rank; }
}
__device__ __forceinline__ void moe_tables(const Params& p, LAS unsigned char* lds, int L) {
    LAS int* CNT = (LAS int*)(lds + MOE_ARR); LAS int* OFF = CNT + 32; LAS int* TIL = CNT + 64;
    if (threadIdx.x < 32) CNT[threadIdx.x] = (int)xb_ld((unsigned*)(p.ws + WS_CTL) + CW_CNT + L * 64 + threadIdx.x);
    __syncthreads();
    if (threadIdx.x == 0) { int o = 0, t = 0; for (int e = 0; e < 32; ++e) { OFF[e] = o; TIL[e] = t; o += CNT[e]; t += (CNT[e] + 255) >> 8; } TIL[32] = t; }
    __syncthreads();
}
__device__ __forceinline__ int find_expert(const LAS int* TIL, int tile) { int e = 0;
#pragma unroll
    for (int j = 1; j < 32; ++j) e += (TIL[j] <= tile) ? 1 : 0;
    return e; }
__device__ __forceinline__ void phase_up(const Params& p, LAS unsigned char* lds, int bid, int nblk, int L) {
    moe_tables(p, lds, L);
    LAS int* CNT = (LAS int*)(lds + MOE_ARR); LAS int* OFF = CNT + 32; LAS int* TIL = CNT + 64;
    pg::MoeSched<true> S; S.A = (const char*)(p.ws + WS_X1); S.Bt = (const char*)(p.ws + WS_W13); S.CNT = CNT; S.OFF = OFF; S.TIL = TIL; S.list = (const int*)(p.ws + WS_LIST);
    S.RIDX = CNT + 128; S.nwg = __builtin_amdgcn_readfirstlane(TIL[32]) * 4; S.G = nblk; S.c = bid; S.K = 1024; S.fallback = (L == 0 ? 0 : NCTX);
    EpiUp E{(u16*)(p.ws + WS_H), OFF};
    pg::gemm_phase<true>(lds, 1024, S, E);
}
__device__ __forceinline__ void phase_down(const Params& p, LAS unsigned char* lds, int bid, int nblk, int L) {
    moe_tables(p, lds, L);
    LAS int* CNT = (LAS int*)(lds + MOE_ARR); LAS int* OFF = CNT + 32; LAS int* TIL = CNT + 64;
    pg::MoeSched<false> S; S.A = (const char*)(p.ws + WS_H); S.Bt = (const char*)(p.ws + WS_W2); S.CNT = CNT; S.OFF = OFF; S.TIL = TIL; S.list = nullptr;
    S.RIDX = CNT + 128; S.nwg = __builtin_amdgcn_readfirstlane(TIL[32]) * 4; S.G = nblk; S.c = bid; S.K = 512; S.fallback = 0;
    EpiDown E{(u16*)(p.ws + WS_YB), OFF};
    pg::gemm_phase<true>(lds, 512, S, E);
}
template <int L>
__device__ __forceinline__ void phase_combine(const Params& p, LAS unsigned char* lds, int bid, int nblk) {
    moe_tables(p, lds, L);
    LAS int* OFF = (LAS int*)(lds + MOE_ARR) + 32;
    const int tid = threadIdx.x, wid = tid >> 6, lane = tid & 63;
    const float* mod = (const float*)(p.ws + WS_MOD);
    const int* asge = (const int*)(p.ws + WS_ASGE); const int* asgr = (const int*)(p.ws + WS_ASGR); const float* asgg = (const float*)(p.ws + WS_ASGG);
    const u16* yb = (const u16*)(p.ws + WS_YB);
    const int r0 = (L == 0 ? 0 : NCTX) + bid * 8 + wid, stride = nblk * 8;
    f32x4 x[4]; u32x2 ya[4], yq[4]; float ga = 0.f, gb = 0.f;
#define C_LOAD(rr, X, YA, YQ, GA, GB) do { load_row(h_row(p, rr), lane, X); const int ea_ = asge[2 * (rr)], eb_ = asge[2 * (rr) + 1]; GA = asgg[2 * (rr)]; GB = asgg[2 * (rr) + 1]; \
        const u16* pa_ = yb + (size_t)(OFF[ea_] + asgr[2 * (rr)]) * 1024 + lane * 4; const u16* pb_ = yb + (size_t)(OFF[eb_] + asgr[2 * (rr) + 1]) * 1024 + lane * 4; \
        _Pragma("unroll") for (int i = 0; i < 4; ++i) { YA[i] = *(const u32x2*)(pa_ + i * 256); YQ[i] = *(const u32x2*)(pb_ + i * 256); } } while (0)
    if (r0 < NROW) C_LOAD(r0, x, ya, yq, ga, gb);
    for (int r = r0; r < NROW; r += stride) {
        float* hp = h_row(p, r);
        const float* m = mod + (size_t)(L * 5 + row_modvec(r)) * 6144;
        f32x4 g2[4]; AdaC ac;
#pragma unroll
        for (int i = 0; i < 4; ++i) g2[i] = *(const f32x4*)(m + 5 * 1024 + i * 256 + lane * 4);
        if (L == 0) { const float* m1 = mod + (size_t)(1 * 5 + row_modvec(r)) * 6144; adac_load(ac, p.in[6] + 1024, m1, m1 + 1024, lane); }
        else {
#pragma unroll
            for (int i = 0; i < 4; ++i) ac.g[i] = *(const f32x4*)(p.in[25] + i * 256 + lane * 4); }
        SBAR();
        const int rn = r + stride; f32x4 nx[4]; u32x2 nya[4], nyq[4]; float nga = 0.f, ngb = 0.f;
        if (rn < NROW) C_LOAD(rn, nx, nya, nyq, nga, ngb);
        SBAR();
#pragma unroll
        for (int i = 0; i < 4; ++i) { const u32x2 a = ya[i], bq = yq[i]; const f32x4 g = g2[i];
            x[i][0] += g[0] * (ga * bflo(a[0]) + gb * bflo(bq[0])); x[i][1] += g[1] * (ga * bfhi(a[0]) + gb * bfhi(bq[0]));
            x[i][2] += g[2] * (ga * bflo(a[1]) + gb * bflo(bq[1])); x[i][3] += g[3] * (ga * bfhi(a[1]) + gb * bfhi(bq[1])); }
        const float rstd = row_rstd(x);
        if (L == 0) {
#pragma unroll
            for (int i = 0; i < 4; ++i) *(f32x4*)(hp + i * 256 + lane * 4) = x[i];
            adaln_apply(x, rstd, ac);
            store_row_bf16((u16*)(p.ws + WS_X1) + (size_t)r * D, lane, x);
        } else {
#pragma unroll
            for (int i = 0; i < 4; ++i) { const f32x4 g = ac.g[i]; f32x4 y = {x[i][0] * rstd * g[0], x[i][1] * rstd * g[1], x[i][2] * rstd * g[2], x[i][3] * rstd * g[3]}; *(f32x4*)(hp + i * 256 + lane * 4) = y; }
        }
        if (rn < NROW) { ga = nga; gb = ngb;
#pragma unroll
            for (int i = 0; i < 4; ++i) { x[i] = nx[i]; ya[i] = nya[i]; yq[i] = nyq[i]; } }
    }
#undef C_LOAD
}

constexpr int A_SHM_V = 16384, A_SHM_K = 16384;
constexpr float A_SCALE = 0.125f, A_THR = 8.f;
__device__ __forceinline__ void smA(f32x16& p0, f32x16& p1, float mC) {
#pragma unroll
    for (int r = 0; r < 16; ++r) p0[r] = __builtin_amdgcn_exp2f(p0[r]);
}
__device__ __forceinline__ void smB(f32x16& p0, f32x16& p1, float& l_reg, bf16x8& pa0, bf16x8& pa1, bf16x8& pa2, bf16x8& pa3) {
#pragma unroll
    for (int r = 0; r < 16; ++r) p1[r] = __builtin_amdgcn_exp2f(p1[r]);
    float ps = 0;
#pragma unroll
    for (int r = 0; r < 16; ++r) ps += p0[r];
#pragma unroll
    for (int r = 0; r < 16; ++r) ps += p1[r];
    l_reg += ps;
    PK4(p0, 0, pa0); PK4(p0, 8, pa1); PK4(p1, 0, pa2); PK4(p1, 8, pa3);
}
__device__ __forceinline__ void attn_unit(const Params& p, LAS unsigned char* lds, int u, float lam) {
    int tz0 = threadIdx.x; asm volatile("" : "+v"(tz0));
    const int tid = tz0, wid = __builtin_amdgcn_readfirstlane(tid >> 6), lane = tid & 63, r32 = lane & 31, hi = lane >> 5;
    const int qt = u & 63, h = (u >> 6) & 7, b = u >> 9, map = wid >> 2, tb = wid & 3;
    unsigned long long wsb = (unsigned long long)(p.ws + WS_PROJ); asm volatile("" : "+s"(wsb));
    const u16* proj = (const u16*)wsb;
    LAS float* li_l = (LAS float*)(lds + 131072) + wid * 64;
    const int qrow0 = NCTX + b * SEQ + qt * 128;
    float l_reg = 0; f32x16 o[4] = {}; bf16x8 qr[4];
    { const u16* qp = proj + (size_t)(qrow0 + tb * 32 + r32) * 3072 + h * 128 + map * 64 + hi * 8;
#pragma unroll
      for (int d0 = 0; d0 < 4; ++d0) qr[d0] = *(const bf16x8*)(qp + d0 * 16); }
    float mC;
    {   float qn2 = 0.f;
#pragma unroll
        for (int d0 = 0; d0 < 4; ++d0)
#pragma unroll
            for (int j = 0; j < 8; ++j) { const float x = bf2f((u16)qr[d0][j]); qn2 += x * x; }
        qn2 = swap32_add(qn2);
        unsigned* km = (unsigned*)(p.ws + WS_CTL) + CW_KMAX + (b * 8 + h) * 4 + map * 2;
        const float kb2 = __uint_as_float(xb_ld(km)) + __uint_as_float(xb_ld(km + 1));
        mC = sqrtf(qn2 * kb2) * (1.02f * A_SCALE * LOG2E);
#pragma unroll
        for (int d0 = 0; d0 < 4; ++d0) { u32x4 w = __builtin_bit_cast(u32x4, qr[d0]);
#pragma unroll
            for (int e = 0; e < 4; ++e) w[e] = cvtpk(bflo(w[e]) * (A_SCALE * LOG2E), bfhi(w[e]) * (A_SCALE * LOG2E));
            qr[d0] = __builtin_bit_cast(bf16x8, w); } }
    f32x16 negm;
#pragma unroll
    for (int r = 0; r < 16; ++r) negm[r] = -mC;
    constexpr int A_SLOT = 32768, NT = 132;
    const unsigned vrd = (unsigned)(unsigned long long)(lds + v_rd_base(lane));
    const int kcb = map * 128;
    unsigned koff0, voff0;
    {   const int P0 = tid;
        { const int row = P0 >> 4, c = ((P0 & 15) ^ (row & 15)) * 8; koff0 = (unsigned)(row * 3072 + 1024 + h * 128 + c); }
        { const int sub = P0 >> 5, kk = (sub >> 2) * 8 + ((P0 >> 2) & 7), c = (sub & 3) * 32 + (P0 & 3) * 8, k = (kk & ~0xC) | ((kk & 4) << 1) | ((kk & 8) >> 1); voff0 = (unsigned)(k * 3072 + 2048 + h * 128 + c); } }
#define KROW(j) ((j) < 4 ? b * 256 + (j) * 64 : NCTX + b * SEQ + ((j) - 4) * 64)
#define ADMA(j) do { const u16* g_ = proj + (size_t)KROW(j) * 3072; LAS unsigned char* s_ = lds + ((j) & 3) * A_SLOT + wid * 1024; \
        glds16(g_ + voff0, s_); glds16(g_ + voff0 + 32 * 3072, s_ + 8192); glds16(g_ + koff0, s_ + 16384); glds16(g_ + koff0 + 32 * 3072, s_ + 16384 + 8192); } while (0)
#define A_WAITBAR(N) do { asm volatile("s_waitcnt vmcnt(" #N ") lgkmcnt(0)" ::: "memory"); BAR(); } while (0)
#define A_ITER(j, PC0, PC1, PP0, PP1, N, DMA) do { A_WAITBAR(N); if (DMA) ADMA((j) + 2); SBAR(); \
        qkt_init<4>(PC0, PC1, lds + ((j) & 3) * A_SLOT + 16384, qr, r32, hi, kcb, negm); \
        smB(PP0, PP1, l_reg, pa0, pa1, pa2, pa3); SBAR(); \
        pv_tile_asm(o, vrd + (((j) - 1) & 3) * A_SLOT, pa0, pa1, pa2, pa3); \
        smA(PC0, PC1, mC); SBAR(); } while (0)
    f32x16 pA0, pA1, pB0, pB1; bf16x8 pa0, pa1, pa2, pa3;
    ADMA(0); ADMA(1);
    A_WAITBAR(4); ADMA(2);
    qkt_init<4>(pA0, pA1, lds + 16384, qr, r32, hi, kcb, negm); smA(pA0, pA1, mC);
    for (int j0 = 1; j0 < NT - 1; j0 += 2) {
        A_ITER(j0, pB0, pB1, pA0, pA1, 4, (j0 + 2 < NT)); A_ITER(j0 + 1, pA0, pA1, pB0, pB1, 4, (j0 + 3 < NT));
    }
    A_ITER(NT - 1, pB0, pB1, pA0, pA1, 0, false);
    smB(pB0, pB1, l_reg, pa0, pa1, pa2, pa3);
    pv_tile_asm(o, vrd + ((NT - 1) & 3) * A_SLOT, pa0, pa1, pa2, pa3);
    l_reg = swap32_add(l_reg);
    asm volatile("" : "+v"(tz0));
    const int lane_e = tz0 & 63, r32e = lane_e & 31, hie = lane_e >> 5;
    if (hie == 0) li_l[r32e] = l_reg; WAIT_L(0);
#pragma unroll
    for (int r = 0; r < 16; ++r) { const float rl = __builtin_amdgcn_rcpf(li_l[crow(r, hie)]);
#pragma unroll
        for (int d = 0; d < 4; ++d) o[d][r] *= rl; }
    __syncthreads();
    LAS float* EX = (LAS float*)lds;
    if (map == 1) {
#pragma unroll
        for (int d = 0; d < 4; ++d)
#pragma unroll
            for (int r = 0; r < 16; ++r) EX[((tb * 4 + d) * 16 + r) * 64 + lane_e] = o[d][r]; }
    __syncthreads();
    if (map == 0) {
        const float* G = p.in[16] + h * 128; float gv[4];
#pragma unroll
        for (int d = 0; d < 4; ++d) gv[d] = G[d * 32 + r32e] * (1.f - LAM_INIT);
#pragma unroll
        for (int r = 0; r < 16; ++r) { float x[4], s2 = 0.f;
#pragma unroll
            for (int d = 0; d < 4; ++d) { x[d] = o[d][r] - lam * EX[((tb * 4 + d) * 16 + r) * 64 + lane_e]; s2 += x[d] * x[d]; }
            s2 = half_sum(s2); const float rstd = rsqrtf(s2 * (1.f / 128.f) + EPS);
            u16* op = (u16*)(p.ws + WS_X1) + (size_t)(qrow0 + tb * 32 + crow(r, hie)) * 1024 + h * 128 + r32e;
#pragma unroll
            for (int d = 0; d < 4; ++d) op[d * 32] = f2bf(x[d] * rstd * gv[d]); }
    }
    __syncthreads();
#undef KROW
#undef ADMA
#undef A_WAITBAR
#undef A_ITER
}

constexpr int NPH = 18;
__global__ void __launch_bounds__(NTHR, 2) mega(Params p, int ph_lo, int ph_hi) {
    extern __shared__ __attribute__((aligned(16))) unsigned char smem_[];
    LAS unsigned char* lds = (LAS unsigned char*)smem_;
    const int bid = blockIdx.x, nblk = gridDim.x, tid = threadIdx.x;
    volatile LAS unsigned* xbw = (volatile LAS unsigned*)(lds + LDS_MISC);
    if (tid < 4) xbw[tid] = 0u;
    __syncthreads();
    XcdBarrier bar; bar.bar = (unsigned*)(p.ws + WS_CTL) + CW_BAR; bar.x = 0; bar.st = xbw;
    if (ph_hi - ph_lo > 1) bar = xcd_barrier_post((unsigned*)(p.ws + WS_CTL) + CW_BAR, xbw);
#ifndef PHMASK
#define PHMASK 0x3ffff
#endif
#define IN(k) (((PHMASK >> (k)) & 1) && ph_lo <= (k) && (k) < ph_hi)
#define SEAM(k) do { if (IN(k) && IN((k) + 1)) xcd_barrier(bar); } while (0)
#ifndef REPMASK
#define REPMASK 0
#endif
#define NREP(k) (1 + ((REPMASK >> (k)) & 1))
    if (IN(0)) for (int rep_ = 0; rep_ < NREP(0); ++rep_) { if (rep_) xcd_barrier(bar); phase0(p, lds, bid, nblk); } SEAM(0);
    if (IN(1)) for (int rep_ = 0; rep_ < NREP(1); ++rep_) { if (rep_) xcd_barrier(bar); phase1(p, lds, bid, nblk); } SEAM(1);
    if (IN(2)) for (int rep_ = 0; rep_ < NREP(2); ++rep_) { if (rep_) xcd_barrier(bar); phase2(p, lds, bid, nblk); } SEAM(2);
    if (IN(3)) for (int rep_ = 0; rep_ < NREP(3); ++rep_) { if (rep_) xcd_barrier(bar); for (int u = bid; u < 2 * 16 * NCH; u += nblk) s1_unit(p, lds, u); } SEAM(3);
    if (IN(4)) for (int rep_ = 0; rep_ < NREP(4); ++rep_) { if (rep_) xcd_barrier(bar); phase_s2(p, bid, nblk); } SEAM(4);
    if (IN(5)) for (int rep_ = 0; rep_ < NREP(5); ++rep_) { if (rep_) xcd_barrier(bar); for (int u = bid; u < 2 * 16 * NCH; u += nblk) s3_unit(p, lds, u); } SEAM(5);
    if (IN(6)) for (int rep_ = 0; rep_ < NREP(6); ++rep_) { if (rep_) xcd_barrier(bar); phase_outproj<0>(p, lds, bid, nblk); } SEAM(6);
    if (IN(7)) for (int rep_ = 0; rep_ < NREP(7); ++rep_) { if (rep_) xcd_barrier(bar); phase_router<0>(p, lds, bid, nblk); } SEAM(7);
    if (IN(8)) for (int rep_ = 0; rep_ < NREP(8); ++rep_) { if (rep_) xcd_barrier(bar); phase_up(p, lds, bid, nblk, 0); } SEAM(8);
    if (IN(9)) for (int rep_ = 0; rep_ < NREP(9); ++rep_) { if (rep_) xcd_barrier(bar); phase_down(p, lds, bid, nblk, 0); } SEAM(9);
    if (IN(10)) for (int rep_ = 0; rep_ < NREP(10); ++rep_) { if (rep_) xcd_barrier(bar); phase_combine<0>(p, lds, bid, nblk); } SEAM(10);
    if (IN(11)) for (int rep_ = 0; rep_ < NREP(11); ++rep_) { if (rep_) xcd_barrier(bar); phase_inproj1(p, lds, bid, nblk); } SEAM(11);
    if (IN(12)) for (int rep_ = 0; rep_ < NREP(12); ++rep_) { if (rep_) xcd_barrier(bar);
        float lam;
        { const float* lp = p.in[15]; float a = 0, c = 0; for (int i = 0; i < 64; ++i) { a += lp[i] * lp[64 + i]; c += lp[128 + i] * lp[192 + i]; } lam = __builtin_bit_cast(float, __builtin_amdgcn_readfirstlane(__builtin_bit_cast(int, __expf(a) - __expf(c) + LAM_INIT))); }
        if (nblk == 256) { const int xg = bid & 7, sl = bid >> 3;
            for (int k = 0; k < 8; ++k) attn_unit(p, lds, ((xg + 8 * (k >> 1)) << 6) | (sl + 32 * (k & 1)), lam); }
        else for (int u = bid; u < NB * 8 * 64; u += nblk) attn_unit(p, lds, u, lam);
    } SEAM(12);
    if (IN(13)) for (int rep_ = 0; rep_ < NREP(13); ++rep_) { if (rep_) xcd_barrier(bar); phase_outproj<1>(p, lds, bid, nblk); } SEAM(13);
    if (IN(14)) for (int rep_ = 0; rep_ < NREP(14); ++rep_) { if (rep_) xcd_barrier(bar); phase_router<1>(p, lds, bid, nblk); } SEAM(14);
    if (IN(15)) for (int rep_ = 0; rep_ < NREP(15); ++rep_) { if (rep_) xcd_barrier(bar); phase_up(p, lds, bid, nblk, 1); } SEAM(15);
    if (IN(16)) for (int rep_ = 0; rep_ < NREP(16); ++rep_) { if (rep_) xcd_barrier(bar); phase_down(p, lds, bid, nblk, 1); } SEAM(16);
    if (IN(17)) { phase_combine<1>(p, lds, bid, nblk); }
}

extern "C" void kernel_launch(void* const* d_in, const int* in_sizes, int n_in, void* d_out, int out_size, void* d_ws, size_t ws_size, hipStream_t stream) {
    static int grid = 0;
    if (!grid) {
        if (n_in != 26 || out_size != NLAT * D || ws_size < WS_END) { fprintf(stderr, "kernel_launch: shape/ws mismatch n_in %d out %d ws %zu need %zu\n", n_in, out_size, ws_size, (size_t)WS_END); return; }
        if (hipFuncSetAttribute((const void*)mega, hipFuncAttributeMaxDynamicSharedMemorySize, LDS_TOTAL) != hipSuccess) { fprintf(stderr, "kernel_launch: LDS attribute failed\n"); return; }
        int dev = 0, cus = 0, per_cu = 0; hipGetDevice(&dev); hipDeviceGetAttribute(&cus, hipDeviceAttributeMultiprocessorCount, dev);
        hipOccupancyMaxActiveBlocksPerMultiprocessor(&per_cu, mega, NTHR, LDS_TOTAL);
        if (per_cu < 1) { fprintf(stderr, "kernel_launch: occupancy 0\n"); return; }
        grid = cus;
    }
    Params p{};
    for (int i = 0; i < 26; ++i) p.in[i] = (const float*)d_in[i];
    p.out = (float*)d_out; p.ws = (unsigned char*)d_ws;
    hipMemsetAsync((unsigned char*)d_ws + WS_CTL, 0, CTL_BYTES, stream);
#if SPLIT_LAUNCH
    for (int k = 0; k < NPH; ++k) hipLaunchKernelGGL(mega, dim3(grid), dim3(NTHR), LDS_TOTAL, stream, p, k, k + 1);
#else
    hipLaunchKernelGGL(mega, dim3(grid), dim3(NTHR), LDS_TOTAL, stream, p, 0, NPH);
#endif
}
```

```cpp
#include <hip/hip_runtime.h>
#include <cstdio>
#include <cstdint>

#define LAS __attribute__((address_space(3)))
typedef unsigned short u16;
using bf16x8 = __attribute__((ext_vector_type(8))) short;
using s16x4  = __attribute__((ext_vector_type(4))) short;
typedef short v4i16_t __attribute__((ext_vector_type(4)));
using f32x4  = __attribute__((ext_vector_type(4))) float;
using f32x16 = __attribute__((ext_vector_type(16))) float;
using u32x4  = __attribute__((ext_vector_type(4))) unsigned;
using u32x2  = __attribute__((ext_vector_type(2))) unsigned;
typedef __bf16 bf16x2_t __attribute__((ext_vector_type(2)));
typedef float f32x2_t __attribute__((ext_vector_type(2)));

#ifndef SPLIT_LAUNCH
#define SPLIT_LAUNCH 0
#endif

constexpr int D = 1024, NB = 4, SEQ = 8192, CTXL = 256;
constexpr int NCTX = NB * CTXL, NLAT = NB * SEQ, NROW = NCTX + NLAT;
constexpr int NCH = 66;
constexpr int NE = 32;
constexpr int NTHR = 512;
constexpr float EPS = 1e-6f;
constexpr float LOG2E = 1.4426950408889634f;
constexpr float LAM_INIT = 0.35550906f;

constexpr size_t al256(size_t x) { return (x + 255) / 256 * 256; }
constexpr size_t WS_CTL = 0, CTL_BYTES = 32768;
constexpr int CW_BAR = 0;
constexpr int CW_KMAX = 5120;
constexpr int CW_CNT = 4096;
constexpr size_t WS_MOD   = CTL_BYTES;
constexpr size_t WS_ROPE1 = WS_MOD + al256(2 * 5 * 6144 * 4);
constexpr size_t WS_ROPE2 = WS_ROPE1 + al256((size_t)8448 * 64 * 8);
constexpr size_t WS_GATEW = WS_ROPE2 + al256(128 * 16 * 8);
constexpr size_t WS_GATES = WS_GATEW + al256(16 * 1024 * 4);
constexpr size_t WS_HCTX  = WS_GATES + al256((size_t)NROW * 16 * 4);
constexpr size_t WS_STATS = WS_HCTX + al256((size_t)NCTX * D * 4);
constexpr size_t WS_MST   = WS_STATS + al256(32 * NCH * 2 * 4);
constexpr size_t WS_NV    = WS_MST + al256(32 * NCH * 4);
constexpr size_t WS_ASGE  = WS_NV + al256((size_t)32 * NCH * 128 * 4);
constexpr size_t WS_ASGR  = WS_ASGE + al256((size_t)NROW * 2 * 4);
constexpr size_t WS_ASGG  = WS_ASGR + al256((size_t)NROW * 2 * 4);
constexpr size_t WS_LIST  = WS_ASGG + al256((size_t)NROW * 2 * 4);
constexpr size_t WS_WINE  = WS_LIST + al256((size_t)NE * NROW * 4);
constexpr size_t WS_WOUTE = WS_WINE + (size_t)4096 * 1024 * 2;
constexpr size_t WS_WINO  = WS_WOUTE + (size_t)1024 * 1024 * 2;
constexpr size_t WS_WOUTO = WS_WINO + (size_t)3072 * 1024 * 2;
constexpr size_t WS_X1    = WS_WOUTO + (size_t)1024 * 1024 * 2;
constexpr size_t WS_PROJ  = WS_X1 + (size_t)NROW * 1024 * 2;
constexpr size_t PROJ_BYTES = (size_t)NROW * 4096 * 2;
constexpr int    HROWS = 2 * NROW + 256;
constexpr size_t WS_H     = WS_PROJ;
constexpr size_t WS_YB    = WS_H + (size_t)HROWS * 512 * 2;
static_assert(WS_YB + (size_t)HROWS * 1024 * 2 <= WS_PROJ + PROJ_BYTES, "moe buffers fit in proj");
constexpr size_t WS_STATES = WS_PROJ + PROJ_BYTES;
constexpr size_t STATES_BYTES = (size_t)64 * NCH * 16384 * 2;
constexpr size_t WS_W13   = WS_STATES;
constexpr size_t WS_W2    = WS_W13 + (size_t)NE * 1024 * 1024 * 2;
static_assert(WS_W2 + (size_t)NE * 1024 * 512 * 2 <= WS_STATES + STATES_BYTES, "moe weights fit in states");
constexpr size_t WS_END   = WS_STATES + STATES_BYTES;

constexpr int LDS_TOTAL = 163840;
constexpr int LDS_MISC  = LDS_TOTAL - 64;

struct Params { const float* in[26]; float* out; unsigned char* ws; };

__device__ __forceinline__ unsigned cvtpk(float lo, float hi) { f32x2_t v = {lo, hi}; bf16x2_t b = __builtin_convertvector(v, bf16x2_t); return __builtin_bit_cast(unsigned, b); }
__device__ __forceinline__ u16 f2bf(float x) { __bf16 b = (__bf16)x; return __builtin_bit_cast(u16, b); }
__device__ __forceinline__ float bf2f(u16 x) { return __uint_as_float(((unsigned)x) << 16); }
__device__ __forceinline__ float bflo(unsigned w) { return __uint_as_float(w << 16); }
__device__ __forceinline__ float bfhi(unsigned w) { return __uint_as_float(w & 0xffff0000u); }
template <int CTRL> __device__ __forceinline__ float dpp_f(float v) { return __builtin_bit_cast(float, __builtin_amdgcn_update_dpp(0, __builtin_bit_cast(int, v), CTRL, 0xf, 0xf, true)); }
__device__ __forceinline__ float row_sum16(float v) { v += dpp_f<0xB1>(v); v += dpp_f<0x4E>(v); v += dpp_f<0x141>(v); v += dpp_f<0x140>(v); return v; }
__device__ __forceinline__ float row_max16(float v) { v = fmaxf(v, dpp_f<0xB1>(v)); v = fmaxf(v, dpp_f<0x4E>(v)); v = fmaxf(v, dpp_f<0x141>(v)); v = fmaxf(v, dpp_f<0x140>(v)); return v; }
__device__ __forceinline__ float swap16_add(float v) { auto rr = __builtin_amdgcn_permlane16_swap(__float_as_uint(v), __float_as_uint(v), false, false); return __uint_as_float(rr[0]) + __uint_as_float(rr[1]); }
__device__ __forceinline__ float swap16_max(float v) { auto rr = __builtin_amdgcn_permlane16_swap(__float_as_uint(v), __float_as_uint(v), false, false); return fmaxf(__uint_as_float(rr[0]), __uint_as_float(rr[1])); }
__device__ __forceinline__ float swap32_add(float v) { auto rr = __builtin_amdgcn_permlane32_swap(__float_as_uint(v), __float_as_uint(v), false, false); return __uint_as_float(rr[0]) + __uint_as_float(rr[1]); }
__device__ __forceinline__ float swap32_max(float v) { auto rr = __builtin_amdgcn_permlane32_swap(__float_as_uint(v), __float_as_uint(v), false, false); return fmaxf(__uint_as_float(rr[0]), __uint_as_float(rr[1])); }
__device__ __forceinline__ float wave_sum(float v) { return swap32_add(swap16_add(row_sum16(v))); }
__device__ __forceinline__ float wave_max(float v) { return swap32_max(swap16_max(row_max16(v))); }
__device__ __forceinline__ float half_sum(float v) { return swap16_add(row_sum16(v)); }
__device__ __forceinline__ float sigmoidf_(float x) { return __builtin_amdgcn_rcpf(1.f + __expf(-x)); }
__device__ __forceinline__ float siluf_(float x) { return x * __builtin_amdgcn_rcpf(1.f + __expf(-x)); }
__device__ __forceinline__ int crow(int r, int hi) { return (r & 3) + 8 * (r >> 2) + 4 * hi; }
__device__ __forceinline__ float swap_add(float v) { auto rr = __builtin_amdgcn_permlane32_swap(__float_as_uint(v), __float_as_uint(v), false, false); return __uint_as_float(rr[0]) + __uint_as_float(rr[1]); }
__device__ __forceinline__ float swap_max(float v) { auto rr = __builtin_amdgcn_permlane32_swap(__float_as_uint(v), __float_as_uint(v), false, false); return fmaxf(__uint_as_float(rr[0]), __uint_as_float(rr[1])); }
__device__ __forceinline__ void glds16(const void* g, LAS unsigned char* l) { __builtin_amdgcn_global_load_lds((const unsigned*)g, (LAS unsigned*)l, 16, 0, 0); }
#define WAIT_V(n) asm volatile("s_waitcnt vmcnt(" #n ")" ::: "memory")
#define WAIT_L(n) asm volatile("s_waitcnt lgkmcnt(" #n ")" ::: "memory")
#define BAR() __builtin_amdgcn_s_barrier()
#define SBAR() __builtin_amdgcn_sched_barrier(0)

__device__ __forceinline__ int row_modvec(int r) { return r < NCTX ? 4 : ((r - NCTX) >> 13); }
__device__ __forceinline__ int row_pos(int r) { return r < NCTX ? (r & 255) : 256 + ((r - NCTX) & 8191); }
__device__ __forceinline__ int chunk_row0(int b, int ch) { return ch < 2 ? b * 256 + ch * 128 : NCTX + b * SEQ + (ch - 2) * 128; }

#define XB_TMO      128
#define XB_XCNT(j)  (256  + 64 * (j))
#define XB_XSUB(j)  (1280 + 64 * (j))
#define XB_XGEN(j)  (2304 + 64 * (j))
#define XB_TOP      3328
#define XB_TOPGEN   3392
#define XCD_BAR_WORDS 3456
#define XB_SPIN_CAP (1u << 18)
__device__ __forceinline__ unsigned xb_ld(unsigned* p)              { return __hip_atomic_load(p, __ATOMIC_RELAXED, __HIP_MEMORY_SCOPE_AGENT); }
__device__ __forceinline__ unsigned xb_add(unsigned* p, unsigned v) { return __hip_atomic_fetch_add(p, v, __ATOMIC_RELAXED, __HIP_MEMORY_SCOPE_AGENT); }
__device__ __forceinline__ unsigned xb_xcc_id() { return (unsigned)__builtin_amdgcn_s_getreg((3 << 11) | 20) & 0xFu; }
#define XB_SPIN(cond, bar) do { unsigned _sp = 0; while (cond) { __builtin_amdgcn_s_sleep(1); \
    if ((++_sp & 255u) == 0u) { if (xb_ld(&(bar)[XB_TMO])) break; if (_sp > XB_SPIN_CAP) { atomicAdd(&(bar)[XB_TMO], 1u); break; } } } } while (0)
struct XcdBarrier { unsigned* bar; unsigned x; volatile LAS unsigned* st; };
__device__ __forceinline__ XcdBarrier xcd_barrier_post(unsigned* bar, volatile LAS unsigned* st) {
    XcdBarrier b; b.bar = bar; b.x = xb_xcc_id(); b.st = st;
    if (threadIdx.x == 0) (void)xb_add(&bar[XB_XCNT(b.x)], 1u);
    return b;
}
__device__ __forceinline__ void xcd_barrier_complete(unsigned* bar, unsigned x, unsigned& nloc, unsigned& nx) {
    const unsigned G = gridDim.x * gridDim.y * gridDim.z;
    unsigned sum, cnt, mine, sp = 0u;
    for (;;) {
        sum = 0u; cnt = 0u; mine = 0u;
#pragma unroll
        for (unsigned j = 0; j < 16; ++j) { const unsigned c = xb_ld(&bar[XB_XCNT(j)]); sum += c; cnt += (c > 0u) ? 1u : 0u; mine = (j == x) ? c : mine; }
        if (sum == G) break;
        __builtin_amdgcn_s_sleep(1);
        if ((++sp & 255u) == 0u) { if (xb_ld(&bar[XB_TMO])) break; if (sp > XB_SPIN_CAP) { atomicAdd(&bar[XB_TMO], 1u); break; } }
    }
    nloc = mine > 0u ? mine : 1u; nx = cnt > 0u ? cnt : 1u;
}
__device__ __forceinline__ void xcd_barrier(const XcdBarrier& b) {
    asm volatile("s_waitcnt vmcnt(0)" ::: "memory");
    __syncthreads();
    if (threadIdx.x == 0) {
        unsigned* bar = b.bar;
        __builtin_amdgcn_s_waitcnt(0);
        unsigned nloc = b.st[0], nx = b.st[1];
        if (nloc == 0u) { xcd_barrier_complete(bar, b.x, nloc, nx); b.st[0] = nloc; b.st[1] = nx; }
        const unsigned old = xb_add(&bar[XB_XSUB(b.x)], 1u);
        const unsigned gen = old / nloc;
        if (old + 1u == (gen + 1u) * nloc) {
            __builtin_amdgcn_fence(__ATOMIC_RELEASE, "agent");
            asm volatile("s_waitcnt vmcnt(0)" ::: "memory");
            const unsigned og = xb_add(&bar[XB_TOP], 1u);
            const unsigned tg = og / nx;
            if (og + 1u == (tg + 1u) * nx) xb_add(&bar[XB_TOPGEN], 1u);
            else XB_SPIN(xb_ld(&bar[XB_TOPGEN]) == tg, bar);
            __builtin_amdgcn_fence(__ATOMIC_ACQUIRE, "agent");
            xb_add(&bar[XB_XGEN(b.x)], 1u);
            asm volatile("s_waitcnt vmcnt(0)" ::: "memory");
        } else {
            XB_SPIN(xb_ld(&bar[XB_XGEN(b.x)]) == gen, bar);
            __builtin_amdgcn_fence(__ATOMIC_ACQUIRE, "agent");
            asm volatile("s_waitcnt vmcnt(0)" ::: "memory");
        }
    }
    __syncthreads();
}

struct ConvJob { const float* src; u16* dst; int ldn, ldk; float scale; };
__device__ __forceinline__ void conv_load(const ConvJob& j, f32x4 (&r)[4]) {
#pragma unroll
    for (int i = 0; i < 2; ++i) { const int idx = threadIdx.x + i * NTHR, kp = idx >> 4, n4 = idx & 15; const float* s = j.src + (size_t)(2 * kp) * j.ldn + n4 * 4;
        r[2 * i] = *(const f32x4*)s; r[2 * i + 1] = *(const f32x4*)(s + j.ldn); }
}
__device__ __forceinline__ void conv_store(const ConvJob& j, const f32x4 (&r)[4], LAS unsigned char* lds) {
    LAS unsigned* scr = (LAS unsigned*)lds;
#pragma unroll
    for (int i = 0; i < 2; ++i) { const int idx = threadIdx.x + i * NTHR, kp = idx >> 4, n4 = idx & 15;
#pragma unroll
        for (int e = 0; e < 4; ++e) scr[(n4 * 4 + e) * 65 + kp] = cvtpk(r[2 * i][e] * j.scale, r[2 * i + 1][e] * j.scale); }
    __syncthreads();
    { const int n = threadIdx.x >> 3, c8 = threadIdx.x & 7; const LAS unsigned* q = scr + n * 65 + c8 * 8;
      u32x4 w0 = {q[0], q[1], q[2], q[3]}, w1 = {q[4], q[5], q[6], q[7]};
      u16* o = j.dst + (size_t)n * j.ldk + c8 * 16; *(u32x4*)o = w0; *(u32x4*)(o + 8) = w1; }
    __syncthreads();
}
template <class JobFn>
__device__ __forceinline__ void conv_stream(int first, int stride, int total, const JobFn& jf, LAS unsigned char* lds) {
    if (first >= total) return;
    const int last = first + ((total - 1 - first) / stride) * stride;
    ConvJob ja = jf(first), jb = jf(first + stride <= last ? first + stride : last), jc = ja;
    f32x4 ra[4], rb[4], rc[4]; conv_load(ja, ra); conv_load(jb, rb);
    int u = first;
    for (; u + 2 * stride <= last; u += 3 * stride) {
        { const int n2 = u + 2 * stride; jc = jf(n2); conv_load(jc, rc); conv_store(ja, ra, lds); }
        { const int n2 = u + 3 * stride; ja = jf(n2 <= last ? n2 : last); conv_load(ja, ra); conv_store(jb, rb, lds); }
        { const int n2 = u + 4 * stride; jb = jf(n2 <= last ? n2 : last); conv_load(jb, rb); conv_store(jc, rc, lds); }
    }
    if (u <= last) { conv_store(ja, ra, lds); if (u + stride <= last) conv_store(jb, rb, lds); }
}
constexpr int MOE_CONV_UNITS = NE * 192;
struct MoeJob { const Params* p; int l;
    __device__ __forceinline__ ConvJob operator()(int u) const {
        const int e = u / 192, j = u % 192; ConvJob c; c.scale = 1.f;
        if (j < 128) { const int nt16 = j >> 3, kt = j & 7, pn = nt16 >> 2, part = (nt16 >> 1) & 1, half = nt16 & 1;
            c.src = (part ? p->in[23] : p->in[22]) + ((size_t)l * NE + e) * 1024 * 512 + (size_t)(kt * 128) * 512 + pn * 128 + half * 64; c.ldn = 512;
            c.dst = (u16*)(p->ws + WS_W13) + (size_t)e * 1024 * 1024 + (size_t)(nt16 * 64) * 1024 + kt * 128; c.ldk = 1024;
        } else { const int jj = j - 128, nt16 = jj >> 2, kt = jj & 3;
            c.src = p->in[24] + ((size_t)l * NE + e) * 512 * 1024 + (size_t)(kt * 128) * 1024 + nt16 * 64; c.ldn = 1024;
            c.dst = (u16*)(p->ws + WS_W2) + (size_t)e * 1024 * 512 + (size_t)(nt16 * 64) * 512 + kt * 128; c.ldk = 512; }
        return c; }
};
struct P0Job { const Params* p;
    __device__ __forceinline__ ConvJob operator()(int u) const { ConvJob c; c.scale = 1.f; c.ldk = 1024;
        if (u < 512) {
            const int nt = u >> 3, kt = u & 7, n0 = nt * 64, grp = n0 >> 9, w = n0 & 511;
            int s0 = n0; if (grp == 4 || grp == 5) s0 = grp * 512 + (2 * (w >> 8) + ((w >> 6) & 1)) * 128 + 64 * ((w >> 7) & 1);
            c.src = p->in[8] + (size_t)(kt * 128) * 4112 + s0 + (s0 >= 2048 ? 16 : 0); c.ldn = 4112; c.dst = (u16*)(p->ws + WS_WINE) + (size_t)n0 * 1024 + kt * 128;
            c.scale = (grp == 1 || grp == 5) ? 0.08838834764831845f : 1.f;
        } else if (u < 640) { const int v = u - 512; c.src = p->in[13] + (size_t)((v & 7) * 128) * 1024 + (v >> 3) * 64; c.ldn = 1024; c.dst = (u16*)(p->ws + WS_WOUTE) + (size_t)((v >> 3) * 64) * 1024 + (v & 7) * 128;
        } else if (u < 1024) { const int v = u - 640; c.src = p->in[14] + (size_t)((v & 7) * 128) * 3072 + (v >> 3) * 64; c.ldn = 3072; c.dst = (u16*)(p->ws + WS_WINO) + (size_t)((v >> 3) * 64) * 1024 + (v & 7) * 128;
        } else { const int v = u - 1024; c.src = p->in[17] + (size_t)((v & 7) * 128) * 1024 + (v >> 3) * 64; c.ldn = 1024; c.dst = (u16*)(p->ws + WS_WOUTO) + (size_t)((v >> 3) * 64) * 1024 + (v & 7) * 128; }
        return c; }
};
constexpr int P0_CONV = 512 + 128 + 384 + 128, P0_GATEW = P0_CONV, P0_MOD = P0_GATEW + 1, P0_ROPE1 = P0_MOD + 384, P0_ROPE2 = P0_ROPE1 + 132, P0_UNITS = P0_ROPE2 + 1;
__device__ __forceinline__ void phase0(const Params& p, LAS unsigned char* lds, int bid, int nblk) {
    const int tid = threadIdx.x;
    { P0Job jf{&p}; conv_stream(bid, nblk, P0_CONV, jf, lds); }
    for (int u = P0_CONV + bid; u < P0_UNITS; u += nblk) {
        if (u == P0_GATEW) {
            float* gw = (float*)(p.ws + WS_GATEW);
            for (int i = tid; i < 16 * 1024; i += NTHR) { int k = i >> 4, j = i & 15; gw[j * 1024 + k] = p.in[8][(size_t)k * 4112 + 2048 + j]; }
        } else if (u < P0_ROPE1) {
            const int v0 = u - P0_MOD, l = v0 / 192, cb = v0 % 192;
            LAS float* sc = (LAS float*)lds;
            LAS float* part = sc + 5 * 1024;
            for (int i = tid; i < 5 * 1024; i += NTHR) { int v = i >> 10, k = i & 1023; float c = v < 4 ? p.in[1][v * 1024 + k] : p.in[3][k]; sc[i] = siluf_(c); }
            __syncthreads();
            const int col = tid & 31, kq = tid >> 5;
            const float* w = p.in[4] + (size_t)l * 1024 * 6144 + cb * 32 + col;
            float a0 = 0, a1 = 0, a2 = 0, a3 = 0, a4 = 0;
#pragma unroll 16
            for (int k = kq * 64; k < kq * 64 + 64; ++k) { float wv = w[(size_t)k * 6144]; a0 += sc[k] * wv; a1 += sc[1024 + k] * wv; a2 += sc[2048 + k] * wv; a3 += sc[3072 + k] * wv; a4 += sc[4096 + k] * wv; }
            part[(kq * 5 + 0) * 32 + col] = a0; part[(kq * 5 + 1) * 32 + col] = a1; part[(kq * 5 + 2) * 32 + col] = a2; part[(kq * 5 + 3) * 32 + col] = a3; part[(kq * 5 + 4) * 32 + col] = a4;
            __syncthreads();
            if (tid < 5 * 32) { const int v = tid >> 5, c = tid & 31; float s = 0.f;
#pragma unroll
                for (int q = 0; q < 16; ++q) s += part[(q * 5 + v) * 32 + c];
                ((float*)(p.ws + WS_MOD))[((size_t)l * 5 + v) * 6144 + cb * 32 + c] = s + p.in[5][l * 6144 + cb * 32 + c]; }
            __syncthreads();
        } else if (u < P0_ROPE2) {
            const int v0 = u - P0_ROPE1; float2* tb = (float2*)(p.ws + WS_ROPE1);
            for (int j = 0; j < 8; ++j) { int e = v0 * 4096 + j * 512 + tid; int pos = e >> 6, f = e & 63;
                float inv = powf(10000.f, -(float)f / 64.f); float ang = (float)pos * inv; tb[e] = make_float2(cosf(ang), sinf(ang)); }
        } else {
            float2* tb = (float2*)(p.ws + WS_ROPE2);
            for (int e = tid; e < 128 * 16; e += NTHR) { int pos = e >> 4, f = e & 15; float inv = powf(10000.f, -(float)f / 16.f); float ang = (float)pos * inv; tb[e] = make_float2(cosf(ang), sinf(ang)); }
        }
    }
}

__device__ __forceinline__ void load_row(const float* rp, int lane, f32x4 (&x)[4]) {
#pragma unroll
    for (int i = 0; i < 4; ++i) x[i] = *(const f32x4*)(rp + i * 256 + lane * 4);
}
__device__ __forceinline__ float row_rstd(const f32x4 (&x)[4]) {
    float ss = 0;
#pragma unroll
    for (int i = 0; i < 4; ++i) ss += x[i][0] * x[i][0] + x[i][1] * x[i][1] + x[i][2] * x[i][2] + x[i][3] * x[i][3];
    ss = wave_sum(ss);
    return rsqrtf(ss * (1.f / 1024.f) + EPS);
}
__device__ __forceinline__ void adaln_row(f32x4 (&x)[4], float rstd, const float* g, const float* shift, const float* scale, int lane) {
#pragma unroll
    for (int i = 0; i < 4; ++i) { f32x4 gv = *(const f32x4*)(g + i * 256 + lane * 4), sh = *(const f32x4*)(shift + i * 256 + lane * 4), sc = *(const f32x4*)(scale + i * 256 + lane * 4);
#pragma unroll
        for (int e = 0; e < 4; ++e) x[i][e] = x[i][e] * rstd * gv[e] * (1.f + sc[e]) + sh[e]; }
}
struct AdaC { f32x4 g[4], sh[4]; };
__device__ __forceinline__ void adac_load(AdaC& c, const float* g, const float* shift, const float* scale, int lane) {
#pragma unroll
    for (int i = 0; i < 4; ++i) { const f32x4 gv = *(const f32x4*)(g + i * 256 + lane * 4), sc = *(const f32x4*)(scale + i * 256 + lane * 4); c.sh[i] = *(const f32x4*)(shift + i * 256 + lane * 4);
#pragma unroll
        for (int e = 0; e < 4; ++e) c.g[i][e] = gv[e] * (1.f + sc[e]); }
}
__device__ __forceinline__ void adaln_apply(f32x4 (&x)[4], float rstd, const AdaC& c) {
#pragma unroll
    for (int i = 0; i < 4; ++i)
#pragma unroll
        for (int e = 0; e < 4; ++e) x[i][e] = x[i][e] * rstd * c.g[i][e] + c.sh[i][e];
}
__device__ __forceinline__ void store_row_bf16(u16* rp, int lane, const f32x4 (&x)[4]) {
#pragma unroll
    for (int i = 0; i < 4; ++i) { u32x2 w = {cvtpk(x[i][0], x[i][1]), cvtpk(x[i][2], x[i][3])}; *(u32x2*)(rp + i * 256 + lane * 4) = w; }
}
__device__ __forceinline__ const float* l0_in_row(const Params& p, int r) { return r < NCTX ? p.in[2] + (size_t)r * D : p.in[0] + (size_t)(r - NCTX) * D; }
__device__ __forceinline__ float* h_row(const Params& p, int r) { return r < NCTX ? (float*)(p.ws + WS_HCTX) + (size_t)r * D : p.out + (size_t)(r - NCTX) * D; }

__device__ __forceinline__ void phase1(const Params& p, LAS unsigned char* lds, int bid, int nblk) {
    const int tid = threadIdx.x, wid = tid >> 6, lane = tid & 63;
    LAS float* gw = (LAS float*)lds;
    { const float* src = (const float*)(p.ws + WS_GATEW); for (int i = tid; i < 16 * 1024 / 4; i += NTHR) *(LAS f32x4*)(gw + i * 4) = *(const f32x4*)(src + i * 4); }
    __syncthreads();
    const float* mod = (const float*)(p.ws + WS_MOD);
    const int gwv = bid * 8 + __builtin_amdgcn_readfirstlane(wid), nwv = nblk * 8, rs = (int)(((long)gwv * NROW) / nwv), re = (int)(((long)(gwv + 1) * NROW) / nwv);
    AdaC ac; int curmv = -1;
    f32x4 gbias;
    { const int q = lane >> 4, dir = q & 1, kind = q >> 1;
#pragma unroll
      for (int h = 0; h < 4; ++h) gbias[h] = p.in[9][dir * 8 + kind * 4 + h]; }
    f32x4 xa[4], xb[4], xc[4];
    if (rs < re) load_row(l0_in_row(p, rs), lane, xa);
    if (rs + 1 < re) load_row(l0_in_row(p, rs + 1), lane, xb);
#define P1_STEP(R, x, PF) do { const int r = (R); if (r + 2 < re) load_row(l0_in_row(p, r + 2), lane, PF); \
        const int mv = row_modvec(r); \
        if (mv != curmv) { const float* m = mod + (size_t)(0 * 5 + mv) * 6144; adac_load(ac, p.in[6], m, m + 1024, lane); curmv = mv; } \
        const float rstd = row_rstd(x); \
        adaln_apply(x, rstd, ac); \
        store_row_bf16((u16*)(p.ws + WS_X1) + (size_t)r * D, lane, x); \
        float a[16]; \
        _Pragma("unroll") for (int jg = 0; jg < 4; ++jg) { f32x4 w[16];        \
            _Pragma("unroll") for (int t = 0; t < 16; ++t) w[t] = *(const LAS f32x4*)(gw + (jg * 4 + (t >> 2)) * 1024 + (t & 3) * 256 + lane * 4); \
            SBAR(); \
            _Pragma("unroll") for (int jj = 0; jj < 4; ++jj) { float s = 0.f; \
                _Pragma("unroll") for (int i = 0; i < 4; ++i) s += x[i][0] * w[jj * 4 + i][0] + x[i][1] * w[jj * 4 + i][1] + x[i][2] * w[jj * 4 + i][2] + x[i][3] * w[jj * 4 + i][3]; \
                a[jg * 4 + jj] = s; } \
            SBAR(); } \
        float s8[8], t4[4]; \
        _Pragma("unroll") for (int j = 0; j < 8; ++j) { auto rr = __builtin_amdgcn_permlane32_swap(__float_as_uint(a[j]), __float_as_uint(a[j + 8]), false, false); s8[j] = __uint_as_float(rr[0]) + __uint_as_float(rr[1]); } \
        _Pragma("unroll") for (int j = 0; j < 4; ++j) { auto rr = __builtin_amdgcn_permlane16_swap(__float_as_uint(s8[j]), __float_as_uint(s8[j + 4]), false, false); t4[j] = row_sum16(__uint_as_float(rr[0]) + __uint_as_float(rr[1])); } \
        if ((lane & 15) == 0) { const int q = lane >> 4; f32x4 o; \
            _Pragma("unroll") for (int h = 0; h < 4; ++h) { const float z = t4[h] + gbias[h]; o[h] = (q < 2) ? z : fminf(z, 0.f) - __logf(1.f + __expf(-fabsf(z))); }        \
            *(f32x4*)((float*)(p.ws + WS_GATES) + (size_t)r * 16 + q * 4) = o; } } while (0)
    for (int r0 = rs; r0 < re; r0 += 3) {
        P1_STEP(r0, xa, xc);
        if (r0 + 1 < re) P1_STEP(r0 + 1, xb, xa);
        if (r0 + 2 < re) P1_STEP(r0 + 2, xc, xb);
    }
#undef P1_STEP
}

namespace pg {
constexpr int BM = 256, BK = 64, HALF = 128, HTB = HALF * BK * 2, NXCD = 8, WGM = 8;
__device__ __forceinline__ int lds_byte(int r, int c) { const int st = (r >> 4) * 2 + (c >> 5), rr = r & 15, cc = c & 31, ob = rr * 64 + cc * 2; return st * 1024 + (ob ^ (((ob >> 9) & 1) << 5)); }
__device__ __forceinline__ void stage_rc(int b, int& R, int& C) { const int st = b / 1024, sb = b % 1024, swz = sb ^ (((sb >> 9) & 1) << 5); R = (st >> 1) * 16 + swz / 64; C = (st & 1) * 32 + (swz % 64) / 2; }
__device__ __forceinline__ int perm32(int rho) { const int n = rho >> 4, i = rho & 15; return 8 * (i >> 2) + 4 * n + (i & 3); }
struct Unit { int pm, pn, e, nv, off; };
__device__ __forceinline__ int xcd_remap(int wgid, int nwg) { const int q = nwg / NXCD, r = nwg % NXCD, xcd = wgid % NXCD, off = wgid / NXCD; return (xcd < r ? xcd * (q + 1) : r * (q + 1) + (xcd - r) * q) + off; }

struct DenseSched {
    static constexpr bool GATHER = false;
    const char* A; const char* Bt; int pm0, nM, nN, nwg, G, c; size_t tstep;
    __device__ __forceinline__ void init(const void* A_, const void* Bt_, int K, int pm0_, int nM_, int nN_, int G_, int c_) { A = (const char*)A_; Bt = (const char*)Bt_; pm0 = pm0_; nM = nM_; nN = nN_; nwg = nM * nN; G = G_; c = c_; tstep = (size_t)BM * K * 2; }
    __device__ __forceinline__ bool next(int i, Unit& u) const {
        const long L = (long)i * G + c; if (L >= nwg) return false;
        const int wgid = xcd_remap((int)L, nwg);
        const int nig = WGM * nN, gid = wgid / nig, fm = gid * WGM, gsz = (nM - fm) < WGM ? (nM - fm) : WGM;
        u.pm = pm0 + fm + ((wgid % nig) % gsz); u.pn = (wgid % nig) / gsz; u.e = 0; u.nv = 256; u.off = 0; return true;
    }
    __device__ __forceinline__ const char* abase(const Unit& u) const { return A + (size_t)u.pm * tstep; }
    __device__ __forceinline__ const char* bbase(const Unit& u) const { return Bt + (size_t)u.pn * tstep; }
    __device__ __forceinline__ void stage_rows(const Unit&) const {}
    __device__ __forceinline__ void aoffs(unsigned (&o)[2][2], int K) const {
#pragma unroll
        for (int h = 0; h < 2; ++h)
#pragma unroll
            for (int i = 0; i < 2; ++i) { int R, C; stage_rc(threadIdx.x * 16 + i * 8192, R, C); o[h][i] = (unsigned)((h * HALF + R) * K + C) * 2u; } }
};
template <bool GATHER_> struct MoeSched {
    static constexpr bool GATHER = GATHER_;
    const char* A; const char* Bt; const LAS int* CNT; const LAS int* OFF; const LAS int* TIL; LAS int* RIDX; const int* list; int nwg, G, c, K, fallback;
    __device__ __forceinline__ bool next(int i, Unit& u) const {
        const long L = (long)i * G + c; if (L >= nwg) return false;
        const int wgid = __builtin_amdgcn_readfirstlane(xcd_remap((int)L, nwg)), tile = wgid >> 2; int e = 0;
#pragma unroll
        for (int j = 1; j < 32; ++j) e += (TIL[j] <= tile) ? 1 : 0;
        e = __builtin_amdgcn_readfirstlane(e);
        u.e = e; u.pm = __builtin_amdgcn_readfirstlane(tile - TIL[e]); u.pn = wgid & 3; const int left = __builtin_amdgcn_readfirstlane(CNT[e]) - u.pm * 256; u.nv = left < 256 ? left : 256;
        u.off = __builtin_amdgcn_readfirstlane(OFF[e]); return true;
    }
    __device__ __forceinline__ const char* abase(const Unit& u) const { return GATHER ? A : A + (size_t)(u.off + u.pm * 256) * K * 2; }
    __device__ __forceinline__ const char* bbase(const Unit& u) const { return Bt + ((size_t)u.e * 1024 + u.pn * 256) * K * 2; }
    __device__ __forceinline__ void stage_rows(const Unit& u) const {
        if (GATHER) { const int t = threadIdx.x; if (t < 256) RIDX[t] = t < u.nv ? list[(size_t)u.e * NROW + u.pm * 256 + t] : fallback; } }
    __device__ __forceinline__ void aoffs(unsigned (&o)[2][2], int K_) const {
#pragma unroll
        for (int h = 0; h < 2; ++h)
#pragma unroll
            for (int i = 0; i < 2; ++i) { int R, C; int tz = threadIdx.x; asm volatile("" : "+v"(tz)); stage_rc(tz * 16 + i * 8192, R, C); const int rr = h * HALF + R;
                if (GATHER) o[h][i] = (unsigned)(RIDX[rr] * K_ + C) * 2u; else o[h][i] = (unsigned)(rr * K_ + C) * 2u; } }
};

template <bool PERM, class Sched, class Epi>
__device__ __forceinline__ void gemm_phase(LAS unsigned char* lds, const int K, const Sched& S, const Epi& E) {
    const int tid = threadIdx.x, wid = __builtin_amdgcn_readfirstlane(tid >> 6), lane = tid & 63, wr = wid >> 2, wc = wid & 3, fr = lane & 15, fq = lane >> 4;
    const int nt = K / BK;
    unsigned voffB[2];
#pragma unroll
    for (int i = 0; i < 2; ++i) { int R, C; stage_rc(tid * 16 + i * 8192, R, C); const int Rb = PERM ? ((R & ~31) + perm32(R & 31)) : R; voffB[i] = (unsigned)(Rb * K + C) * 2u; }
    const size_t kstep = (size_t)(BK * 2);
    const size_t hstep = (size_t)HALF * K * 2;
    const unsigned ldsw = (unsigned)wid * 1024u;
    const int aoff = lds_byte(wr * 64 + fr, fq * 8), boff = lds_byte(wc * 32 + fr, fq * 8);
#define PG_SA(b, h) (((b) * 2 + (h)) * HTB)
#define PG_SB(b, h) ((4 + (b) * 2 + (h)) * HTB)
#define PG_STG(bufoff, gbase, o0, o1) do { __builtin_amdgcn_global_load_lds((const unsigned*)((const char*)(gbase) + (o0)), (LAS unsigned*)(lds + (bufoff) + ldsw), 16, 0, 0); \
        __builtin_amdgcn_global_load_lds((const unsigned*)((const char*)(gbase) + (o1)), (LAS unsigned*)(lds + (bufoff) + ldsw + 8192), 16, 0, 0); } while (0)
#define PG_STGB(bufoff, gbase) PG_STG(bufoff, gbase, voffB[0], voffB[1])
#define PG_LDA(dst, b, h) do { _Pragma("unroll") for (int m = 0; m < 4; ++m) _Pragma("unroll") for (int k = 0; k < 2; ++k) dst[m][k] = *(const LAS bf16x8*)(lds + PG_SA(b, h) + aoff + m * 2048 + k * 1024); } while (0)
#define PG_LDB(dst, b, h) do { _Pragma("unroll") for (int n = 0; n < 2; ++n) _Pragma("unroll") for (int k = 0; k < 2; ++k) dst[n][k] = *(const LAS bf16x8*)(lds + PG_SB(b, h) + boff + n * 2048 + k * 1024); } while (0)
#define PG_MMA(ai, bj, At, Bt) do { __builtin_amdgcn_s_setprio(1); _Pragma("unroll") for (int m = 0; m < 4; ++m) _Pragma("unroll") for (int n = 0; n < 2; ++n) _Pragma("unroll") for (int k = 0; k < 2; ++k) \
        acc[ai][bj][m][n] = __builtin_amdgcn_mfma_f32_16x16x32_bf16(Bt[n][k], At[m][k], acc[ai][bj][m][n], 0, 0, 0); __builtin_amdgcn_s_setprio(0); } while (0)
#define PG_BAR __builtin_amdgcn_s_barrier()
#define PG_SCHED __builtin_amdgcn_sched_barrier(0)
    Unit cur, nxt; int ui = 0;
    if (!S.next(0, cur)) return;
    f32x4 acc[2][2][4][2];
#pragma unroll
    for (int a = 0; a < 2; ++a)
#pragma unroll
        for (int b = 0; b < 2; ++b)
#pragma unroll
            for (int m = 0; m < 4; ++m)
#pragma unroll
                for (int n = 0; n < 2; ++n) acc[a][b][m][n] = (f32x4){0.f, 0.f, 0.f, 0.f};
    bf16x8 At[4][2], B0[2][2], B1[2][2];
    const char* cA = S.abase(cur); const char* cB = S.bbase(cur);
    unsigned oc[2][2];
    if (Sched::GATHER) { S.stage_rows(cur); __syncthreads(); }
    S.aoffs(oc, K);
    PG_STGB(PG_SB(0, 0), cB); PG_STGB(PG_SB(0, 1), cB + hstep); PG_STG(PG_SA(0, 0), cA, oc[0][0], oc[0][1]); PG_STG(PG_SA(0, 1), cA, oc[1][0], oc[1][1]);
    if (wr == 1) PG_BAR;
    WAIT_V(2); PG_BAR;
    PG_STGB(PG_SB(1, 0), cB + kstep); PG_STG(PG_SA(1, 0), cA + kstep, oc[0][0], oc[0][1]); PG_STGB(PG_SB(1, 1), cB + hstep + kstep);
    WAIT_V(6); PG_BAR;
    for (;;) {
        const bool has_next = S.next(ui + 1, nxt);
        const char* nA = cA; const char* nB = cB;
        if (has_next) { nA = S.abase(nxt); nB = S.bbase(nxt); if (Sched::GATHER) S.stage_rows(nxt); }
        for (int t = 0; t < nt; t += 2) {
            const bool last = (t == nt - 2);
            const char* a1 = cA + (size_t)(t + 1) * kstep;
            const char* a2 = last ? nA : cA + (size_t)(t + 2) * kstep; const char* b2 = last ? nB : cB + (size_t)(t + 2) * kstep;
            const char* a3 = a2 + kstep; const char* b3 = b2 + kstep;
            PG_LDB(B0, 0, 0); PG_LDB(B1, 0, 1); PG_SCHED; PG_LDA(At, 0, 0); PG_STG(PG_SA(1, 1), a1, oc[1][0], oc[1][1]);
            if (Sched::GATHER) { if (last && has_next) S.aoffs(oc, K); }
            WAIT_V(8); WAIT_L(0); PG_BAR; PG_MMA(0, 0, At, B0); PG_MMA(0, 1, At, B1); PG_BAR; PG_SCHED;
            PG_LDA(At, 0, 1); PG_STGB(PG_SB(0, 0), b2); PG_STGB(PG_SB(0, 1), b2 + hstep); PG_STG(PG_SA(0, 0), a2, oc[0][0], oc[0][1]);
            WAIT_V(8); WAIT_L(0); PG_BAR; PG_MMA(1, 0, At, B0); PG_MMA(1, 1, At, B1); PG_BAR; PG_SCHED;
            PG_LDB(B0, 1, 0); PG_LDB(B1, 1, 1); PG_SCHED; PG_LDA(At, 1, 0); PG_STG(PG_SA(0, 1), a2, oc[1][0], oc[1][1]);
            WAIT_V(8); WAIT_L(0); PG_BAR; PG_MMA(0, 0, At, B0); PG_MMA(0, 1, At, B1); PG_BAR; PG_SCHED;
            PG_LDA(At, 1, 1); PG_STGB(PG_SB(1, 0), b3); PG_STGB(PG_SB(1, 1), b3 + hstep); PG_STG(PG_SA(1, 0), a3, oc[0][0], oc[0][1]);
            WAIT_V(8); WAIT_L(0); PG_BAR; PG_MMA(1, 0, At, B0); PG_MMA(1, 1, At, B1); PG_BAR; PG_SCHED;
        }
        if (wr == 0) PG_BAR;
        E(acc, cur, wr, wc, fr, fq);
        if (!has_next) break;
#pragma unroll
        for (int a = 0; a < 2; ++a)
#pragma unroll
            for (int b = 0; b < 2; ++b)
#pragma unroll
                for (int m = 0; m < 4; ++m)
#pragma unroll
                    for (int n = 0; n < 2; ++n) acc[a][b][m][n] = (f32x4){0.f, 0.f, 0.f, 0.f};
        cur = nxt; cA = nA; cB = nB; ++ui;
        if (wr == 1) PG_BAR;
    }
    WAIT_V(0);
    PG_BAR;
#undef PG_SA
#undef PG_SB
#undef PG_STG
#undef PG_STGB
#undef PG_LDA
#undef PG_LDB
#undef PG_MMA
#undef PG_BAR
#undef PG_SCHED
}
}

__device__ __forceinline__ u32x4 pack8(const f32x4& a, const f32x4& b) { return (u32x4){cvtpk(a[0], a[1]), cvtpk(a[2], a[3]), cvtpk(b[0], b[1]), cvtpk(b[2], b[3])}; }

struct EpiIn0 { u16* O; const float2* rope;
    __device__ __forceinline__ void operator()(const f32x4 (&acc)[2][2][4][2], const pg::Unit& u, int wr_, int wc_, int fr_, int fq_) const {
        int tz = threadIdx.x; asm volatile("" : "+v"(tz)); const int wr = tz >> 8, wc = (tz >> 6) & 3, fr = tz & 15, fq = (tz >> 4) & 3;
        const int g8 = u.pn >> 1, row0 = u.pm * 256 + wr * 64 + fr, qq0 = wc * 32 + fq * 8;
        if (g8 == 4 || g8 == 5) {
            const int head = 2 * (u.pn & 1) + (qq0 >> 6), f0 = qq0 & 63;
#pragma unroll
            for (int ai = 0; ai < 2; ++ai)
#pragma unroll
                for (int m = 0; m < 4; ++m) { const int row = row0 + ai * 128 + m * 16; const f32x4* tb = (const f32x4*)(rope + (size_t)row_pos(row) * 64 + f0);
                    const f32x4 t0 = tb[0], t1 = tb[1], t2 = tb[2], t3 = tb[3];
                    const f32x4 xa = acc[ai][0][m][0], xb = acc[ai][0][m][1], ya = acc[ai][1][m][0], yb = acc[ai][1][m][1];
                    f32x4 o1a = {xa[0] * t0[0] - ya[0] * t0[1], xa[1] * t0[2] - ya[1] * t0[3], xa[2] * t1[0] - ya[2] * t1[1], xa[3] * t1[2] - ya[3] * t1[3]};
                    f32x4 o1b = {xb[0] * t2[0] - yb[0] * t2[1], xb[1] * t2[2] - yb[1] * t2[3], xb[2] * t3[0] - yb[2] * t3[1], xb[3] * t3[2] - yb[3] * t3[3]};
                    f32x4 o2a = {xa[0] * t0[1] + ya[0] * t0[0], xa[1] * t0[3] + ya[1] * t0[2], xa[2] * t1[1] + ya[2] * t1[0], xa[3] * t1[3] + ya[3] * t1[2]};
                    f32x4 o2b = {xb[0] * t2[1] + yb[0] * t2[0], xb[1] * t2[3] + yb[1] * t2[2], xb[2] * t3[1] + yb[2] * t3[0], xb[3] * t3[3] + yb[3] * t3[2]};
                    u16* op = O + (size_t)row * 4096 + g8 * 512 + head * 128 + f0;
                    *(u32x4*)op = pack8(o1a, o1b); *(u32x4*)(op + 64) = pack8(o2a, o2b); }
        } else {
#pragma unroll
            for (int ai = 0; ai < 2; ++ai)
#pragma unroll
                for (int m = 0; m < 4; ++m)
#pragma unroll
                    for (int bj = 0; bj < 2; ++bj) { f32x4 v0 = acc[ai][bj][m][0], v1 = acc[ai][bj][m][1];
                        if (g8 == 3) {
#pragma unroll
                            for (int e = 0; e < 4; ++e) { v0[e] = sigmoidf_(v0[e]); v1[e] = sigmoidf_(v1[e]); } }
                        else if (g8 == 7) {
#pragma unroll
                            for (int e = 0; e < 4; ++e) { v0[e] = siluf_(v0[e]); v1[e] = siluf_(v1[e]); } }
                        *(u32x4*)(O + (size_t)(row0 + ai * 128 + m * 16) * 4096 + u.pn * 256 + bj * 128 + qq0) = pack8(v0, v1); }
        }
    }
};
struct EpiIn1 { u16* O; const float2* rope; unsigned* kmax;
    __device__ __forceinline__ void operator()(const f32x4 (&acc)[2][2][4][2], const pg::Unit& u, int wr_, int wc_, int fr_, int fq_) const {
        int tz = threadIdx.x; asm volatile("" : "+v"(tz)); const int wr = tz >> 8, wc = (tz >> 6) & 3, fr = tz & 15, fq = (tz >> 4) & 3;
        const int row0 = u.pm * 256 + wr * 64 + fr; const bool rot = (u.pn < 8) && (u.pm >= 4);
        if (u.pn >= 4 && u.pn < 8) {
            float mx0 = 0.f, mx1 = 0.f;
#pragma unroll
            for (int ai = 0; ai < 2; ++ai)
#pragma unroll
                for (int m = 0; m < 4; ++m) {
                    float s0 = 0.f, s1 = 0.f;
#pragma unroll
                    for (int n = 0; n < 2; ++n)
#pragma unroll
                        for (int e = 0; e < 4; ++e) { s0 += acc[ai][0][m][n][e] * acc[ai][0][m][n][e]; s1 += acc[ai][1][m][n][e] * acc[ai][1][m][n][e]; }
                    s0 = swap32_add(swap16_add(s0)); s1 = swap32_add(swap16_add(s1)); mx0 = fmaxf(mx0, s0); mx1 = fmaxf(mx1, s1); }
            mx0 = row_max16(mx0); mx1 = row_max16(mx1);
            if ((tz & 63) == 0) { const int b = u.pm < 4 ? u.pm : ((u.pm - 4) >> 5), hd = 2 * (u.pn - 4);
                atomicMax(kmax + (b * 8 + hd) * 4 + wc, __float_as_uint(mx0)); atomicMax(kmax + (b * 8 + hd + 1) * 4 + wc, __float_as_uint(mx1)); }
        }
#pragma unroll
        for (int ai = 0; ai < 2; ++ai)
#pragma unroll
            for (int m = 0; m < 4; ++m) { const int row = row0 + ai * 128 + m * 16; u16* op = O + (size_t)row * 3072 + u.pn * 256 + wc * 32 + fq * 4;
                f32x4 t0 = {1.f, 0.f, 1.f, 0.f}, t1 = {1.f, 0.f, 1.f, 0.f};
                if (rot) { const int t = (row - NCTX) & 8191, pos = (wc & 1) ? (t & 63) : (t >> 6); const f32x4* tb = (const f32x4*)(rope + pos * 16 + fq * 4); t0 = tb[0]; t1 = tb[1]; }
#pragma unroll
                for (int bj = 0; bj < 2; ++bj) { const f32x4 x = acc[ai][bj][m][0], y = acc[ai][bj][m][1];
                    f32x4 o1 = {x[0] * t0[0] - y[0] * t0[1], x[1] * t0[2] - y[1] * t0[3], x[2] * t1[0] - y[2] * t1[1], x[3] * t1[2] - y[3] * t1[3]};
                    f32x4 o2 = {x[0] * t0[1] + y[0] * t0[0], x[1] * t0[3] + y[1] * t0[2], x[2] * t1[1] + y[2] * t1[0], x[3] * t1[3] + y[3] * t1[2]};
                    *(u32x2*)(op + bj * 128) = (u32x2){cvtpk(o1[0], o1[1]), cvtpk(o1[2], o1[3])}; *(u32x2*)(op + bj * 128 + 16) = (u32x2){cvtpk(o2[0], o2[1]), cvtpk(o2[2], o2[3])}; } }
    }
};
template <int L> struct EpiOut { const Params* p;
    __device__ __forceinline__ void operator()(const f32x4 (&acc)[2][2][4][2], const pg::Unit& u, int wr_, int wc_, int fr_, int fq_) const {
        int tz = threadIdx.x; asm volatile("" : "+v"(tz)); const int wr = tz >> 8, wc = (tz >> 6) & 3, fr = tz & 15, fq = (tz >> 4) & 3;
        const int row0 = u.pm * 256 + wr * 64 + fr, c0 = u.pn * 256 + wc * 32 + fq * 8;
        const float* gate = (const float*)(p->ws + WS_MOD) + (size_t)(L * 5 + row_modvec(u.pm * 256)) * 6144 + 2 * 1024 + c0;
        const f32x4 g00 = *(const f32x4*)gate, g01 = *(const f32x4*)(gate + 4), g10 = *(const f32x4*)(gate + 128), g11 = *(const f32x4*)(gate + 132);
#pragma unroll
        for (int ai = 0; ai < 2; ++ai)
#pragma unroll
            for (int m = 0; m < 4; ++m) { const int r = row0 + ai * 128 + m * 16;
                const float* src = (L == 0 ? l0_in_row(*p, r) : (const float*)h_row(*p, r)) + c0; float* dst = h_row(*p, r) + c0;
                *(f32x4*)dst = *(const f32x4*)src + g00 * acc[ai][0][m][0]; *(f32x4*)(dst + 4) = *(const f32x4*)(src + 4) + g01 * acc[ai][0][m][1];
                *(f32x4*)(dst + 128) = *(const f32x4*)(src + 128) + g10 * acc[ai][1][m][0]; *(f32x4*)(dst + 132) = *(const f32x4*)(src + 132) + g11 * acc[ai][1][m][1]; }
    }
};
struct EpiUp { u16* H; const LAS int* OFF;
    __device__ __forceinline__ void operator()(const f32x4 (&acc)[2][2][4][2], const pg::Unit& u, int wr_, int wc_, int fr_, int fq_) const {
        int tz = threadIdx.x; asm volatile("" : "+v"(tz)); const int wr = tz >> 8, wc = (tz >> 6) & 3, fr = tz & 15, fq = (tz >> 4) & 3;
        const int rl0 = wr * 64 + fr; u16* base = H + (size_t)(u.off + u.pm * 256) * 512 + u.pn * 128 + wc * 32 + fq * 8;
#pragma unroll
        for (int ai = 0; ai < 2; ++ai)
#pragma unroll
            for (int m = 0; m < 4; ++m) { const int rl = rl0 + ai * 128 + m * 16;
                if (rl < u.nv) { f32x4 a = acc[ai][0][m][0], b = acc[ai][0][m][1]; const f32x4 c = acc[ai][1][m][0], d = acc[ai][1][m][1];
#pragma unroll
                    for (int e = 0; e < 4; ++e) { a[e] = siluf_(a[e]) * c[e]; b[e] = siluf_(b[e]) * d[e]; }
                    *(u32x4*)(base + (size_t)rl * 512) = pack8(a, b); } }
    }
};
struct EpiDown { u16* Y; const LAS int* OFF;
    __device__ __forceinline__ void operator()(const f32x4 (&acc)[2][2][4][2], const pg::Unit& u, int wr_, int wc_, int fr_, int fq_) const {
        int tz = threadIdx.x; asm volatile("" : "+v"(tz)); const int wr = tz >> 8, wc = (tz >> 6) & 3, fr = tz & 15, fq = (tz >> 4) & 3;
        const int rl0 = wr * 64 + fr; u16* base = Y + (size_t)(u.off + u.pm * 256) * 1024 + u.pn * 256 + wc * 32 + fq * 8;
#pragma unroll
        for (int ai = 0; ai < 2; ++ai)
#pragma unroll
            for (int m = 0; m < 4; ++m) { const int rl = rl0 + ai * 128 + m * 16;
                if (rl < u.nv) {
#pragma unroll
                    for (int bj = 0; bj < 2; ++bj) *(u32x4*)(base + (size_t)rl * 1024 + bj * 128) = pack8(acc[ai][bj][m][0], acc[ai][bj][m][1]); } }
    }
};

__device__ __forceinline__ void phase2(const Params& p, LAS unsigned char* lds, int bid, int nblk) {
    pg::DenseSched S; S.init(p.ws + WS_X1, p.ws + WS_WINE, 1024, 0, 132, 16, nblk, bid);
    EpiIn0 E{(u16*)(p.ws + WS_PROJ), (const float2*)(p.ws + WS_ROPE1)};
    pg::gemm_phase<true>(lds, 1024, S, E);
}
__device__ __forceinline__ void phase_inproj1(const Params& p, LAS unsigned char* lds, int bid, int nblk) {
    pg::DenseSched S; S.init(p.ws + WS_X1, p.ws + WS_WINO, 1024, 0, 132, 12, nblk, bid);
    EpiIn1 E{(u16*)(p.ws + WS_PROJ), (const float2*)(p.ws + WS_ROPE2), (unsigned*)(p.ws + WS_CTL) + CW_KMAX};
    pg::gemm_phase<false>(lds, 1024, S, E);
}
template <int L> __device__ __forceinline__ void phase_outproj(const Params& p, LAS unsigned char* lds, int bid, int nblk) {
    pg::DenseSched S; S.init(p.ws + WS_X1, p.ws + (L == 0 ? WS_WOUTE : WS_WOUTO), 1024, L == 0 ? 0 : 4, L == 0 ? 132 : 128, 4, nblk, bid);
    EpiOut<L> E{&p};
    pg::gemm_phase<true>(lds, 1024, S, E);
    __syncthreads();
    const int ngemm = (L == 0 ? 132 : 128) * 4, extra = ngemm % nblk;
    const int nconv = nblk - extra, cid = bid - extra;
    if (cid >= 0) { MoeJob jf{&p, L}; conv_stream(cid, nconv, MOE_CONV_UNITS, jf, lds); }
}

#define KSWZ(row, colB) ((row) * 256 + ((colB) ^ (((row) & 15) << 4)))
__device__ __forceinline__ int v_st(int k, int c) { const int kk = (k & ~0xC) | ((k & 4) << 1) | ((k & 8) >> 1); return ((kk >> 3) * 4 + (c >> 5)) * 512 + ((kk & 7) * 32 + (c & 31)) * 2; }
__device__ __forceinline__ int v_rd_base(int lane) { return ((lane & 3) << 3) | (((lane >> 2) & 3) << 6) | (((lane >> 4) & 1) << 5) | (((lane >> 5) & 1) << 8); }
__device__ __forceinline__ s16x4 tr_rd(const LAS unsigned char* a) { return __builtin_bit_cast(s16x4, __builtin_amdgcn_ds_read_tr16_b64_v4i16((LAS v4i16_t*)a)); }
__device__ __forceinline__ bf16x8 tr_frag(const LAS unsigned char* a, int d0, int ks) {
    const s16x4 l = tr_rd(a + d0 * 512 + ks * 4096), h = tr_rd(a + d0 * 512 + ks * 4096 + 2048);
    return (bf16x8){l[0], l[1], l[2], l[3], h[0], h[1], h[2], h[3]};
}
#define PK4(P, BASE, OUT) do { unsigned a0 = cvtpk(P[BASE + 0], P[BASE + 1]), a1 = cvtpk(P[BASE + 2], P[BASE + 3]);   \
    unsigned b0 = cvtpk(P[BASE + 4], P[BASE + 5]), b1 = cvtpk(P[BASE + 6], P[BASE + 7]);                              \
    auto r0 = __builtin_amdgcn_permlane32_swap(a0, b0, false, false); auto r1 = __builtin_amdgcn_permlane32_swap(a1, b1, false, false); \
    u32x4 w = {r0[0], r1[0], r0[1], r1[1]}; OUT = __builtin_bit_cast(bf16x8, w); } while (0)
__device__ __forceinline__ void pv_tile(f32x16 (&o)[4], const LAS unsigned char* vb, bf16x8 pa0, bf16x8 pa1, bf16x8 pa2, bf16x8 pa3) {
#pragma unroll
    for (int d0 = 0; d0 < 4; ++d0) {
        { const bf16x8 b0 = tr_frag(vb, d0, 0), b1 = tr_frag(vb, d0, 1);
          o[d0] = __builtin_amdgcn_mfma_f32_32x32x16_bf16(pa0, b0, o[d0], 0, 0, 0);
          o[d0] = __builtin_amdgcn_mfma_f32_32x32x16_bf16(pa1, b1, o[d0], 0, 0, 0); }
        { const bf16x8 b2 = tr_frag(vb, d0, 2), b3 = tr_frag(vb, d0, 3);
          o[d0] = __builtin_amdgcn_mfma_f32_32x32x16_bf16(pa2, b2, o[d0], 0, 0, 0);
          o[d0] = __builtin_amdgcn_mfma_f32_32x32x16_bf16(pa3, b3, o[d0], 0, 0, 0); }
    }
}
template <int OFF> __device__ __forceinline__ s16x4 tr_asm(unsigned vb) { s16x4 r; asm volatile("ds_read_b64_tr_b16 %0, %1 offset:%2" : "=&v"(r) : "v"(vb), "i"(OFF) : "memory"); return r; }
template <int G> __device__ __forceinline__ void pv_rd(unsigned vb, s16x4 (&r)[4]) {
    constexpr int B = (G >> 1) * 512 + (G & 1) * 8192;
    r[0] = tr_asm<B>(vb); r[1] = tr_asm<B + 2048>(vb); r[2] = tr_asm<B + 4096>(vb); r[3] = tr_asm<B + 6144>(vb);
}
#define PV_WAIT(N, R) asm volatile("s_waitcnt lgkmcnt(" #N ")" : "+v"(R[0]), "+v"(R[1]), "+v"(R[2]), "+v"(R[3]) :: "memory")
#define PKLH(L, H) (bf16x8){L[0], L[1], L[2], L[3], H[0], H[1], H[2], H[3]}
#define PV_MMA(G, R, PA, PB) do { o[(G) >> 1] = __builtin_amdgcn_mfma_f32_32x32x16_bf16(PA, PKLH(R[0], R[1]), o[(G) >> 1], 0, 0, 0); \
                                  o[(G) >> 1] = __builtin_amdgcn_mfma_f32_32x32x16_bf16(PB, PKLH(R[2], R[3]), o[(G) >> 1], 0, 0, 0); } while (0)
__device__ __forceinline__ void pv_tile_asm(f32x16 (&o)[4], unsigned vb, bf16x8 pa0, bf16x8 pa1, bf16x8 pa2, bf16x8 pa3) {
    s16x4 rA[4], rB[4], rC[4];
    pv_rd<0>(vb, rA); pv_rd<1>(vb, rB); pv_rd<2>(vb, rC);
    PV_WAIT(8, rA); PV_MMA(0, rA, pa0, pa1); pv_rd<3>(vb, rA);
    PV_WAIT(8, rB); PV_MMA(1, rB, pa2, pa3); pv_rd<4>(vb, rB);
    PV_WAIT(8, rC); PV_MMA(2, rC, pa0, pa1); pv_rd<5>(vb, rC);
    PV_WAIT(8, rA); PV_MMA(3, rA, pa2, pa3); pv_rd<6>(vb, rA);
    PV_WAIT(8, rB); PV_MMA(4, rB, pa0, pa1); pv_rd<7>(vb, rB);
    PV_WAIT(8, rC); PV_MMA(5, rC, pa2, pa3);
    PV_WAIT(4, rA); PV_MMA(6, rA, pa0, pa1);
    PV_WAIT(0, rB); PV_MMA(7, rB, pa2, pa3);
}
#undef PV_WAIT
#undef PV_MMA
#undef PKLH
template <bool SUFFIX, bool MAXOP> __device__ __forceinline__ float scan128(const LAS float* a, int t) {
    float acc = MAXOP ? -3.0e38f : 0.f;
#pragma unroll 4
    for (int r4 = 0; r4 < 32; ++r4) { const f32x4 v = *(const LAS f32x4*)(a + r4 * 4);
#pragma unroll
        for (int e = 0; e < 4; ++e) { const int r = r4 * 4 + e; const bool in = SUFFIX ? (r >= t) : (r <= t); if (MAXOP) acc = in ? fmaxf(acc, v[e]) : acc; else acc += in ? v[e] : 0.f; } }
    return acc;
}
constexpr int SC_ARR = 131072;

__device__ __forceinline__ void s1_unit(const Params& p, LAS unsigned char* lds, int u) {
    const int tid = threadIdx.x, wid = tid >> 6, lane = tid & 63, r32 = lane & 31, hi = lane >> 5;
    const int ch = u % NCH, t1 = u / NCH, h = t1 & 3, b = (t1 >> 2) & 3, mx = t1 >> 4;
    const int row0 = chunk_row0(b, ch);
    LAS unsigned char* KIMG = lds; LAS unsigned char* VF = lds + 32768; LAS unsigned char* VB = lds + 65536;
    LAS float* arr = (LAS float*)(lds + SC_ARR);
    LAS float *IF = arr, *IB = arr + 128, *FF = arr + 256, *FB = arr + 384, *WF = arr + 512, *WB = arr + 640, *SCL = arr + 768, *RED = arr + 1024;
    const u16* proj = (const u16*)(p.ws + WS_PROJ);
    const int kcol = (mx ? 2560 : 512) + h * 128, vcol = (mx ? 3072 : 1024) + h * 128;
    if (mx == 0) {
        if (tid < 128) { const float* g = (const float*)(p.ws + WS_GATES) + (size_t)(row0 + tid) * 16; IF[tid] = g[h]; IB[tid] = g[4 + h]; FF[tid] = g[8 + h]; FB[tid] = g[12 + h]; }
        __syncthreads();
        if (tid < 128) { const float bf = scan128<false, false>(FF, tid), bb = scan128<true, false>(FB, tid), Bf = scan128<false, false>(FF, 127), Bb = scan128<true, false>(FB, 0);
            float wlf = Bf - bf + IF[tid], wlb = Bb - bb + IB[tid];
            WF[tid] = wlf; WB[tid] = wlb;
            if (tid == 0) { SCL[0] = Bf; SCL[1] = Bb; } }
        __syncthreads();
        if (wid < 2) { LAS float* W = wid ? WB : WF; float m = wave_max(fmaxf(W[lane], W[lane + 64])); if (lane == 0) SCL[2 + wid] = m; }
        __syncthreads();
        const float af = SCL[2], ab = SCL[3];
        if (tid == 0) { float* st = (float*)(p.ws + WS_STATS); const int c0 = (b * 4 + h) * 2;
            st[((size_t)(c0 + 0) * NCH + ch) * 2 + 0] = SCL[0]; st[((size_t)(c0 + 0) * NCH + ch) * 2 + 1] = af;
            st[((size_t)(c0 + 1) * NCH + ch) * 2 + 0] = SCL[1]; st[((size_t)(c0 + 1) * NCH + ch) * 2 + 1] = ab; }
        __syncthreads();
        if (tid < 128) { float a = WF[tid], c = WB[tid]; WF[tid] = __expf(a - af); WB[tid] = __expf(c - ab); }
    } else {
        const float lgf = p.in[11][h], lgb = p.in[11][4 + h];
        if (tid < 128) { WF[tid] = __expf(lgf * (float)(127 - tid)); WB[tid] = __expf(lgb * (float)tid); }
    }
    __syncthreads();
#pragma unroll
    for (int i = 0; i < 4; ++i) { const int pi = tid + i * NTHR, s = pi >> 4, c8 = (pi & 15) * 8;
        const u16* rp = proj + (size_t)(row0 + s) * 4096;
        const u32x4 kv = *(const u32x4*)(rp + kcol + c8), vv = *(const u32x4*)(rp + vcol + c8);
        const int off = (s >> 6) * 16384 + v_st(s & 63, c8);
        *(LAS u32x4*)(KIMG + off) = kv;
        const float wf = WF[s], wb = WB[s]; u32x4 of, ob;
#pragma unroll
        for (int e = 0; e < 4; ++e) { float lo = bflo(vv[e]), hh = bfhi(vv[e]); of[e] = cvtpk(lo * wf, hh * wf); ob[e] = cvtpk(lo * wb, hh * wb); }
        *(LAS u32x4*)(VF + off) = of; *(LAS u32x4*)(VB + off) = ob; }
    __syncthreads();
    {   const int dir = wid >> 2, kblk = wid & 3; const int vrb = v_rd_base(lane);
        const LAS unsigned char* ka = KIMG + vrb; const LAS unsigned char* va = (dir ? VB : VF) + vrb;
        f32x16 acc[4] = {};
#pragma unroll
        for (int ks16 = 0; ks16 < 8; ++ks16) { const int tile = ks16 >> 2, ks = ks16 & 3;
            const bf16x8 a = tr_frag(ka + tile * 16384, kblk, ks);
#pragma unroll
            for (int d0 = 0; d0 < 4; ++d0) { const bf16x8 bb = tr_frag(va + tile * 16384, d0, ks); acc[d0] = __builtin_amdgcn_mfma_f32_32x32x16_bf16(a, bb, acc[d0], 0, 0, 0); } }
        const int chain = ((mx * 4 + b) * 4 + h) * 2 + dir;
        u16* base = (u16*)(p.ws + WS_STATES) + ((size_t)chain * NCH + ch) * 16384;
#pragma unroll
        for (int d0 = 0; d0 < 4; ++d0)
#pragma unroll
            for (int g = 0; g < 4; ++g) { u32x2 w = {cvtpk(acc[d0][4 * g], acc[d0][4 * g + 1]), cvtpk(acc[d0][4 * g + 2], acc[d0][4 * g + 3])};
                *(u32x2*)(base + (d0 * 32 + r32) * 128 + kblk * 32 + 8 * g + 4 * hi) = w; }
    }
    if (mx == 0) {
        const int dir = tid >> 8, k = tid & 127, half = (tid >> 7) & 1; LAS float* W = dir ? WB : WF; float s = 0;
#pragma unroll 16
        for (int i = 0; i < 64; ++i) { const int t = half * 64 + i; s += W[t] * bf2f(*(const LAS u16*)(KIMG + half * 16384 + v_st(i, k))); }
        RED[(dir * 2 + half) * 128 + k] = s;
        __syncthreads();
        if (half == 0) { const int chain = (b * 4 + h) * 2 + dir; ((float*)(p.ws + WS_NV))[((size_t)chain * NCH + ch) * 128 + k] = RED[(dir * 2) * 128 + k] + RED[(dir * 2 + 1) * 128 + k]; }
    }
    __syncthreads();
}

__device__ __forceinline__ int chain_chunk(int dir, int i) { return dir == 0 ? i : (i < 2 ? 1 - i : 67 - i); }

__device__ __forceinline__ void phase_s2(const Params& p, int bid, int nblk) {
    const float* st = (const float*)(p.ws + WS_STATS);
    for (int gid = bid * NTHR + threadIdx.x; gid < 64 * 2048; gid += nblk * NTHR) {
        const int chain = gid >> 11, v = (gid >> 4) & 127, kc = gid & 15, dir = chain & 1, mx = chain >> 5, h = (chain >> 1) & 3;
        u16* base = (u16*)(p.ws + WS_STATES) + (size_t)chain * NCH * 16384 + v * 128 + kc * 8;
        float c[8] = {0, 0, 0, 0, 0, 0, 0, 0}; float nvc[8] = {0, 0, 0, 0, 0, 0, 0, 0};
        float m = 0.f; const float rdec = mx ? __expf(128.f * p.in[11][dir * 4 + h]) : 1.f;
        const bool do_n = (mx == 0 && v == 0);
        for (int i0 = 0; i0 < NCH; i0 += 6) {
            u32x4 dd[6]; float Bv[6], av[6];
#pragma unroll
            for (int k = 0; k < 6; ++k) { const int ch = chain_chunk(dir, i0 + k); dd[k] = *(const u32x4*)(base + (size_t)ch * 16384);
                if (mx == 0) { Bv[k] = st[((size_t)chain * NCH + ch) * 2]; av[k] = st[((size_t)chain * NCH + ch) * 2 + 1]; } else { Bv[k] = 0.f; av[k] = 0.f; } }
#pragma unroll
            for (int k = 0; k < 6; ++k) {
                const int ch = chain_chunk(dir, i0 + k);
                float dec, sc;
                if (mx == 0) { const float mn = fmaxf(Bv[k] + m, av[k]); dec = __expf(Bv[k] + m - mn); sc = __expf(av[k] - mn);
                    if (v == 0 && kc == 0) ((float*)(p.ws + WS_MST))[(size_t)chain * NCH + ch] = m;
                    m = mn;
                } else { dec = rdec; sc = 1.f; }
                const u32x4 d = dd[k];
                *(u32x4*)(base + (size_t)ch * 16384) = (u32x4){cvtpk(c[0], c[1]), cvtpk(c[2], c[3]), cvtpk(c[4], c[5]), cvtpk(c[6], c[7])};
#pragma unroll
                for (int e = 0; e < 4; ++e) { c[2 * e] = dec * c[2 * e] + sc * bflo(d[e]); c[2 * e + 1] = dec * c[2 * e + 1] + sc * bfhi(d[e]); }
                if (do_n) { float* nq = (float*)(p.ws + WS_NV) + ((size_t)chain * NCH + ch) * 128 + kc * 8;
#pragma unroll
                    for (int e = 0; e < 8; ++e) { float dn = nq[e]; nq[e] = nvc[e]; nvc[e] = dec * nvc[e] + sc * dn; } }
            }
        }
    }
}

template <int NQ>
__device__ __forceinline__ void qkt_init(f32x16& p0, f32x16& p1, const LAS unsigned char* Ks, const bf16x8* qr, int r32, int hi, int colB0, const f32x16& ini) {
    {   const int cb = colB0 + (hi * 8) * 2;
        const bf16x8 b0 = *(const LAS bf16x8*)(Ks + KSWZ(r32, cb)), b1 = *(const LAS bf16x8*)(Ks + KSWZ(32 + r32, cb));
        p0 = __builtin_amdgcn_mfma_f32_32x32x16_bf16(b0, qr[0], ini, 0, 0, 0);
        p1 = __builtin_amdgcn_mfma_f32_32x32x16_bf16(b1, qr[0], ini, 0, 0, 0); }
#pragma unroll
    for (int d0 = 1; d0 < NQ; ++d0) { const int cb = colB0 + (d0 * 16 + hi * 8) * 2;
        const bf16x8 b0 = *(const LAS bf16x8*)(Ks + KSWZ(r32, cb)), b1 = *(const LAS bf16x8*)(Ks + KSWZ(32 + r32, cb));
        p0 = __builtin_amdgcn_mfma_f32_32x32x16_bf16(b0, qr[d0], p0, 0, 0, 0);
        p1 = __builtin_amdgcn_mfma_f32_32x32x16_bf16(b1, qr[d0], p1, 0, 0, 0); }
}
template <int NQ>
__device__ __forceinline__ void qkt(f32x16& p0, f32x16& p1, const LAS unsigned char* Ks, const bf16x8* qr, int r32, int hi, int colB0) {
    p0 = f32x16{}; p1 = f32x16{};
#pragma unroll
    for (int d0 = 0; d0 < NQ; ++d0) { const int cb = colB0 + (d0 * 16 + hi * 8) * 2;
        const bf16x8 b0 = *(const LAS bf16x8*)(Ks + KSWZ(r32, cb)), b1 = *(const LAS bf16x8*)(Ks + KSWZ(32 + r32, cb));
        p0 = __builtin_amdgcn_mfma_f32_32x32x16_bf16(b0, qr[d0], p0, 0, 0, 0);
        p1 = __builtin_amdgcn_mfma_f32_32x32x16_bf16(b1, qr[d0], p1, 0, 0, 0); }
}

__device__ __forceinline__ void s3_unit(const Params& p, LAS unsigned char* lds, int u) {
    const int tid = threadIdx.x, wid = tid >> 6, lane = tid & 63, r32 = lane & 31, hi = lane >> 5;
    const int ch = u % NCH, t1 = u / NCH, h = t1 & 3, b = (t1 >> 2) & 3, mx = t1 >> 4;
    const int row0 = chunk_row0(b, ch);
    LAS unsigned char* KT = lds; LAS unsigned char* VI = lds + 32768; LAS unsigned char* CT = lds + 65536;
    LAS float* arr = (LAS float*)(lds + SC_ARR);
    LAS float *U = arr, *MXA = arr + 256, *WI = arr + 512, *FL = arr + 768, *NVL = arr + 1024, *HS = arr + 1280  , *TMP = arr + 1536  ;
    const u16* proj = (const u16*)(p.ws + WS_PROJ);
    const int qcol = (mx ? 2048 : 0) + h * 128, kcol = qcol + 512, vcol = qcol + 1024, gcol = qcol + 1536;
    const int chain0 = ((mx * 4 + b) * 4 + h) * 2;
    if (mx == 0) {
        LAS float *IF = TMP, *IB = TMP + 128, *FF = TMP + 256, *FB = TMP + 384, *BF = TMP + 512, *BB = TMP + 640;
        if (tid < 128) { const float* g = (const float*)(p.ws + WS_GATES) + (size_t)(row0 + tid) * 16; IF[tid] = g[h]; IB[tid] = g[4 + h]; FF[tid] = g[8 + h]; FB[tid] = g[12 + h]; }
        if (tid >= 256) { const int d = (tid >> 7) & 1, k = tid & 127; NVL[d * 128 + k] = ((const float*)(p.ws + WS_NV))[((size_t)(chain0 - 0 + d) * NCH + ch) * 128 + k]; }
        __syncthreads();
        if (tid < 128) { const float bf = scan128<false, false>(FF, tid), bb = scan128<true, false>(FB, tid);
            BF[tid] = bf; BB[tid] = bb; U[tid] = IF[tid] - bf; U[128 + tid] = IB[tid] - bb; }
        __syncthreads();
        if (tid < 128) { const float pf = scan128<false, true>(U, tid), pb = scan128<true, true>(U + 128, tid);
            const float mf = ((const float*)(p.ws + WS_MST))[(size_t)chain0 * NCH + ch], mb = ((const float*)(p.ws + WS_MST))[(size_t)(chain0 + 1) * NCH + ch];
            const float Mf = fmaxf(mf, pf), Mb = fmaxf(mb, pb);
            MXA[tid] = Mf; MXA[128 + tid] = Mb; WI[tid] = __expf(mf - Mf); WI[128 + tid] = __expf(mb - Mb);
            FL[tid] = __expf(-(BF[tid] + Mf)); FL[128 + tid] = __expf(-(BB[tid] + Mb)); }
    } else {
        const float lgf = p.in[11][h], lgb = p.in[11][4 + h];
        if (tid < 128) { const float t = (float)tid; U[tid] = -lgf * t; MXA[tid] = -lgf * t; WI[tid] = __expf(lgf * (t + 1.f));
            U[128 + tid] = lgb * t; MXA[128 + tid] = lgb * t; WI[128 + tid] = __expf(lgb * (128.f - t)); FL[tid] = 0.f; FL[128 + tid] = 0.f; }
        if (tid >= 256) NVL[tid - 256] = 0.f;
    }
    const u16* cf = (const u16*)(p.ws + WS_STATES) + ((size_t)chain0 * NCH + ch) * 16384;
    const u16* cbp = (const u16*)(p.ws + WS_STATES) + ((size_t)(chain0 + 1) * NCH + ch) * 16384;
#pragma unroll
    for (int i = 0; i < 4; ++i) { const int pi = tid + i * NTHR, s = pi >> 4, c8 = (pi & 15) * 8;
        const u16* rp = proj + (size_t)(row0 + s) * 4096;
        *(LAS u32x4*)(KT + KSWZ(s, c8 * 2)) = *(const u32x4*)(rp + kcol + c8);
        *(LAS u32x4*)(VI + (s >> 6) * 16384 + v_st(s & 63, c8)) = *(const u32x4*)(rp + vcol + c8);
        *(LAS u32x4*)(CT + KSWZ(s, c8 * 2)) = *(const u32x4*)(cf + s * 128 + c8);
        *(LAS u32x4*)(CT + 32768 + KSWZ(s, c8 * 2)) = *(const u32x4*)(cbp + s * 128 + c8); }
    const int dir = wid >> 2, tb = wid & 3, t = tb * 32 + r32;
    bf16x8 qr[8];
    { const u16* qp = proj + (size_t)(row0 + t) * 4096 + qcol + hi * 8;
#pragma unroll
      for (int d0 = 0; d0 < 8; ++d0) qr[d0] = *(const bf16x8*)(qp + d0 * 16); }
    __syncthreads();
    f32x16 o[4] = {};
    {
        const LAS unsigned char* C = CT + dir * 32768;
#pragma unroll
        for (int dv = 0; dv < 4; ++dv)
#pragma unroll
            for (int d0 = 0; d0 < 8; ++d0) { const bf16x8 bb = *(const LAS bf16x8*)(C + KSWZ(dv * 32 + r32, (d0 * 16 + hi * 8) * 2)); o[dv] = __builtin_amdgcn_mfma_f32_32x32x16_bf16(qr[d0], bb, o[dv], 0, 0, 0); }
#pragma unroll
        for (int r = 0; r < 16; ++r) { const float w = WI[dir * 128 + tb * 32 + crow(r, hi)];
#pragma unroll
            for (int dv = 0; dv < 4; ++dv) o[dv][r] *= w; }
    }
    float qn = 0.f;
#pragma unroll
    for (int d0 = 0; d0 < 8; ++d0)
#pragma unroll
        for (int j = 0; j < 8; ++j) qn += bf2f((u16)qr[d0][j]) * NVL[dir * 128 + d0 * 16 + hi * 8 + j];
    qn = swap_add(qn);
    float rs = 0.f; const float Mt = MXA[dir * 128 + t];
    const int vrb = v_rd_base(lane);
#pragma unroll 1
    for (int kt = 0; kt < 2; ++kt) {
        f32x16 p0, p1; qkt<8>(p0, p1, KT + kt * 64 * 256, qr, r32, hi, 0);
#pragma unroll
        for (int r = 0; r < 16; ++r) { const int s0 = kt * 64 + crow(r, hi), s1 = s0 + 32;
            const bool v0 = dir ? (s0 >= t) : (s0 <= t), v1 = dir ? (s1 >= t) : (s1 <= t);
            const float f0 = v0 ? __builtin_amdgcn_exp2f((U[dir * 128 + s0] - Mt) * LOG2E) : 0.f, f1 = v1 ? __builtin_amdgcn_exp2f((U[dir * 128 + s1] - Mt) * LOG2E) : 0.f;
            p0[r] *= f0; p1[r] *= f1; rs += p0[r] + p1[r]; }
        bf16x8 pa0, pa1, pa2, pa3; PK4(p0, 0, pa0); PK4(p0, 8, pa1); PK4(p1, 0, pa2); PK4(p1, 8, pa3);
        pv_tile(o, VI + kt * 16384 + vrb, pa0, pa1, pa2, pa3);
    }
    rs = swap_add(rs);
    if (mx == 0) { const float den = rs + WI[dir * 128 + t] * qn; const float hs = 1.f / fmaxf(fabsf(den), FL[dir * 128 + t]);
        if (hi == 0) HS[wid * 32 + r32] = hs;
        WAIT_L(0);
#pragma unroll
        for (int r = 0; r < 16; ++r) { const float s = HS[wid * 32 + crow(r, hi)];
#pragma unroll
            for (int dv = 0; dv < 4; ++dv) o[dv][r] *= s; } }
    __syncthreads();
    LAS float* T = (LAS float*)lds;
    if (dir == 1) {
#pragma unroll
        for (int dv = 0; dv < 4; ++dv)
#pragma unroll
            for (int r = 0; r < 16; ++r) T[(tb * 32 + crow(r, hi)) * 132 + dv * 32 + r32] = o[dv][r]; }
    __syncthreads();
    if (dir == 0) {
#pragma unroll
        for (int dv = 0; dv < 4; ++dv)
#pragma unroll
            for (int r = 0; r < 16; ++r) T[(tb * 32 + crow(r, hi)) * 132 + dv * 32 + r32] += o[dv][r]; }
    __syncthreads();
    {
        const int tt = tid >> 2, sg = tid & 3, row = row0 + tt;
        const float* G = (mx ? p.in[12] : p.in[10]) + h * 128 + sg * 32;
        const u16* gp = proj + (size_t)row * 4096 + gcol + sg * 32;
        u32x4 gw[4];
#pragma unroll
        for (int i = 0; i < 4; ++i) gw[i] = *(const u32x4*)(gp + i * 8);
        float x[32], s1 = 0.f, s2 = 0.f;
#pragma unroll
        for (int i = 0; i < 8; ++i) { const f32x4 v = *(const LAS f32x4*)(T + tt * 132 + sg * 32 + i * 4); x[4 * i] = v[0]; x[4 * i + 1] = v[1]; x[4 * i + 2] = v[2]; x[4 * i + 3] = v[3]; }
        float gt[32];
#pragma unroll
        for (int i = 0; i < 4; ++i)
#pragma unroll
            for (int e = 0; e < 4; ++e) { gt[i * 8 + 2 * e] = bflo(gw[i][e]); gt[i * 8 + 2 * e + 1] = bfhi(gw[i][e]); }
#pragma unroll
        for (int i = 0; i < 32; ++i) { if (mx == 0) x[i] *= gt[i]; s1 += x[i]; s2 += x[i] * x[i]; }
        s1 += dpp_f<0xB1>(s1); s1 += dpp_f<0x4E>(s1); s2 += dpp_f<0xB1>(s2); s2 += dpp_f<0x4E>(s2);
        const float mu = s1 * (1.f / 128.f), var = fmaxf(s2 * (1.f / 128.f) - mu * mu, 0.f), rstd = rsqrtf(var + EPS);
        u16* op = (u16*)(p.ws + WS_X1) + (size_t)row * 1024 + mx * 512 + h * 128 + sg * 32;
#pragma unroll
        for (int i = 0; i < 4; ++i) { const f32x4 g0 = *(const f32x4*)(G + i * 8), g1 = *(const f32x4*)(G + i * 8 + 4); float y[8];
#pragma unroll
            for (int e = 0; e < 8; ++e) { y[e] = (x[i * 8 + e] - mu) * rstd * (e < 4 ? g0[e] : g1[e - 4]); if (mx) y[e] *= gt[i * 8 + e]; }
            *(u32x4*)(op + i * 8) = (u32x4){cvtpk(y[0], y[1]), cvtpk(y[2], y[3]), cvtpk(y[4], y[5]), cvtpk(y[6], y[7])}; }
    }
    __syncthreads();
}

constexpr int R_WT = 0;
constexpr int R_PITCH = 1028;
constexpr int MOE_ARR = 148480;
__device__ __forceinline__ void reduce36(float (&a)[36], float (&t)[9]) {
    float s[18];
#pragma unroll
    for (int j = 0; j < 18; ++j) { auto rr = __builtin_amdgcn_permlane32_swap(__float_as_uint(a[j]), __float_as_uint(a[j + 18]), false, false); s[j] = __uint_as_float(rr[0]) + __uint_as_float(rr[1]); }
#pragma unroll
    for (int j = 0; j < 9; ++j) { auto rr = __builtin_amdgcn_permlane16_swap(__float_as_uint(s[j]), __float_as_uint(s[j + 9]), false, false); t[j] = row_sum16(__uint_as_float(rr[0]) + __uint_as_float(rr[1])); }
}
template <int L>
__device__ __forceinline__ void route_row(const Params& p, const LAS float* lg, int r, int slot, LAS int* LCNT, LAS int* SLOT, int lane) {
    const float g0 = lg[0], g1 = lg[1], g2 = lg[2], g3 = lg[3];
    int grp = 0; float gm = g0; if (g1 > gm) { gm = g1; grp = 1; } if (g2 > gm) { gm = g2; grp = 2; } if (g3 > gm) { gm = g3; grp = 3; }
    const float pg = 1.f / (__expf(g0 - gm) + __expf(g1 - gm) + __expf(g2 - gm) + __expf(g3 - gm));
    int i0 = 0, i1 = -1; float m0 = -3.0e38f, m1 = -3.0e38f;
#pragma unroll
    for (int j = 0; j < 8; ++j) { const float v = lg[4 + grp * 8 + j];
        if (v > m0) { m1 = m0; i1 = i0; m0 = v; i0 = j; } else if (v > m1) { m1 = v; i1 = j; } }
    const float e1 = __expf(m1 - m0), den = 1.f / (1.f + e1);
    const float w0 = pg * den, w1 = pg * e1 * den;
    if (lane == 0) { const int ea = grp * 8 + i0, eb = grp * 8 + i1;
        const int la = (int)__hip_atomic_fetch_add((LAS unsigned*)&LCNT[ea], 1u, __ATOMIC_RELAXED, __HIP_MEMORY_SCOPE_WORKGROUP), lb = (int)__hip_atomic_fetch_add((LAS unsigned*)&LCNT[eb], 1u, __ATOMIC_RELAXED, __HIP_MEMORY_SCOPE_WORKGROUP);
        LAS int* sl = SLOT + slot * 4; sl[0] = ea; sl[1] = eb; sl[2] = la; sl[3] = lb;
        int* asge = (int*)(p.ws + WS_ASGE); float* asgg = (float*)(p.ws + WS_ASGG);
        asge[2 * r] = ea; asge[2 * r + 1] = eb; asgg[2 * r] = w0; asgg[2 * r + 1] = w1; }
}
template <int L>
__device__ __forceinline__ void phase_router(const Params& p, LAS unsigned char* lds, int bid, int nblk) {
    const int tid = threadIdx.x, wid = tid >> 6, lane = tid & 63;
    LAS float* wt = (LAS float*)(lds + R_WT);
    for (int i = tid; i < 4 * 1024; i += NTHR) { const int k = i >> 2, j = i & 3; wt[j * R_PITCH + k] = p.in[18][(size_t)L * 4096 + i]; }
    for (int i = tid; i < 32 * 1024; i += NTHR) { const int k = i >> 5, j = i & 31; wt[(4 + j) * R_PITCH + k] = p.in[20][(size_t)L * 32768 + i]; }
    const float* mod = (const float*)(p.ws + WS_MOD);
    unsigned* cnt = (unsigned*)(p.ws + WS_CTL) + CW_CNT + L * 64;
    int* asgr = (int*)(p.ws + WS_ASGR); int* list = (int*)(p.ws + WS_LIST);
    LAS int* LCNT = (LAS int*)(lds + MOE_ARR); LAS int* LBASE = LCNT + 32; LAS int* SLOT = LCNT + 64;
    LAS float* LG = (LAS float*)(lds + MOE_ARR + 4096) + wid * 80;
    if (tid < 32) LCNT[tid] = 0;
    __syncthreads();
    const int base = (L == 0 ? 0 : NCTX), nr = NROW - base, gwv = bid * 8 + __builtin_amdgcn_readfirstlane(wid), nwv = nblk * 8;
    const int rs = base + (int)(((long)gwv * nr) / nwv), re = base + (int)(((long)(gwv + 1) * nr) / nwv);
    const int qperm = ((lane >> 4) == 1) ? 2 : ((lane >> 4) == 2) ? 1 : (lane >> 4);
    LAS float* BQ = (LAS float*)(lds + MOE_ARR + 4096) + 8 * 80;
    if (tid < 36) BQ[tid] = tid < 4 ? p.in[19][L * 4 + tid] : p.in[21][L * 32 + tid - 4];
    __syncthreads();
    AdaC ac; int curmv = -1;
    f32x4 xa[4], xb[4];
    load_row(h_row(p, rs), lane, xa); load_row(h_row(p, rs + 1 < re ? rs + 1 : rs), lane, xb);
#define R_FMA4(acc, x, w, o) acc += x[0][0] * w[o][0] + x[0][1] * w[o][1] + x[0][2] * w[o][2] + x[0][3] * w[o][3] + x[1][0] * w[o + 1][0] + x[1][1] * w[o + 1][1] + x[1][2] * w[o + 1][2] + x[1][3] * w[o + 1][3] \
        + x[2][0] * w[o + 2][0] + x[2][1] * w[o + 2][1] + x[2][2] * w[o + 2][2] + x[2][3] * w[o + 2][3] + x[3][0] * w[o + 3][0] + x[3][1] * w[o + 3][1] + x[3][2] * w[o + 3][2] + x[3][3] * w[o + 3][3]
#define R_RED4(a0, a1, a2, a3, DST) do { \
        auto r01 = __builtin_amdgcn_permlane32_swap(__float_as_uint(a0), __float_as_uint(a1), false, false); const float s01 = __uint_as_float(r01[0]) + __uint_as_float(r01[1]); \
        auto r23 = __builtin_amdgcn_permlane32_swap(__float_as_uint(a2), __float_as_uint(a3), false, false); const float s23 = __uint_as_float(r23[0]) + __uint_as_float(r23[1]); \
        auto rq = __builtin_amdgcn_permlane16_swap(__float_as_uint(s01), __float_as_uint(s23), false, false); const float tg = row_sum16(__uint_as_float(rq[0]) + __uint_as_float(rq[1])); \
        if ((lane & 15) == 0) (DST)[4 * g + qperm] = tg + BQ[4 * g + qperm]; } while (0)
#define R_STEP2(R, x, y) do { const int r = (R); const bool hasB = (r + 1) < re; const int rb = hasB ? r + 1 : r; \
        { const int mv = row_modvec(r); if (mv != curmv) { const float* m = mod + (size_t)(L * 5 + mv) * 6144; adac_load(ac, p.in[7] + L * 1024, m + 3 * 1024, m + 4 * 1024, lane); curmv = mv; } \
          const float rstd = row_rstd(x); adaln_apply(x, rstd, ac); store_row_bf16((u16*)(p.ws + WS_X1) + (size_t)r * D, lane, x); } \
        { const int mv = row_modvec(rb); if (mv != curmv) { const float* m = mod + (size_t)(L * 5 + mv) * 6144; adac_load(ac, p.in[7] + L * 1024, m + 3 * 1024, m + 4 * 1024, lane); curmv = mv; } \
          const float rstd = row_rstd(y); adaln_apply(y, rstd, ac); store_row_bf16((u16*)(p.ws + WS_X1) + (size_t)rb * D, lane, y); } \
        _Pragma("unroll") for (int g = 0; g < 9; ++g) { float a0 = 0.f, a1 = 0.f, a2 = 0.f, a3 = 0.f, b0 = 0.f, b1 = 0.f, b2 = 0.f, b3 = 0.f; \
            { f32x4 w[8];        \
              _Pragma("unroll") for (int t = 0; t < 8; ++t) w[t] = *(const LAS f32x4*)(wt + (4 * g + (t >> 2)) * R_PITCH + (t & 3) * 256 + lane * 4); \
              SBAR(); R_FMA4(a0, x, w, 0); R_FMA4(a1, x, w, 4); R_FMA4(b0, y, w, 0); R_FMA4(b1, y, w, 4); SBAR(); } \
            { f32x4 w[8]; \
              _Pragma("unroll") for (int t = 0; t < 8; ++t) w[t] = *(const LAS f32x4*)(wt + (4 * g + 2 + (t >> 2)) * R_PITCH + (t & 3) * 256 + lane * 4); \
              SBAR(); R_FMA4(a2, x, w, 0); R_FMA4(a3, x, w, 4); R_FMA4(b2, y, w, 0); R_FMA4(b3, y, w, 4); SBAR(); } \
            R_RED4(a0, a1, a2, a3, LG); R_RED4(b0, b1, b2, b3, LG + 40); SBAR(); } \
        { const int n0 = r + 2 < re ? r + 2 : re - 1, n1 = r + 3 < re ? r + 3 : re - 1; load_row(h_row(p, n0), lane, x); load_row(h_row(p, n1), lane, y); }        \
        route_row<L>(p, LG, r, (r - rs) * 8 + wid, LCNT, SLOT, lane); \
        if (hasB) route_row<L>(p, LG + 40, rb, (rb - rs) * 8 + wid, LCNT, SLOT, lane); } while (0)
    for (int r0 = rs; r0 < re; r0 += 2) R_STEP2(r0, xa, xb);
#undef R_STEP2
#undef R_RED4
#undef R_FMA4
    __syncthreads();
    if (tid < 32) { const unsigned n = (unsigned)LCNT[tid]; LBASE[tid] = n ? (int)atomicAdd(&cnt[tid], n) : 0; }
    __syncthreads();
    for (int r = rs; r < re; ++r) if (lane < 2) {
        const LAS int* sl = SLOT + ((r - rs) * 8 + wid) * 4; const int e = sl[lane], rank = LBASE[e] + sl[2 + lane];
        list[(size_t)e * NROW + rank] = r; asgr[2 * r + lane] = rank; }
}
__device__ __forceinline__ void moe_tables(const Params& p, LAS unsigned char* lds, int L) {
    LAS int* CNT = (LAS int*)(lds + MOE_ARR); LAS int* OFF = CNT + 32; LAS int* TIL = CNT + 64;
    if (threadIdx.x < 32) CNT[threadIdx.x] = (int)xb_ld((unsigned*)(p.ws + WS_CTL) + CW_CNT + L * 64 + threadIdx.x);
    __syncthreads();
    if (threadIdx.x == 0) { int o = 0, t = 0; for (int e = 0; e < 32; ++e) { OFF[e] = o; TIL[e] = t; o += CNT[e]; t += (CNT[e] + 255) >> 8; } TIL[32] = t; }
    __syncthreads();
}
__device__ __forceinline__ int find_expert(const LAS int* TIL, int tile) { int e = 0;
#pragma unroll
    for (int j = 1; j < 32; ++j) e += (TIL[j] <= tile) ? 1 : 0;
    return e; }
__device__ __forceinline__ void phase_up(const Params& p, LAS unsigned char* lds, int bid, int nblk, int L) {
    moe_tables(p, lds, L);
    LAS int* CNT = (LAS int*)(lds + MOE_ARR); LAS int* OFF = CNT + 32; LAS int* TIL = CNT + 64;
    pg::MoeSched<true> S; S.A = (const char*)(p.ws + WS_X1); S.Bt = (const char*)(p.ws + WS_W13); S.CNT = CNT; S.OFF = OFF; S.TIL = TIL; S.list = (const int*)(p.ws + WS_LIST);
    S.RIDX = CNT + 128; S.nwg = __builtin_amdgcn_readfirstlane(TIL[32]) * 4; S.G = nblk; S.c = bid; S.K = 1024; S.fallback = (L == 0 ? 0 : NCTX);
    EpiUp E{(u16*)(p.ws + WS_H), OFF};
    pg::gemm_phase<true>(lds, 1024, S, E);
}
__device__ __forceinline__ void phase_down(const Params& p, LAS unsigned char* lds, int bid, int nblk, int L) {
    moe_tables(p, lds, L);
    LAS int* CNT = (LAS int*)(lds + MOE_ARR); LAS int* OFF = CNT + 32; LAS int* TIL = CNT + 64;
    pg::MoeSched<false> S; S.A = (const char*)(p.ws + WS_H); S.Bt = (const char*)(p.ws + WS_W2); S.CNT = CNT; S.OFF = OFF; S.TIL = TIL; S.list = nullptr;
    S.RIDX = CNT + 128; S.nwg = __builtin_amdgcn_readfirstlane(TIL[32]) * 4; S.G = nblk; S.c = bid; S.K = 512; S.fallback = 0;
    EpiDown E{(u16*)(p.ws + WS_YB), OFF};
    pg::gemm_phase<true>(lds, 512, S, E);
}
template <int L>
__device__ __forceinline__ void phase_combine(const Params& p, LAS unsigned char* lds, int bid, int nblk) {
    moe_tables(p, lds, L);
    LAS int* OFF = (LAS int*)(lds + MOE_ARR) + 32;
    const int tid = threadIdx.x, wid = tid >> 6, lane = tid & 63;
    const float* mod = (const float*)(p.ws + WS_MOD);
    const int* asge = (const int*)(p.ws + WS_ASGE); const int* asgr = (const int*)(p.ws + WS_ASGR); const float* asgg = (const float*)(p.ws + WS_ASGG);
    const u16* yb = (const u16*)(p.ws + WS_YB);
    const int r0 = (L == 0 ? 0 : NCTX) + bid * 8 + wid, stride = nblk * 8;
    f32x4 x[4]; u32x2 ya[4], yq[4]; float ga = 0.f, gb = 0.f;
#define C_LOAD(rr, X, YA, YQ, GA, GB) do { load_row(h_row(p, rr), lane, X); const int ea_ = asge[2 * (rr)], eb_ = asge[2 * (rr) + 1]; GA = asgg[2 * (rr)]; GB = asgg[2 * (rr) + 1]; \
        const u16* pa_ = yb + (size_t)(OFF[ea_] + asgr[2 * (rr)]) * 1024 + lane * 4; const u16* pb_ = yb + (size_t)(OFF[eb_] + asgr[2 * (rr) + 1]) * 1024 + lane * 4; \
        _Pragma("unroll") for (int i = 0; i < 4; ++i) { YA[i] = *(const u32x2*)(pa_ + i * 256); YQ[i] = *(const u32x2*)(pb_ + i * 256); } } while (0)
    if (r0 < NROW) C_LOAD(r0, x, ya, yq, ga, gb);
    for (int r = r0; r < NROW; r += stride) {
        float* hp = h_row(p, r);
        const float* m = mod + (size_t)(L * 5 + row_modvec(r)) * 6144;
        f32x4 g2[4]; AdaC ac;
#pragma unroll
        for (int i = 0; i < 4; ++i) g2[i] = *(const f32x4*)(m + 5 * 1024 + i * 256 + lane * 4);
        if (L == 0) { const float* m1 = mod + (size_t)(1 * 5 + row_modvec(r)) * 6144; adac_load(ac, p.in[6] + 1024, m1, m1 + 1024, lane); }
        else {
#pragma unroll
            for (int i = 0; i < 4; ++i) ac.g[i] = *(const f32x4*)(p.in[25] + i * 256 + lane * 4); }
        SBAR();
        const int rn = r + stride; f32x4 nx[4]; u32x2 nya[4], nyq[4]; float nga = 0.f, ngb = 0.f;
        if (rn < NROW) C_LOAD(rn, nx, nya, nyq, nga, ngb);
        SBAR();
#pragma unroll
        for (int i = 0; i < 4; ++i) { const u32x2 a = ya[i], bq = yq[i]; const f32x4 g = g2[i];
            x[i][0] += g[0] * (ga * bflo(a[0]) + gb * bflo(bq[0])); x[i][1] += g[1] * (ga * bfhi(a[0]) + gb * bfhi(bq[0]));
            x[i][2] += g[2] * (ga * bflo(a[1]) + gb * bflo(bq[1])); x[i][3] += g[3] * (ga * bfhi(a[1]) + gb * bfhi(bq[1])); }
        const float rstd = row_rstd(x);
        if (L == 0) {
#pragma unroll
            for (int i = 0; i < 4; ++i) *(f32x4*)(hp + i * 256 + lane * 4) = x[i];
            adaln_apply(x, rstd, ac);
            store_row_bf16((u16*)(p.ws + WS_X1) + (size_t)r * D, lane, x);
        } else {
#pragma unroll
            for (int i = 0; i < 4; ++i) { const f32x4 g = ac.g[i]; f32x4 y = {x[i][0] * rstd * g[0], x[i][1] * rstd * g[1], x[i][2] * rstd * g[2], x[i][3] * rstd * g[3]}; *(f32x4*)(hp + i * 256 + lane * 4) = y; }
        }
        if (rn < NROW) { ga = nga; gb = ngb;
#pragma unroll
            for (int i = 0; i < 4; ++i) { x[i] = nx[i]; ya[i] = nya[i]; yq[i] = nyq[i]; } }
    }
#undef C_LOAD
}

constexpr int A_SHM_V = 16384, A_SHM_K = 16384;
constexpr float A_SCALE = 0.125f, A_THR = 8.f;
__device__ __forceinline__ void smA(f32x16& p0, f32x16& p1, float mC) {
#pragma unroll
    for (int r = 0; r < 16; ++r) p0[r] = __builtin_amdgcn_exp2f(p0[r]);
}
__device__ __forceinline__ void smB(f32x16& p0, f32x16& p1, float& l_reg, bf16x8& pa0, bf16x8& pa1, bf16x8& pa2, bf16x8& pa3) {
#pragma unroll
    for (int r = 0; r < 16; ++r) p1[r] = __builtin_amdgcn_exp2f(p1[r]);
    float ps = 0;
#pragma unroll
    for (int r = 0; r < 16; ++r) ps += p0[r];
#pragma unroll
    for (int r = 0; r < 16; ++r) ps += p1[r];
    l_reg += ps;
    PK4(p0, 0, pa0); PK4(p0, 8, pa1); PK4(p1, 0, pa2); PK4(p1, 8, pa3);
}
__device__ __forceinline__ void attn_unit(const Params& p, LAS unsigned char* lds, int u, float lam) {
    int tz0 = threadIdx.x; asm volatile("" : "+v"(tz0));
    const int tid = tz0, wid = __builtin_amdgcn_readfirstlane(tid >> 6), lane = tid & 63, r32 = lane & 31, hi = lane >> 5;
    const int qt = u & 63, h = (u >> 6) & 7, b = u >> 9, map = wid >> 2, tb = wid & 3;
    unsigned long long wsb = (unsigned long long)(p.ws + WS_PROJ); asm volatile("" : "+s"(wsb));
    const u16* proj = (const u16*)wsb;
    LAS float* li_l = (LAS float*)(lds + 131072) + wid * 64;
    const int qrow0 = NCTX + b * SEQ + qt * 128;
    float l_reg = 0; f32x16 o[4] = {}; bf16x8 qr[4];
    { const u16* qp = proj + (size_t)(qrow0 + tb * 32 + r32) * 3072 + h * 128 + map * 64 + hi * 8;
#pragma unroll
      for (int d0 = 0; d0 < 4; ++d0) qr[d0] = *(const bf16x8*)(qp + d0 * 16); }
    float mC;
    {   float qn2 = 0.f;
#pragma unroll
        for (int d0 = 0; d0 < 4; ++d0)
#pragma unroll
            for (int j = 0; j < 8; ++j) { const float x = bf2f((u16)qr[d0][j]); qn2 += x * x; }
        qn2 = swap32_add(qn2);
        unsigned* km = (unsigned*)(p.ws + WS_CTL) + CW_KMAX + (b * 8 + h) * 4 + map * 2;
        const float kb2 = __uint_as_float(xb_ld(km)) + __uint_as_float(xb_ld(km + 1));
        mC = sqrtf(qn2 * kb2) * (1.02f * A_SCALE * LOG2E);
#pragma unroll
        for (int d0 = 0; d0 < 4; ++d0) { u32x4 w = __builtin_bit_cast(u32x4, qr[d0]);
#pragma unroll
            for (int e = 0; e < 4; ++e) w[e] = cvtpk(bflo(w[e]) * (A_SCALE * LOG2E), bfhi(w[e]) * (A_SCALE * LOG2E));
            qr[d0] = __builtin_bit_cast(bf16x8, w); } }
    f32x16 negm;
#pragma unroll
    for (int r = 0; r < 16; ++r) negm[r] = -mC;
    constexpr int A_SLOT = 32768, NT = 132;
    const unsigned vrd = (unsigned)(unsigned long long)(lds + v_rd_base(lane));
    const int kcb = map * 128;
    unsigned koff0, voff0;
    {   const int P0 = tid;
        { const int row = P0 >> 4, c = ((P0 & 15) ^ (row & 15)) * 8; koff0 = (unsigned)(row * 3072 + 1024 + h * 128 + c); }
        { const int sub = P0 >> 5, kk = (sub >> 2) * 8 + ((P0 >> 2) & 7), c = (sub & 3) * 32 + (P0 & 3) * 8, k = (kk & ~0xC) | ((kk & 4) << 1) | ((kk & 8) >> 1); voff0 = (unsigned)(k * 3072 + 2048 + h * 128 + c); } }
#define KROW(j) ((j) < 4 ? b * 256 + (j) * 64 : NCTX + b * SEQ + ((j) - 4) * 64)
#define ADMA(j) do { const u16* g_ = proj + (size_t)KROW(j) * 3072; LAS unsigned char* s_ = lds + ((j) & 3) * A_SLOT + wid * 1024; \
        glds16(g_ + voff0, s_); glds16(g_ + voff0 + 32 * 3072, s_ + 8192); glds16(g_ + koff0, s_ + 16384); glds16(g_ + koff0 + 32 * 3072, s_ + 16384 + 8192); } while (0)
#define A_WAITBAR(N) do { asm volatile("s_waitcnt vmcnt(" #N ") lgkmcnt(0)" ::: "memory"); BAR(); } while (0)
#define A_ITER(j, PC0, PC1, PP0, PP1, N, DMA) do { A_WAITBAR(N); if (DMA) ADMA((j) + 2); SBAR(); \
        qkt_init<4>(PC0, PC1, lds + ((j) & 3) * A_SLOT + 16384, qr, r32, hi, kcb, negm); \
        smB(PP0, PP1, l_reg, pa0, pa1, pa2, pa3); SBAR(); \
        pv_tile_asm(o, vrd + (((j) - 1) & 3) * A_SLOT, pa0, pa1, pa2, pa3); \
        smA(PC0, PC1, mC); SBAR(); } while (0)
    f32x16 pA0, pA1, pB0, pB1; bf16x8 pa0, pa1, pa2, pa3;
    ADMA(0); ADMA(1);
    A_WAITBAR(4); ADMA(2);
    qkt_init<4>(pA0, pA1, lds + 16384, qr, r32, hi, kcb, negm); smA(pA0, pA1, mC);
    for (int j0 = 1; j0 < NT - 1; j0 += 2) {
        A_ITER(j0, pB0, pB1, pA0, pA1, 4, (j0 + 2 < NT)); A_ITER(j0 + 1, pA0, pA1, pB0, pB1, 4, (j0 + 3 < NT));
    }
    A_ITER(NT - 1, pB0, pB1, pA0, pA1, 0, false);
    smB(pB0, pB1, l_reg, pa0, pa1, pa2, pa3);
    pv_tile_asm(o, vrd + ((NT - 1) & 3) * A_SLOT, pa0, pa1, pa2, pa3);
    l_reg = swap32_add(l_reg);
    asm volatile("" : "+v"(tz0));
    const int lane_e = tz0 & 63, r32e = lane_e & 31, hie = lane_e >> 5;
    if (hie == 0) li_l[r32e] = l_reg; WAIT_L(0);
#pragma unroll
    for (int r = 0; r < 16; ++r) { const float rl = __builtin_amdgcn_rcpf(li_l[crow(r, hie)]);
#pragma unroll
        for (int d = 0; d < 4; ++d) o[d][r] *= rl; }
    __syncthreads();
    LAS float* EX = (LAS float*)lds;
    if (map == 1) {
#pragma unroll
        for (int d = 0; d < 4; ++d)
#pragma unroll
            for (int r = 0; r < 16; ++r) EX[((tb * 4 + d) * 16 + r) * 64 + lane_e] = o[d][r]; }
    __syncthreads();
    if (map == 0) {
        const float* G = p.in[16] + h * 128; float gv[4];
#pragma unroll
        for (int d = 0; d < 4; ++d) gv[d] = G[d * 32 + r32e] * (1.f - LAM_INIT);
#pragma unroll
        for (int r = 0; r < 16; ++r) { float x[4], s2 = 0.f;
#pragma unroll
            for (int d = 0; d < 4; ++d) { x[d] = o[d][r] - lam * EX[((tb * 4 + d) * 16 + r) * 64 + lane_e]; s2 += x[d] * x[d]; }
            s2 = half_sum(s2); const float rstd = rsqrtf(s2 * (1.f / 128.f) + EPS);
            u16* op = (u16*)(p.ws + WS_X1) + (size_t)(qrow0 + tb * 32 + crow(r, hie)) * 1024 + h * 128 + r32e;
#pragma unroll
            for (int d = 0; d < 4; ++d) op[d * 32] = f2bf(x[d] * rstd * gv[d]); }
    }
    __syncthreads();
#undef KROW
#undef ADMA
#undef A_WAITBAR
#undef A_ITER
}

constexpr int NPH = 18;
__global__ void __launch_bounds__(NTHR, 2) mega(Params p, int ph_lo, int ph_hi) {
    extern __shared__ __attribute__((aligned(16))) unsigned char smem_[];
    LAS unsigned char* lds = (LAS unsigned char*)smem_;
    const int bid = blockIdx.x, nblk = gridDim.x, tid = threadIdx.x;
    volatile LAS unsigned* xbw = (volatile LAS unsigned*)(lds + LDS_MISC);
    if (tid < 4) xbw[tid] = 0u;
    __syncthreads();
    XcdBarrier bar; bar.bar = (unsigned*)(p.ws + WS_CTL) + CW_BAR; bar.x = 0; bar.st = xbw;
    if (ph_hi - ph_lo > 1) bar = xcd_barrier_post((unsigned*)(p.ws + WS_CTL) + CW_BAR, xbw);
#ifndef PHMASK
#define PHMASK 0x3ffff
#endif
#define IN(k) (((PHMASK >> (k)) & 1) && ph_lo <= (k) && (k) < ph_hi)
#define SEAM(k) do { if (IN(k) && IN((k) + 1)) xcd_barrier(bar); } while (0)
#ifndef REPMASK
#define REPMASK 0
#endif
#define NREP(k) (1 + ((REPMASK >> (k)) & 1))
    if (IN(0)) for (int rep_ = 0; rep_ < NREP(0); ++rep_) { if (rep_) xcd_barrier(bar); phase0(p, lds, bid, nblk); } SEAM(0);
    if (IN(1)) for (int rep_ = 0; rep_ < NREP(1); ++rep_) { if (rep_) xcd_barrier(bar); phase1(p, lds, bid, nblk); } SEAM(1);
    if (IN(2)) for (int rep_ = 0; rep_ < NREP(2); ++rep_) { if (rep_) xcd_barrier(bar); phase2(p, lds, bid, nblk); } SEAM(2);
    if (IN(3)) for (int rep_ = 0; rep_ < NREP(3); ++rep_) { if (rep_) xcd_barrier(bar); for (int u = bid; u < 2 * 16 * NCH; u += nblk) s1_unit(p, lds, u); } SEAM(3);
    if (IN(4)) for (int rep_ = 0; rep_ < NREP(4); ++rep_) { if (rep_) xcd_barrier(bar); phase_s2(p, bid, nblk); } SEAM(4);
    if (IN(5)) for (int rep_ = 0; rep_ < NREP(5); ++rep_) { if (rep_) xcd_barrier(bar); for (int u = bid; u < 2 * 16 * NCH; u += nblk) s3_unit(p, lds, u); } SEAM(5);
    if (IN(6)) for (int rep_ = 0; rep_ < NREP(6); ++rep_) { if (rep_) xcd_barrier(bar); phase_outproj<0>(p, lds, bid, nblk); } SEAM(6);
    if (IN(7)) for (int rep_ = 0; rep_ < NREP(7); ++rep_) { if (rep_) xcd_barrier(bar); phase_router<0>(p, lds, bid, nblk); } SEAM(7);
    if (IN(8)) for (int rep_ = 0; rep_ < NREP(8); ++rep_) { if (rep_) xcd_barrier(bar); phase_up(p, lds, bid, nblk, 0); } SEAM(8);
    if (IN(9)) for (int rep_ = 0; rep_ < NREP(9); ++rep_) { if (rep_) xcd_barrier(bar); phase_down(p, lds, bid, nblk, 0); } SEAM(9);
    if (IN(10)) for (int rep_ = 0; rep_ < NREP(10); ++rep_) { if (rep_) xcd_barrier(bar); phase_combine<0>(p, lds, bid, nblk); } SEAM(10);
    if (IN(11)) for (int rep_ = 0; rep_ < NREP(11); ++rep_) { if (rep_) xcd_barrier(bar); phase_inproj1(p, lds, bid, nblk); } SEAM(11);
    if (IN(12)) for (int rep_ = 0; rep_ < NREP(12); ++rep_) { if (rep_) xcd_barrier(bar);
        float lam;
        { const float* lp = p.in[15]; float a = 0, c = 0; for (int i = 0; i < 64; ++i) { a += lp[i] * lp[64 + i]; c += lp[128 + i] * lp[192 + i]; } lam = __builtin_bit_cast(float, __builtin_amdgcn_readfirstlane(__builtin_bit_cast(int, __expf(a) - __expf(c) + LAM_INIT))); }
        if (nblk == 256) { const int xg = bid & 7, sl = bid >> 3;
            for (int k = 0; k < 8; ++k) attn_unit(p, lds, ((xg + 8 * (k >> 1)) << 6) | (sl + 32 * (k & 1)), lam); }
        else for (int u = bid; u < NB * 8 * 64; u += nblk) attn_unit(p, lds, u, lam);
    } SEAM(12);
    if (IN(13)) for (int rep_ = 0; rep_ < NREP(13); ++rep_) { if (rep_) xcd_barrier(bar); phase_outproj<1>(p, lds, bid, nblk); } SEAM(13);
    if (IN(14)) for (int rep_ = 0; rep_ < NREP(14); ++rep_) { if (rep_) xcd_barrier(bar); phase_router<1>(p, lds, bid, nblk); } SEAM(14);
    if (IN(15)) for (int rep_ = 0; rep_ < NREP(15); ++rep_) { if (rep_) xcd_barrier(bar); phase_up(p, lds, bid, nblk, 1); } SEAM(15);
    if (IN(16)) for (int rep_ = 0; rep_ < NREP(16); ++rep_) { if (rep_) xcd_barrier(bar); phase_down(p, lds, bid, nblk, 1); } SEAM(16);
    if (IN(17)) { phase_combine<1>(p, lds, bid, nblk); }
}

extern "C" void kernel_launch(void* const* d_in, const int* in_sizes, int n_in, void* d_out, int out_size, void* d_ws, size_t ws_size, hipStream_t stream) {
    static int grid = 0;
    if (!grid) {
        if (n_in != 26 || out_size != NLAT * D || ws_size < WS_END) { fprintf(stderr, "kernel_launch: shape/ws mismatch n_in %d out %d ws %zu need %zu\n", n_in, out_size, ws_size, (size_t)WS_END); return; }
        if (hipFuncSetAttribute((const void*)mega, hipFuncAttributeMaxDynamicSharedMemorySize, LDS_TOTAL) != hipSuccess) { fprintf(stderr, "kernel_launch: LDS attribute failed\n"); return; }
        int dev = 0, cus = 0, per_cu = 0; hipGetDevice(&dev); hipDeviceGetAttribute(&cus, hipDeviceAttributeMultiprocessorCount, dev);
        hipOccupancyMaxActiveBlocksPerMultiprocessor(&per_cu, mega, NTHR, LDS_TOTAL);
        if (per_cu < 1) { fprintf(stderr, "kernel_launch: occupancy 0\n"); return; }
        grid = cus;
    }
    Params p{};
    for (int i = 0; i < 26; ++i) p.in[i] = (const float*)d_in[i];
    p.out = (float*)d_out; p.ws = (unsigned char*)d_ws;
    hipMemsetAsync((unsigned char*)d_ws + WS_CTL, 0, CTL_BYTES, stream);
#if SPLIT_LAUNCH
    for (int k = 0; k < NPH; ++k) hipLaunchKernelGGL(mega, dim3(grid), dim3(NTHR), LDS_TOTAL, stream, p, k, k + 1);
#else
    hipLaunchKernelGGL(mega, dim3(grid), dim3(NTHR), LDS_TOTAL, stream, p, 0, NPH);
#endif
}
```

```cpp
#include <hip/hip_runtime.h>
#include <cstdio>
#include <cstdint>

#define LAS __attribute__((address_space(3)))
typedef unsigned short u16;
using bf16x8 = __attribute__((ext_vector_type(8))) short;
using s16x4  = __attribute__((ext_vector_type(4))) short;
typedef short v4i16_t __attribute__((ext_vector_type(4)));
using f32x4  = __attribute__((ext_vector_type(4))) float;
using f32x16 = __attribute__((ext_vector_type(16))) float;
using u32x4  = __attribute__((ext_vector_type(4))) unsigned;
using u32x2  = __attribute__((ext_vector_type(2))) unsigned;
typedef __bf16 bf16x2_t __attribute__((ext_vector_type(2)));
typedef float f32x2_t __attribute__((ext_vector_type(2)));

#ifndef SPLIT_LAUNCH
#define SPLIT_LAUNCH 0
#endif

constexpr int D = 1024, NB = 4, SEQ = 8192, CTXL = 256;
constexpr int NCTX = NB * CTXL, NLAT = NB * SEQ, NROW = NCTX + NLAT;
constexpr int NCH = 66;
constexpr int NE = 32;
constexpr int NTHR = 512;
constexpr float EPS = 1e-6f;
constexpr float LOG2E = 1.4426950408889634f;
constexpr float LAM_INIT = 0.35550906f;

constexpr size_t al256(size_t x) { return (x + 255) / 256 * 256; }
constexpr size_t WS_CTL = 0, CTL_BYTES = 32768;
constexpr int CW_BAR = 0;
constexpr int CW_KMAX = 5120;
constexpr int CW_CNT = 4096;
constexpr size_t WS_MOD   = CTL_BYTES;
constexpr size_t WS_ROPE1 = WS_MOD + al256(2 * 5 * 6144 * 4);
constexpr size_t WS_ROPE2 = WS_ROPE1 + al256((size_t)8448 * 64 * 8);
constexpr size_t WS_GATEW = WS_ROPE2 + al256(128 * 16 * 8);
constexpr size_t WS_GATES = WS_GATEW + al256(16 * 1024 * 4);
constexpr size_t WS_HCTX  = WS_GATES + al256((size_t)NROW * 16 * 4);
constexpr size_t WS_STATS = WS_HCTX + al256((size_t)NCTX * D * 4);
constexpr size_t WS_MST   = WS_STATS + al256(32 * NCH * 2 * 4);
constexpr size_t WS_NV    = WS_MST + al256(32 * NCH * 4);
constexpr size_t WS_ASGE  = WS_NV + al256((size_t)32 * NCH * 128 * 4);
constexpr size_t WS_ASGR  = WS_ASGE + al256((size_t)NROW * 2 * 4);
constexpr size_t WS_ASGG  = WS_ASGR + al256((size_t)NROW * 2 * 4);
constexpr size_t WS_LIST  = WS_ASGG + al256((size_t)NROW * 2 * 4);
constexpr size_t WS_WINE  = WS_LIST + al256((size_t)NE * NROW * 4);
constexpr size_t WS_WOUTE = WS_WINE + (size_t)4096 * 1024 * 2;
constexpr size_t WS_WINO  = WS_WOUTE + (size_t)1024 * 1024 * 2;
constexpr size_t WS_WOUTO = WS_WINO + (size_t)3072 * 1024 * 2;
constexpr size_t WS_X1    = WS_WOUTO + (size_t)1024 * 1024 * 2;
constexpr size_t WS_PROJ  = WS_X1 + (size_t)NROW * 1024 * 2;
constexpr size_t PROJ_BYTES = (size_t)NROW * 4096 * 2;
constexpr int    HROWS = 2 * NROW + 256;
constexpr size_t WS_H     = WS_PROJ;
constexpr size_t WS_YB    = WS_H + (size_t)HROWS * 512 * 2;
static_assert(WS_YB + (size_t)HROWS * 1024 * 2 <= WS_PROJ + PROJ_BYTES, "moe buffers fit in proj");
constexpr size_t WS_STATES = WS_PROJ + PROJ_BYTES;
constexpr size_t STATES_BYTES = (size_t)64 * NCH * 16384 * 2;
constexpr size_t WS_W13   = WS_STATES;
constexpr size_t WS_W2    = WS_W13 + (size_t)NE * 1024 * 1024 * 2;
static_assert(WS_W2 + (size_t)NE * 1024 * 512 * 2 <= WS_STATES + STATES_BYTES, "moe weights fit in states");
constexpr size_t WS_END   = WS_STATES + STATES_BYTES;

constexpr int LDS_TOTAL = 163840;
constexpr int LDS_MISC  = LDS_TOTAL - 64;

struct Params { const float* in[26]; float* out; unsigned char* ws; };

__device__ __forceinline__ unsigned cvtpk(float lo, float hi) { f32x2_t v = {lo, hi}; bf16x2_t b = __builtin_convertvector(v, bf16x2_t); return __builtin_bit_cast(unsigned, b); }
__device__ __forceinline__ u16 f2bf(float x) { __bf16 b = (__bf16)x; return __builtin_bit_cast(u16, b); }
__device__ __forceinline__ float bf2f(u16 x) { return __uint_as_float(((unsigned)x) << 16); }
__device__ __forceinline__ float bflo(unsigned w) { return __uint_as_float(w << 16); }
__device__ __forceinline__ float bfhi(unsigned w) { return __uint_as_float(w & 0xffff0000u); }
template <int CTRL> __device__ __forceinline__ float dpp_f(float v) { return __builtin_bit_cast(float, __builtin_amdgcn_update_dpp(0, __builtin_bit_cast(int, v), CTRL, 0xf, 0xf, true)); }
__device__ __forceinline__ float row_sum16(float v) { v += dpp_f<0xB1>(v); v += dpp_f<0x4E>(v); v += dpp_f<0x141>(v); v += dpp_f<0x140>(v); return v; }
__device__ __forceinline__ float row_max16(float v) { v = fmaxf(v, dpp_f<0xB1>(v)); v = fmaxf(v, dpp_f<0x4E>(v)); v = fmaxf(v, dpp_f<0x141>(v)); v = fmaxf(v, dpp_f<0x140>(v)); return v; }
__device__ __forceinline__ float swap16_add(float v) { auto rr = __builtin_amdgcn_permlane16_swap(__float_as_uint(v), __float_as_uint(v), false, false); return __uint_as_float(rr[0]) + __uint_as_float(rr[1]); }
__device__ __forceinline__ float swap16_max(float v) { auto rr = __builtin_amdgcn_permlane16_swap(__float_as_uint(v), __float_as_uint(v), false, false); return fmaxf(__uint_as_float(rr[0]), __uint_as_float(rr[1])); }
__device__ __forceinline__ float swap32_add(float v) { auto rr = __builtin_amdgcn_permlane32_swap(__float_as_uint(v), __float_as_uint(v), false, false); return __uint_as_float(rr[0]) + __uint_as_float(rr[1]); }
__device__ __forceinline__ float swap32_max(float v) { auto rr = __builtin_amdgcn_permlane32_swap(__float_as_uint(v), __float_as_uint(v), false, false); return fmaxf(__uint_as_float(rr[0]), __uint_as_float(rr[1])); }
__device__ __forceinline__ float wave_sum(float v) { return swap32_add(swap16_add(row_sum16(v))); }
__device__ __forceinline__ float wave_max(float v) { return swap32_max(swap16_max(row_max16(v))); }
__device__ __forceinline__ float half_sum(float v) { return swap16_add(row_sum16(v)); }
__device__ __forceinline__ float sigmoidf_(float x) { return __builtin_amdgcn_rcpf(1.f + __expf(-x)); }
__device__ __forceinline__ float siluf_(float x) { return x * __builtin_amdgcn_rcpf(1.f + __expf(-x)); }
__device__ __forceinline__ int crow(int r, int hi) { return (r & 3) + 8 * (r >> 2) + 4 * hi; }
__device__ __forceinline__ float swap_add(float v) { auto rr = __builtin_amdgcn_permlane32_swap(__float_as_uint(v), __float_as_uint(v), false, false); return __uint_as_float(rr[0]) + __uint_as_float(rr[1]); }
__device__ __forceinline__ float swap_max(float v) { auto rr = __builtin_amdgcn_permlane32_swap(__float_as_uint(v), __float_as_uint(v), false, false); return fmaxf(__uint_as_float(rr[0]), __uint_as_float(rr[1])); }
__device__ __forceinline__ void glds16(const void* g, LAS unsigned char* l) { __builtin_amdgcn_global_load_lds((const unsigned*)g, (LAS unsigned*)l, 16, 0, 0); }
#define WAIT_V(n) asm volatile("s_waitcnt vmcnt(" #n ")" ::: "memory")
#define WAIT_L(n) asm volatile("s_waitcnt lgkmcnt(" #n ")" ::: "memory")
#define BAR() __builtin_amdgcn_s_barrier()
#define SBAR() __builtin_amdgcn_sched_barrier(0)

__device__ __forceinline__ int row_modvec(int r) { return r < NCTX ? 4 : ((r - NCTX) >> 13); }
__device__ __forceinline__ int row_pos(int r) { return r < NCTX ? (r & 255) : 256 + ((r - NCTX) & 8191); }
__device__ __forceinline__ int chunk_row0(int b, int ch) { return ch < 2 ? b * 256 + ch * 128 : NCTX + b * SEQ + (ch - 2) * 128; }

#define XB_TMO      128
#define XB_XCNT(j)  (256  + 64 * (j))
#define XB_XSUB(j)  (1280 + 64 * (j))
#define XB_XGEN(j)  (2304 + 64 * (j))
#define XB_TOP      3328
#define XB_TOPGEN   3392
#define XCD_BAR_WORDS 3456
#define XB_SPIN_CAP (1u << 18)
__device__ __forceinline__ unsigned xb_ld(unsigned* p)              { return __hip_atomic_load(p, __ATOMIC_RELAXED, __HIP_MEMORY_SCOPE_AGENT); }
__device__ __forceinline__ unsigned xb_add(unsigned* p, unsigned v) { return __hip_atomic_fetch_add(p, v, __ATOMIC_RELAXED, __HIP_MEMORY_SCOPE_AGENT); }
__device__ __forceinline__ unsigned xb_xcc_id() { return (unsigned)__builtin_amdgcn_s_getreg((3 << 11) | 20) & 0xFu; }
#define XB_SPIN(cond, bar) do { unsigned _sp = 0; while (cond) { __builtin_amdgcn_s_sleep(1); \
    if ((++_sp & 255u) == 0u) { if (xb_ld(&(bar)[XB_TMO])) break; if (_sp > XB_SPIN_CAP) { atomicAdd(&(bar)[XB_TMO], 1u); break; } } } } while (0)
struct XcdBarrier { unsigned* bar; unsigned x; volatile LAS unsigned* st; };
__device__ __forceinline__ XcdBarrier xcd_barrier_post(unsigned* bar, volatile LAS unsigned* st) {
    XcdBarrier b; b.bar = bar; b.x = xb_xcc_id(); b.st = st;
    if (threadIdx.x == 0) (void)xb_add(&bar[XB_XCNT(b.x)], 1u);
    return b;
}
__device__ __forceinline__ void xcd_barrier_complete(unsigned* bar, unsigned x, unsigned& nloc, unsigned& nx) {
    const unsigned G = gridDim.x * gridDim.y * gridDim.z;
    unsigned sum, cnt, mine, sp = 0u;
    for (;;) {
        sum = 0u; cnt = 0u; mine = 0u;
#pragma unroll
        for (unsigned j = 0; j < 16; ++j) { const unsigned c = xb_ld(&bar[XB_XCNT(j)]); sum += c; cnt += (c > 0u) ? 1u : 0u; mine = (j == x) ? c : mine; }
        if (sum == G) break;
        __builtin_amdgcn_s_sleep(1);
        if ((++sp & 255u) == 0u) { if (xb_ld(&bar[XB_TMO])) break; if (sp > XB_SPIN_CAP) { atomicAdd(&bar[XB_TMO], 1u); break; } }
    }
    nloc = mine > 0u ? mine : 1u; nx = cnt > 0u ? cnt : 1u;
}
__device__ __forceinline__ void xcd_barrier(const XcdBarrier& b) {
    asm volatile("s_waitcnt vmcnt(0)" ::: "memory");
    __syncthreads();
    if (threadIdx.x == 0) {
        unsigned* bar = b.bar;
        __builtin_amdgcn_s_waitcnt(0);
        unsigned nloc = b.st[0], nx = b.st[1];
        if (nloc == 0u) { xcd_barrier_complete(bar, b.x, nloc, nx); b.st[0] = nloc; b.st[1] = nx; }
        const unsigned old = xb_add(&bar[XB_XSUB(b.x)], 1u);
        const unsigned gen = old / nloc;
        if (old + 1u == (gen + 1u) * nloc) {
            __builtin_amdgcn_fence(__ATOMIC_RELEASE, "agent");
            asm volatile("s_waitcnt vmcnt(0)" ::: "memory");
            const unsigned og = xb_add(&bar[XB_TOP], 1u);
            const unsigned tg = og / nx;
            if (og + 1u == (tg + 1u) * nx) xb_add(&bar[XB_TOPGEN], 1u);
            else XB_SPIN(xb_ld(&bar[XB_TOPGEN]) == tg, bar);
            __builtin_amdgcn_fence(__ATOMIC_ACQUIRE, "agent");
            xb_add(&bar[XB_XGEN(b.x)], 1u);
            asm volatile("s_waitcnt vmcnt(0)" ::: "memory");
        } else {
            XB_SPIN(xb_ld(&bar[XB_XGEN(b.x)]) == gen, bar);
            __builtin_amdgcn_fence(__ATOMIC_ACQUIRE, "agent");
            asm volatile("s_waitcnt vmcnt(0)" ::: "memory");
        }
    }
    __syncthreads();
}

struct ConvJob { const float* src; u16* dst; int ldn, ldk; float scale; };
__device__ __forceinline__ void conv_load(const ConvJob& j, f32x4 (&r)[4]) {
#pragma unroll
    for (int i = 0; i < 2; ++i) { const int idx = threadIdx.x + i * NTHR, kp = idx >> 4, n4 = idx & 15; const float* s = j.src + (size_t)(2 * kp) * j.ldn + n4 * 4;
        r[2 * i] = *(const f32x4*)s; r[2 * i + 1] = *(const f32x4*)(s + j.ldn); }
}
__device__ __forceinline__ void conv_store(const ConvJob& j, const f32x4 (&r)[4], LAS unsigned char* lds) {
    LAS unsigned* scr = (LAS unsigned*)lds;
#pragma unroll
    for (int i = 0; i < 2; ++i) { const int idx = threadIdx.x + i * NTHR, kp = idx >> 4, n4 = idx & 15;
#pragma unroll
        for (int e = 0; e < 4; ++e) scr[(n4 * 4 + e) * 65 + kp] = cvtpk(r[2 * i][e] * j.scale, r[2 * i + 1][e] * j.scale); }
    __syncthreads();
    { const int n = threadIdx.x >> 3, c8 = threadIdx.x & 7; const LAS unsigned* q = scr + n * 65 + c8 * 8;
      u32x4 w0 = {q[0], q[1], q[2], q[3]}, w1 = {q[4], q[5], q[6], q[7]};
      u16* o = j.dst + (size_t)n * j.ldk + c8 * 16; *(u32x4*)o = w0; *(u32x4*)(o + 8) = w1; }
    __syncthreads();
}
template <class JobFn>
__device__ __forceinline__ void conv_stream(int first, int stride, int total, const JobFn& jf, LAS unsigned char* lds) {
    if (first >= total) return;
    const int last = first + ((total - 1 - first) / stride) * stride;
    ConvJob ja = jf(first), jb = jf(first + stride <= last ? first + stride : last), jc = ja;
    f32x4 ra[4], rb[4], rc[4]; conv_load(ja, ra); conv_load(jb, rb);
    int u = first;
    for (; u + 2 * stride <= last; u += 3 * stride) {
        { const int n2 = u + 2 * stride; jc = jf(n2); conv_load(jc, rc); conv_store(ja, ra, lds); }
        { const int n2 = u + 3 * stride; ja = jf(n2 <= last ? n2 : last); conv_load(ja, ra); conv_store(jb, rb, lds); }
        { const int n2 = u + 4 * stride; jb = jf(n2 <= last ? n2 : last); conv_load(jb, rb); conv_store(jc, rc, lds); }
    }
    if (u <= last) { conv_store(ja, ra, lds); if (u + stride <= last) conv_store(jb, rb, lds); }
}
constexpr int MOE_CONV_UNITS = NE * 192;
struct MoeJob { const Params* p; int l;
    __device__ __forceinline__ ConvJob operator()(int u) const {
        const int e = u / 192, j = u % 192; ConvJob c; c.scale = 1.f;
        if (j < 128) { const int nt16 = j >> 3, kt = j & 7, pn = nt16 >> 2, part = (nt16 >> 1) & 1, half = nt16 & 1;
            c.src = (part ? p->in[23] : p->in[22]) + ((size_t)l * NE + e) * 1024 * 512 + (size_t)(kt * 128) * 512 + pn * 128 + half * 64; c.ldn = 512;
            c.dst = (u16*)(p->ws + WS_W13) + (size_t)e * 1024 * 1024 + (size_t)(nt16 * 64) * 1024 + kt * 128; c.ldk = 1024;
        } else { const int jj = j - 128, nt16 = jj >> 2, kt = jj & 3;
            c.src = p->in[24] + ((size_t)l * NE + e) * 512 * 1024 + (size_t)(kt * 128) * 1024 + nt16 * 64; c.ldn = 1024;
            c.dst = (u16*)(p->ws + WS_W2) + (size_t)e * 1024 * 512 + (size_t)(nt16 * 64) * 512 + kt * 128; c.ldk = 512; }
        return c; }
};
struct P0Job { const Params* p;
    __device__ __forceinline__ ConvJob operator()(int u) const { ConvJob c; c.scale = 1.f; c.ldk = 1024;
        if (u < 512) {
            const int nt = u >> 3, kt = u & 7, n0 = nt * 64, grp = n0 >> 9, w = n0 & 511;
            int s0 = n0; if (grp == 4 || grp == 5) s0 = grp * 512 + (2 * (w >> 8) + ((w >> 6) & 1)) * 128 + 64 * ((w >> 7) & 1);
            c.src = p->in[8] + (size_t)(kt * 128) * 4112 + s0 + (s0 >= 2048 ? 16 : 0); c.ldn = 4112; c.dst = (u16*)(p->ws + WS_WINE) + (size_t)n0 * 1024 + kt * 128;
            c.scale = (grp == 1 || grp == 5) ? 0.08838834764831845f : 1.f;
        } else if (u < 640) { const int v = u - 512; c.src = p->in[13] + (size_t)((v & 7) * 128) * 1024 + (v >> 3) * 64; c.ldn = 1024; c.dst = (u16*)(p->ws + WS_WOUTE) + (size_t)((v >> 3) * 64) * 1024 + (v & 7) * 128;
        } else if (u < 1024) { const int v = u - 640; c.src = p->in[14] + (size_t)((v & 7) * 128) * 3072 + (v >> 3) * 64; c.ldn = 3072; c.dst = (u16*)(p->ws + WS_WINO) + (size_t)((v >> 3) * 64) * 1024 + (v & 7) * 128;
        } else { const int v = u - 1024; c.src = p->in[17] + (size_t)((v & 7) * 128) * 1024 + (v >> 3) * 64; c.ldn = 1024; c.dst = (u16*)(p->ws + WS_WOUTO) + (size_t)((v >> 3) * 64) * 1024 + (v & 7) * 128; }
        return c; }
};
constexpr int P0_CONV = 512 + 128 + 384 + 128, P0_GATEW = P0_CONV, P0_MOD = P0_GATEW + 1, P0_ROPE1 = P0_MOD + 384, P0_ROPE2 = P0_ROPE1 + 132, P0_UNITS = P0_ROPE2 + 1;
__device__ __forceinline__ void phase0(const Params& p, LAS unsigned char* lds, int bid, int nblk) {
    const int tid = threadIdx.x;
    { P0Job jf{&p}; conv_stream(bid, nblk, P0_CONV, jf, lds); }
    for (int u = P0_CONV + bid; u < P0_UNITS; u += nblk) {
        if (u == P0_GATEW) {
            float* gw = (float*)(p.ws + WS_GATEW);
            for (int i = tid; i < 16 * 1024; i += NTHR) { int k = i >> 4, j = i & 15; gw[j * 1024 + k] = p.in[8][(size_t)k * 4112 + 2048 + j]; }
        } else if (u < P0_ROPE1) {
            const int v0 = u - P0_MOD, l = v0 / 192, cb = v0 % 192;
            LAS float* sc = (LAS float*)lds;
            LAS float* part = sc + 5 * 1024;
            for (int i = tid; i < 5 * 1024; i += NTHR) { int v = i >> 10, k = i & 1023; float c = v < 4 ? p.in[1][v * 1024 + k] : p.in[3][k]; sc[i] = siluf_(c); }
            __syncthreads();
            const int col = tid & 31, kq = tid >> 5;
            const float* w = p.in[4] + (size_t)l * 1024 * 6144 + cb * 32 + col;
            float a0 = 0, a1 = 0, a2 = 0, a3 = 0, a4 = 0;
#pragma unroll 16
            for (int k = kq * 64; k < kq * 64 + 64; ++k) { float wv = w[(size_t)k * 6144]; a0 += sc[k] * wv; a1 += sc[1024 + k] * wv; a2 += sc[2048 + k] * wv; a3 += sc[3072 + k] * wv; a4 += sc[4096 + k] * wv; }
            part[(kq * 5 + 0) * 32 + col] = a0; part[(kq * 5 + 1) * 32 + col] = a1; part[(kq * 5 + 2) * 32 + col] = a2; part[(kq * 5 + 3) * 32 + col] = a3; part[(kq * 5 + 4) * 32 + col] = a4;
            __syncthreads();
            if (tid < 5 * 32) { const int v = tid >> 5, c = tid & 31; float s = 0.f;
#pragma unroll
                for (int q = 0; q < 16; ++q) s += part[(q * 5 + v) * 32 + c];
                ((float*)(p.ws + WS_MOD))[((size_t)l * 5 + v) * 6144 + cb * 32 + c] = s + p.in[5][l * 6144 + cb * 32 + c]; }
            __syncthreads();
        } else if (u < P0_ROPE2) {
            const int v0 = u - P0_ROPE1; float2* tb = (float2*)(p.ws + WS_ROPE1);
            for (int j = 0; j < 8; ++j) { int e = v0 * 4096 + j * 512 + tid; int pos = e >> 6, f = e & 63;
                float inv = powf(10000.f, -(float)f / 64.f); float ang = (float)pos * inv; tb[e] = make_float2(cosf(ang), sinf(ang)); }
        } else {
            float2* tb = (float2*)(p.ws + WS_ROPE2);
            for (int e = tid; e < 128 * 16; e += NTHR) { int pos = e >> 4, f = e & 15; float inv = powf(10000.f, -(float)f / 16.f); float ang = (float)pos * inv; tb[e] = make_float2(cosf(ang), sinf(ang)); }
        }
    }
}

__device__ __forceinline__ void load_row(const float* rp, int lane, f32x4 (&x)[4]) {
#pragma unroll
    for (int i = 0; i < 4; ++i) x[i] = *(const f32x4*)(rp + i * 256 + lane * 4);
}
__device__ __forceinline__ float row_rstd(const f32x4 (&x)[4]) {
    float ss = 0;
#pragma unroll
    for (int i = 0; i < 4; ++i) ss += x[i][0] * x[i][0] + x[i][1] * x[i][1] + x[i][2] * x[i][2] + x[i][3] * x[i][3];
    ss = wave_sum(ss);
    return rsqrtf(ss * (1.f / 1024.f) + EPS);
}
__device__ __forceinline__ void adaln_row(f32x4 (&x)[4], float rstd, const float* g, const float* shift, const float* scale, int lane) {
#pragma unroll
    for (int i = 0; i < 4; ++i) { f32x4 gv = *(const f32x4*)(g + i * 256 + lane * 4), sh = *(const f32x4*)(shift + i * 256 + lane * 4), sc = *(const f32x4*)(scale + i * 256 + lane * 4);
#pragma unroll
        for (int e = 0; e < 4; ++e) x[i][e] = x[i][e] * rstd * gv[e] * (1.f + sc[e]) + sh[e]; }
}
struct AdaC { f32x4 g[4], sh[4]; };
__device__ __forceinline__ void adac_load(AdaC& c, const float* g, const float* shift, const float* scale, int lane) {
#pragma unroll
    for (int i = 0; i < 4; ++i) { const f32x4 gv = *(const f32x4*)(g + i * 256 + lane * 4), sc = *(const f32x4*)(scale + i * 256 + lane * 4); c.sh[i] = *(const f32x4*)(shift + i * 256 + lane * 4);
#pragma unroll
        for (int e = 0; e < 4; ++e) c.g[i][e] = gv[e] * (1.f + sc[e]); }
}
__device__ __forceinline__ void adaln_apply(f32x4 (&x)[4], float rstd, const AdaC& c) {
#pragma unroll
    for (int i = 0; i < 4; ++i)
#pragma unroll
        for (int e = 0; e < 4; ++e) x[i][e] = x[i][e] * rstd * c.g[i][e] + c.sh[i][e];
}
__device__ __forceinline__ void store_row_bf16(u16* rp, int lane, const f32x4 (&x)[4]) {
#pragma unroll
    for (int i = 0; i < 4; ++i) { u32x2 w = {cvtpk(x[i][0], x[i][1]), cvtpk(x[i][2], x[i][3])}; *(u32x2*)(rp + i * 256 + lane * 4) = w; }
}
__device__ __forceinline__ const float* l0_in_row(const Params& p, int r) { return r < NCTX ? p.in[2] + (size_t)r * D : p.in[0] + (size_t)(r - NCTX) * D; }
__device__ __forceinline__ float* h_row(const Params& p, int r) { return r < NCTX ? (float*)(p.ws + WS_HCTX) + (size_t)r * D : p.out + (size_t)(r - NCTX) * D; }

__device__ __forceinline__ void phase1(const Params& p, LAS unsigned char* lds, int bid, int nblk) {
    const int tid = threadIdx.x, wid = tid >> 6, lane = tid & 63;
    LAS float* gw = (LAS float*)lds;
    { const float* src = (const float*)(p.ws + WS_GATEW); for (int i = tid; i < 16 * 1024 / 4; i += NTHR) *(LAS f32x4*)(gw + i * 4) = *(const f32x4*)(src + i * 4); }
    __syncthreads();
    const float* mod = (const float*)(p.ws + WS_MOD);
    const int gwv = bid * 8 + __builtin_amdgcn_readfirstlane(wid), nwv = nblk * 8, rs = (int)(((long)gwv * NROW) / nwv), re = (int)(((long)(gwv + 1) * NROW) / nwv);
    AdaC ac; int curmv = -1;
    f32x4 gbias;
    { const int q = lane >> 4, dir = q & 1, kind = q >> 1;
#pragma unroll
      for (int h = 0; h < 4; ++h) gbias[h] = p.in[9][dir * 8 + kind * 4 + h]; }
    f32x4 xa[4], xb[4], xc[4];
    if (rs < re) load_row(l0_in_row(p, rs), lane, xa);
    if (rs + 1 < re) load_row(l0_in_row(p, rs + 1), lane, xb);
#define P1_STEP(R, x, PF) do { const int r = (R); if (r + 2 < re) load_row(l0_in_row(p, r + 2), lane, PF); \
        const int mv = row_modvec(r); \
        if (mv != curmv) { const float* m = mod + (size_t)(0 * 5 + mv) * 6144; adac_load(ac, p.in[6], m, m + 1024, lane); curmv = mv; } \
        const float rstd = row_rstd(x); \
        adaln_apply(x, rstd, ac); \
        store_row_bf16((u16*)(p.ws + WS_X1) + (size_t)r * D, lane, x); \
        float a[16]; \
        _Pragma("unroll") for (int jg = 0; jg < 4; ++jg) { f32x4 w[16];        \
            _Pragma("unroll") for (int t = 0; t < 16; ++t) w[t] = *(const LAS f32x4*)(gw + (jg * 4 + (t >> 2)) * 1024 + (t & 3) * 256 + lane * 4); \
            SBAR(); \
            _Pragma("unroll") for (int jj = 0; jj < 4; ++jj) { float s = 0.f; \
                _Pragma("unroll") for (int i = 0; i < 4; ++i) s += x[i][0] * w[jj * 4 + i][0] + x[i][1] * w[jj * 4 + i][1] + x[i][2] * w[jj * 4 + i][2] + x[i][3] * w[jj * 4 + i][3]; \
                a[jg * 4 + jj] = s; } \
            SBAR(); } \
        float s8[8], t4[4]; \
        _Pragma("unroll") for (int j = 0; j < 8; ++j) { auto rr = __builtin_amdgcn_permlane32_swap(__float_as_uint(a[j]), __float_as_uint(a[j + 8]), false, false); s8[j] = __uint_as_float(rr[0]) + __uint_as_float(rr[1]); } \
        _Pragma("unroll") for (int j = 0; j < 4; ++j) { auto rr = __builtin_amdgcn_permlane16_swap(__float_as_uint(s8[j]), __float_as_uint(s8[j + 4]), false, false); t4[j] = row_sum16(__uint_as_float(rr[0]) + __uint_as_float(rr[1])); } \
        if ((lane & 15) == 0) { const int q = lane >> 4; f32x4 o; \
            _Pragma("unroll") for (int h = 0; h < 4; ++h) { const float z = t4[h] + gbias[h]; o[h] = (q < 2) ? z : fminf(z, 0.f) - __logf(1.f + __expf(-fabsf(z))); }        \
            *(f32x4*)((float*)(p.ws + WS_GATES) + (size_t)r * 16 + q * 4) = o; } } while (0)
    for (int r0 = rs; r0 < re; r0 += 3) {
        P1_STEP(r0, xa, xc);
        if (r0 + 1 < re) P1_STEP(r0 + 1, xb, xa);
        if (r0 + 2 < re) P1_STEP(r0 + 2, xc, xb);
    }
#undef P1_STEP
}

namespace pg {
constexpr int BM = 256, BK = 64, HALF = 128, HTB = HALF * BK * 2, NXCD = 8, WGM = 8;
__device__ __forceinline__ int lds_byte(int r, int c) { const int st = (r >> 4) * 2 + (c >> 5), rr = r & 15, cc = c & 31, ob = rr * 64 + cc * 2; return st * 1024 + (ob ^ (((ob >> 9) & 1) << 5)); }
__device__ __forceinline__ void stage_rc(int b, int& R, int& C) { const int st = b / 1024, sb = b % 1024, swz = sb ^ (((sb >> 9) & 1) << 5); R = (st >> 1) * 16 + swz / 64; C = (st & 1) * 32 + (swz % 64) / 2; }
__device__ __forceinline__ int perm32(int rho) { const int n = rho >> 4, i = rho & 15; return 8 * (i >> 2) + 4 * n + (i & 3); }
struct Unit { int pm, pn, e, nv, off; };
__device__ __forceinline__ int xcd_remap(int wgid, int nwg) { const int q = nwg / NXCD, r = nwg % NXCD, xcd = wgid % NXCD, off = wgid / NXCD; return (xcd < r ? xcd * (q + 1) : r * (q + 1) + (xcd - r) * q) + off; }

struct DenseSched {
    static constexpr bool GATHER = false;
    const char* A; const char* Bt; int pm0, nM, nN, nwg, G, c; size_t tstep;
    __device__ __forceinline__ void init(const void* A_, const void* Bt_, int K, int pm0_, int nM_, int nN_, int G_, int c_) { A = (const char*)A_; Bt = (const char*)Bt_; pm0 = pm0_; nM = nM_; nN = nN_; nwg = nM * nN; G = G_; c = c_; tstep = (size_t)BM * K * 2; }
    __device__ __forceinline__ bool next(int i, Unit& u) const {
        const long L = (long)i * G + c; if (L >= nwg) return false;
        const int wgid = xcd_remap((int)L, nwg);
        const int nig = WGM * nN, gid = wgid / nig, fm = gid * WGM, gsz = (nM - fm) < WGM ? (nM - fm) : WGM;
        u.pm = pm0 + fm + ((wgid % nig) % gsz); u.pn = (wgid % nig) / gsz; u.e = 0; u.nv = 256; u.off = 0; return true;
    }
    __device__ __forceinline__ const char* abase(const Unit& u) const { return A + (size_t)u.pm * tstep; }
    __device__ __forceinline__ const char* bbase(const Unit& u) const { return Bt + (size_t)u.pn * tstep; }
    __device__ __forceinline__ void stage_rows(const Unit&) const {}
    __device__ __forceinline__ void aoffs(unsigned (&o)[2][2], int K) const {
#pragma unroll
        for (int h = 0; h < 2; ++h)
#pragma unroll
            for (int i = 0; i < 2; ++i) { int R, C; stage_rc(threadIdx.x * 16 + i * 8192, R, C); o[h][i] = (unsigned)((h * HALF + R) * K + C) * 2u; } }
};
template <bool GATHER_> struct MoeSched {
    static constexpr bool GATHER = GATHER_;
    const char* A; const char* Bt; const LAS int* CNT; const LAS int* OFF; const LAS int* TIL; LAS int* RIDX; const int* list; int nwg, G, c, K, fallback;
    __device__ __forceinline__ bool next(int i, Unit& u) const {
        const long L = (long)i * G + c; if (L >= nwg) return false;
        const int wgid = __builtin_amdgcn_readfirstlane(xcd_remap((int)L, nwg)), tile = wgid >> 2; int e = 0;
        {   u32x4 tv[8];
#pragma unroll
            for (int j = 0; j < 8; ++j) tv[j] = *(const LAS u32x4*)(TIL + 4 * j);
#pragma unroll
            for (int j = 1; j < 32; ++j) e += ((int)tv[j >> 2][j & 3] <= tile) ? 1 : 0; }
        e = __builtin_amdgcn_readfirstlane(e);
        u.e = e; u.pm = __builtin_amdgcn_readfirstlane(tile - TIL[e]); u.pn = wgid & 3; const int left = __builtin_amdgcn_readfirstlane(CNT[e]) - u.pm * 256; u.nv = left < 256 ? left : 256;
        u.off = __builtin_amdgcn_readfirstlane(OFF[e]); return true;
    }
    __device__ __forceinline__ const char* abase(const Unit& u) const { return GATHER ? A : A + (size_t)(u.off + u.pm * 256) * K * 2; }
    __device__ __forceinline__ const char* bbase(const Unit& u) const { return Bt + ((size_t)u.e * 1024 + u.pn * 256) * K * 2; }
    __device__ __forceinline__ void stage_rows(const Unit& u) const {
        if (GATHER) { const int t = threadIdx.x; if (t < 256) RIDX[t] = t < u.nv ? list[(size_t)u.e * NROW + u.pm * 256 + t] : fallback; } }
    __device__ __forceinline__ void aoffs(unsigned (&o)[2][2], int K_) const {
#pragma unroll
        for (int h = 0; h < 2; ++h)
#pragma unroll
            for (int i = 0; i < 2; ++i) { int R, C; int tz = threadIdx.x; asm volatile("" : "+v"(tz)); stage_rc(tz * 16 + i * 8192, R, C); const int rr = h * HALF + R;
                if (GATHER) o[h][i] = (unsigned)(RIDX[rr] * K_ + C) * 2u; else o[h][i] = (unsigned)(rr * K_ + C) * 2u; } }
};

template <bool PERM, class Sched, class Epi>
__device__ __forceinline__ void gemm_phase(LAS unsigned char* lds, const int K, const Sched& S, const Epi& E) {
    const int tid = threadIdx.x, wid = __builtin_amdgcn_readfirstlane(tid >> 6), lane = tid & 63, wr = wid >> 2, wc = wid & 3, fr = lane & 15, fq = lane >> 4;
    const int nt = K / BK;
    unsigned voffB[2];
#pragma unroll
    for (int i = 0; i < 2; ++i) { int R, C; stage_rc(tid * 16 + i * 8192, R, C); const int Rb = PERM ? ((R & ~31) + perm32(R & 31)) : R; voffB[i] = (unsigned)(Rb * K + C) * 2u; }
    const size_t kstep = (size_t)(BK * 2);
    const size_t hstep = (size_t)HALF * K * 2;
    const unsigned ldsw = (unsigned)wid * 1024u;
    const int aoff = lds_byte(wr * 64 + fr, fq * 8), boff = lds_byte(wc * 32 + fr, fq * 8);
#define PG_SA(b, h) (((b) * 2 + (h)) * HTB)
#define PG_SB(b, h) ((4 + (b) * 2 + (h)) * HTB)
#define PG_STG(bufoff, gbase, o0, o1) do { __builtin_amdgcn_global_load_lds((const unsigned*)((const char*)(gbase) + (o0)), (LAS unsigned*)(lds + (bufoff) + ldsw), 16, 0, 0); \
        __builtin_amdgcn_global_load_lds((const unsigned*)((const char*)(gbase) + (o1)), (LAS unsigned*)(lds + (bufoff) + ldsw + 8192), 16, 0, 0); } while (0)
#define PG_STGB(bufoff, gbase) PG_STG(bufoff, gbase, voffB[0], voffB[1])
#define PG_LDA(dst, b, h) do { _Pragma("unroll") for (int m = 0; m < 4; ++m) _Pragma("unroll") for (int k = 0; k < 2; ++k) dst[m][k] = *(const LAS bf16x8*)(lds + PG_SA(b, h) + aoff + m * 2048 + k * 1024); } while (0)
#define PG_LDB(dst, b, h) do { _Pragma("unroll") for (int n = 0; n < 2; ++n) _Pragma("unroll") for (int k = 0; k < 2; ++k) dst[n][k] = *(const LAS bf16x8*)(lds + PG_SB(b, h) + boff + n * 2048 + k * 1024); } while (0)
#define PG_MMA(ai, bj, At, Bt) do { __builtin_amdgcn_s_setprio(1); _Pragma("unroll") for (int m = 0; m < 4; ++m) _Pragma("unroll") for (int n = 0; n < 2; ++n) _Pragma("unroll") for (int k = 0; k < 2; ++k) \
        acc[ai][bj][m][n] = __builtin_amdgcn_mfma_f32_16x16x32_bf16(Bt[n][k], At[m][k], acc[ai][bj][m][n], 0, 0, 0); __builtin_amdgcn_s_setprio(0); } while (0)
#define PG_BAR __builtin_amdgcn_s_barrier()
#define PG_SCHED __builtin_amdgcn_sched_barrier(0)
    Unit cur, nxt; int ui = 0;
    if (!S.next(0, cur)) return;
    f32x4 acc[2][2][4][2];
#pragma unroll
    for (int a = 0; a < 2; ++a)
#pragma unroll
        for (int b = 0; b < 2; ++b)
#pragma unroll
            for (int m = 0; m < 4; ++m)
#pragma unroll
                for (int n = 0; n < 2; ++n) acc[a][b][m][n] = (f32x4){0.f, 0.f, 0.f, 0.f};
    bf16x8 At[4][2], B0[2][2], B1[2][2];
    const char* cA = S.abase(cur); const char* cB = S.bbase(cur);
    unsigned oc[2][2];
    if (Sched::GATHER) { S.stage_rows(cur); __syncthreads(); }
    S.aoffs(oc, K);
    PG_STGB(PG_SB(0, 0), cB); PG_STGB(PG_SB(0, 1), cB + hstep); PG_STG(PG_SA(0, 0), cA, oc[0][0], oc[0][1]); PG_STG(PG_SA(0, 1), cA, oc[1][0], oc[1][1]);
    if (wr == 1) PG_BAR;
    WAIT_V(2); PG_BAR;
    PG_STGB(PG_SB(1, 0), cB + kstep); PG_STG(PG_SA(1, 0), cA + kstep, oc[0][0], oc[0][1]); PG_STGB(PG_SB(1, 1), cB + hstep + kstep);
    WAIT_V(6); PG_BAR;
    for (;;) {
        const bool has_next = S.next(ui + 1, nxt);
        const char* nA = cA; const char* nB = cB;
        if (has_next) { nA = S.abase(nxt); nB = S.bbase(nxt); if (Sched::GATHER) S.stage_rows(nxt); }
        for (int t = 0; t < nt; t += 2) {
            const bool last = (t == nt - 2);
            const char* a1 = cA + (size_t)(t + 1) * kstep;
            const char* a2 = last ? nA : cA + (size_t)(t + 2) * kstep; const char* b2 = last ? nB : cB + (size_t)(t + 2) * kstep;
            const char* a3 = a2 + kstep; const char* b3 = b2 + kstep;
            PG_LDB(B0, 0, 0); PG_LDB(B1, 0, 1); PG_SCHED; PG_LDA(At, 0, 0); PG_STG(PG_SA(1, 1), a1, oc[1][0], oc[1][1]);
            if (Sched::GATHER) { if (last && has_next) S.aoffs(oc, K); }
            WAIT_V(8); WAIT_L(0); PG_BAR; PG_MMA(0, 0, At, B0); PG_MMA(0, 1, At, B1); PG_BAR; PG_SCHED;
            PG_LDA(At, 0, 1); PG_STGB(PG_SB(0, 0), b2); PG_STGB(PG_SB(0, 1), b2 + hstep); PG_STG(PG_SA(0, 0), a2, oc[0][0], oc[0][1]);
            WAIT_V(8); WAIT_L(0); PG_BAR; PG_MMA(1, 0, At, B0); PG_MMA(1, 1, At, B1); PG_BAR; PG_SCHED;
            PG_LDB(B0, 1, 0); PG_LDB(B1, 1, 1); PG_SCHED; PG_LDA(At, 1, 0); PG_STG(PG_SA(0, 1), a2, oc[1][0], oc[1][1]);
            WAIT_V(8); WAIT_L(0); PG_BAR; PG_MMA(0, 0, At, B0); PG_MMA(0, 1, At, B1); PG_BAR; PG_SCHED;
            PG_LDA(At, 1, 1); PG_STGB(PG_SB(1, 0), b3); PG_STGB(PG_SB(1, 1), b3 + hstep); PG_STG(PG_SA(1, 0), a3, oc[0][0], oc[0][1]);
            WAIT_V(8); WAIT_L(0); PG_BAR; PG_MMA(1, 0, At, B0); PG_MMA(1, 1, At, B1); PG_BAR; PG_SCHED;
        }
        if (wr == 0) PG_BAR;
        E(acc, cur, wr, wc, fr, fq);
        if (!has_next) break;
#pragma unroll
        for (int a = 0; a < 2; ++a)
#pragma unroll
            for (int b = 0; b < 2; ++b)
#pragma unroll
                for (int m = 0; m < 4; ++m)
#pragma unroll
                    for (int n = 0; n < 2; ++n) acc[a][b][m][n] = (f32x4){0.f, 0.f, 0.f, 0.f};
        cur = nxt; cA = nA; cB = nB; ++ui;
        if (wr == 1) PG_BAR;
    }
    WAIT_V(0);
    PG_BAR;
#undef PG_SA
#undef PG_SB
#undef PG_STG
#undef PG_STGB
#undef PG_LDA
#undef PG_LDB
#undef PG_MMA
#undef PG_BAR
#undef PG_SCHED
}
}

__device__ __forceinline__ u32x4 pack8(const f32x4& a, const f32x4& b) { return (u32x4){cvtpk(a[0], a[1]), cvtpk(a[2], a[3]), cvtpk(b[0], b[1]), cvtpk(b[2], b[3])}; }

struct EpiIn0 { u16* O; const float2* rope;
    __device__ __forceinline__ void operator()(const f32x4 (&acc)[2][2][4][2], const pg::Unit& u, int wr_, int wc_, int fr_, int fq_) const {
        int tz = threadIdx.x; asm volatile("" : "+v"(tz)); const int wr = tz >> 8, wc = (tz >> 6) & 3, fr = tz & 15, fq = (tz >> 4) & 3;
        const int g8 = u.pn >> 1, row0 = u.pm * 256 + wr * 64 + fr, qq0 = wc * 32 + fq * 8;
        if (g8 == 4 || g8 == 5) {
            const int head = 2 * (u.pn & 1) + (qq0 >> 6), f0 = qq0 & 63;
#pragma unroll
            for (int ai = 0; ai < 2; ++ai) { f32x4 tt[4][4];
#pragma unroll
                for (int m = 0; m < 4; ++m) { const f32x4* tb = (const f32x4*)(rope + (size_t)row_pos(row0 + ai * 128 + m * 16) * 64 + f0); tt[m][0] = tb[0]; tt[m][1] = tb[1]; tt[m][2] = tb[2]; tt[m][3] = tb[3]; }
                SBAR();
#pragma unroll
                for (int m = 0; m < 4; ++m) { const int row = row0 + ai * 128 + m * 16;
                    const f32x4 t0 = tt[m][0], t1 = tt[m][1], t2 = tt[m][2], t3 = tt[m][3];
                    const f32x4 xa = acc[ai][0][m][0], xb = acc[ai][0][m][1], ya = acc[ai][1][m][0], yb = acc[ai][1][m][1];
                    f32x4 o1a = {xa[0] * t0[0] - ya[0] * t0[1], xa[1] * t0[2] - ya[1] * t0[3], xa[2] * t1[0] - ya[2] * t1[1], xa[3] * t1[2] - ya[3] * t1[3]};
                    f32x4 o1b = {xb[0] * t2[0] - yb[0] * t2[1], xb[1] * t2[2] - yb[1] * t2[3], xb[2] * t3[0] - yb[2] * t3[1], xb[3] * t3[2] - yb[3] * t3[3]};
                    f32x4 o2a = {xa[0] * t0[1] + ya[0] * t0[0], xa[1] * t0[3] + ya[1] * t0[2], xa[2] * t1[1] + ya[2] * t1[0], xa[3] * t1[3] + ya[3] * t1[2]};
                    f32x4 o2b = {xb[0] * t2[1] + yb[0] * t2[0], xb[1] * t2[3] + yb[1] * t2[2], xb[2] * t3[1] + yb[2] * t3[0], xb[3] * t3[3] + yb[3] * t3[2]};
                    u16* op = O + (size_t)row * 4096 + g8 * 512 + head * 128 + f0;
                    *(u32x4*)op = pack8(o1a, o1b); *(u32x4*)(op + 64) = pack8(o2a, o2b); }
                SBAR(); }
        } else {
#pragma unroll
            for (int ai = 0; ai < 2; ++ai)
#pragma unroll
                for (int m = 0; m < 4; ++m)
#pragma unroll
                    for (int bj = 0; bj < 2; ++bj) { f32x4 v0 = acc[ai][bj][m][0], v1 = acc[ai][bj][m][1];
                        if (g8 == 3) {
#pragma unroll
                            for (int e = 0; e < 4; ++e) { v0[e] = sigmoidf_(v0[e]); v1[e] = sigmoidf_(v1[e]); } }
                        else if (g8 == 7) {
#pragma unroll
                            for (int e = 0; e < 4; ++e) { v0[e] = siluf_(v0[e]); v1[e] = siluf_(v1[e]); } }
                        *(u32x4*)(O + (size_t)(row0 + ai * 128 + m * 16) * 4096 + u.pn * 256 + bj * 128 + qq0) = pack8(v0, v1); }
        }
    }
};
struct EpiIn1 { u16* O; const float2* rope; unsigned* kmax;
    __device__ __forceinline__ void operator()(const f32x4 (&acc)[2][2][4][2], const pg::Unit& u, int wr_, int wc_, int fr_, int fq_) const {
        int tz = threadIdx.x; asm volatile("" : "+v"(tz)); const int wr = tz >> 8, wc = (tz >> 6) & 3, fr = tz & 15, fq = (tz >> 4) & 3;
        const int row0 = u.pm * 256 + wr * 64 + fr; const bool rot = (u.pn < 8) && (u.pm >= 4);
        if (u.pn >= 4 && u.pn < 8) {
            float mx0 = 0.f, mx1 = 0.f;
#pragma unroll
            for (int ai = 0; ai < 2; ++ai)
#pragma unroll
                for (int m = 0; m < 4; ++m) {
                    float s0 = 0.f, s1 = 0.f;
#pragma unroll
                    for (int n = 0; n < 2; ++n)
#pragma unroll
                        for (int e = 0; e < 4; ++e) { s0 += acc[ai][0][m][n][e] * acc[ai][0][m][n][e]; s1 += acc[ai][1][m][n][e] * acc[ai][1][m][n][e]; }
                    s0 = swap32_add(swap16_add(s0)); s1 = swap32_add(swap16_add(s1)); mx0 = fmaxf(mx0, s0); mx1 = fmaxf(mx1, s1); }
            mx0 = row_max16(mx0); mx1 = row_max16(mx1);
            if ((tz & 63) == 0) { const int b = u.pm < 4 ? u.pm : ((u.pm - 4) >> 5), hd = 2 * (u.pn - 4);
                atomicMax(kmax + (b * 8 + hd) * 4 + wc, __float_as_uint(mx0)); atomicMax(kmax + (b * 8 + hd + 1) * 4 + wc, __float_as_uint(mx1)); }
        }
#pragma unroll
        for (int ai = 0; ai < 2; ++ai) { f32x4 tt[4][2];
#pragma unroll
            for (int m = 0; m < 4; ++m) { const int row = row0 + ai * 128 + m * 16, t = (row - NCTX) & 8191, pos = rot ? ((wc & 1) ? (t & 63) : (t >> 6)) : 0; const f32x4* tb = (const f32x4*)(rope + pos * 16 + fq * 4); tt[m][0] = tb[0]; tt[m][1] = tb[1]; }
            SBAR();
#pragma unroll
            for (int m = 0; m < 4; ++m) { const int row = row0 + ai * 128 + m * 16; u16* op = O + (size_t)row * 3072 + u.pn * 256 + wc * 32 + fq * 4;
                const f32x4 t0 = tt[m][0], t1 = tt[m][1];
#pragma unroll
                for (int bj = 0; bj < 2; ++bj) { const f32x4 x = acc[ai][bj][m][0], y = acc[ai][bj][m][1];
                    f32x4 o1 = {x[0] * t0[0] - y[0] * t0[1], x[1] * t0[2] - y[1] * t0[3], x[2] * t1[0] - y[2] * t1[1], x[3] * t1[2] - y[3] * t1[3]};
                    f32x4 o2 = {x[0] * t0[1] + y[0] * t0[0], x[1] * t0[3] + y[1] * t0[2], x[2] * t1[1] + y[2] * t1[0], x[3] * t1[3] + y[3] * t1[2]};
                    *(u32x2*)(op + bj * 128) = (u32x2){cvtpk(o1[0], o1[1]), cvtpk(o1[2], o1[3])}; *(u32x2*)(op + bj * 128 + 16) = (u32x2){cvtpk(o2[0], o2[1]), cvtpk(o2[2], o2[3])}; } }
            SBAR(); }
    }
};
template <int L> struct EpiOut { const Params* p;
    __device__ __forceinline__ void operator()(const f32x4 (&acc)[2][2][4][2], const pg::Unit& u, int wr_, int wc_, int fr_, int fq_) const {
        int tz = threadIdx.x; asm volatile("" : "+v"(tz)); const int wr = tz >> 8, wc = (tz >> 6) & 3, fr = tz & 15, fq = (tz >> 4) & 3;
        const int row0 = u.pm * 256 + wr * 64 + fr, c0 = u.pn * 256 + wc * 32 + fq * 8;
        const float* gate = (const float*)(p->ws + WS_MOD) + (size_t)(L * 5 + row_modvec(u.pm * 256)) * 6144 + 2 * 1024 + c0;
        const f32x4 g00 = *(const f32x4*)gate, g01 = *(const f32x4*)(gate + 4), g10 = *(const f32x4*)(gate + 128), g11 = *(const f32x4*)(gate + 132);
#pragma unroll
        for (int ai = 0; ai < 2; ++ai) { f32x4 hv[4][4];
#pragma unroll
            for (int m = 0; m < 4; ++m) { const int r = row0 + ai * 128 + m * 16; const float* src = (L == 0 ? l0_in_row(*p, r) : (const float*)h_row(*p, r)) + c0;
                hv[m][0] = *(const f32x4*)src; hv[m][1] = *(const f32x4*)(src + 4); hv[m][2] = *(const f32x4*)(src + 128); hv[m][3] = *(const f32x4*)(src + 132); }
            SBAR();
#pragma unroll
            for (int m = 0; m < 4; ++m) { const int r = row0 + ai * 128 + m * 16; float* dst = h_row(*p, r) + c0;
                *(f32x4*)dst = hv[m][0] + g00 * acc[ai][0][m][0]; *(f32x4*)(dst + 4) = hv[m][1] + g01 * acc[ai][0][m][1];
                *(f32x4*)(dst + 128) = hv[m][2] + g10 * acc[ai][1][m][0]; *(f32x4*)(dst + 132) = hv[m][3] + g11 * acc[ai][1][m][1]; }
            SBAR(); }
    }
};
struct EpiUp { u16* H; const LAS int* OFF;
    __device__ __forceinline__ void operator()(const f32x4 (&acc)[2][2][4][2], const pg::Unit& u, int wr_, int wc_, int fr_, int fq_) const {
        int tz = threadIdx.x; asm volatile("" : "+v"(tz)); const int wr = tz >> 8, wc = (tz >> 6) & 3, fr = tz & 15, fq = (tz >> 4) & 3;
        const int rl0 = wr * 64 + fr; u16* base = H + (size_t)(u.off + u.pm * 256) * 512 + u.pn * 128 + wc * 32 + fq * 8;
#pragma unroll
        for (int ai = 0; ai < 2; ++ai)
#pragma unroll
            for (int m = 0; m < 4; ++m) { const int rl = rl0 + ai * 128 + m * 16;
                if (rl < u.nv) { f32x4 a = acc[ai][0][m][0], b = acc[ai][0][m][1]; const f32x4 c = acc[ai][1][m][0], d = acc[ai][1][m][1];
#pragma unroll
                    for (int e = 0; e < 4; ++e) { a[e] = siluf_(a[e]) * c[e]; b[e] = siluf_(b[e]) * d[e]; }
                    *(u32x4*)(base + (size_t)rl * 512) = pack8(a, b); } }
    }
};
struct EpiDown { u16* Y; const LAS int* OFF;
    __device__ __forceinline__ void operator()(const f32x4 (&acc)[2][2][4][2], const pg::Unit& u, int wr_, int wc_, int fr_, int fq_) const {
        int tz = threadIdx.x; asm volatile("" : "+v"(tz)); const int wr = tz >> 8, wc = (tz >> 6) & 3, fr = tz & 15, fq = (tz >> 4) & 3;
        const int rl0 = wr * 64 + fr; u16* base = Y + (size_t)(u.off + u.pm * 256) * 1024 + u.pn * 256 + wc * 32 + fq * 8;
#pragma unroll
        for (int ai = 0; ai < 2; ++ai)
#pragma unroll
            for (int m = 0; m < 4; ++m) { const int rl = rl0 + ai * 128 + m * 16;
                if (rl < u.nv) {
#pragma unroll
                    for (int bj = 0; bj < 2; ++bj) *(u32x4*)(base + (size_t)rl * 1024 + bj * 128) = pack8(acc[ai][bj][m][0], acc[ai][bj][m][1]); } }
    }
};

__device__ __forceinline__ void phase2(const Params& p, LAS unsigned char* lds, int bid, int nblk) {
    pg::DenseSched S; S.init(p.ws + WS_X1, p.ws + WS_WINE, 1024, 0, 132, 16, nblk, bid);
    EpiIn0 E{(u16*)(p.ws + WS_PROJ), (const float2*)(p.ws + WS_ROPE1)};
    pg::gemm_phase<true>(lds, 1024, S, E);
}
__device__ __forceinline__ void phase_inproj1(const Params& p, LAS unsigned char* lds, int bid, int nblk) {
    pg::DenseSched S; S.init(p.ws + WS_X1, p.ws + WS_WINO, 1024, 0, 132, 12, nblk, bid);
    EpiIn1 E{(u16*)(p.ws + WS_PROJ), (const float2*)(p.ws + WS_ROPE2), (unsigned*)(p.ws + WS_CTL) + CW_KMAX};
    pg::gemm_phase<false>(lds, 1024, S, E);
}
template <int L> __device__ __forceinline__ void phase_outproj(const Params& p, LAS unsigned char* lds, int bid, int nblk) {
    pg::DenseSched S; S.init(p.ws + WS_X1, p.ws + (L == 0 ? WS_WOUTE : WS_WOUTO), 1024, L == 0 ? 0 : 4, L == 0 ? 132 : 128, 4, nblk, bid);
    EpiOut<L> E{&p};
    pg::gemm_phase<true>(lds, 1024, S, E);
    __syncthreads();
    const int ngemm = (L == 0 ? 132 : 128) * 4, extra = ngemm % nblk;
    const int nconv = nblk - extra, cid = bid - extra;
    if (cid >= 0) { MoeJob jf{&p, L}; conv_stream(cid, nconv, MOE_CONV_UNITS, jf, lds); }
}

#define KSWZ(row, colB) ((row) * 256 + ((colB) ^ (((row) & 15) << 4)))
__device__ __forceinline__ int v_st(int k, int c) { const int kk = (k & ~0xC) | ((k & 4) << 1) | ((k & 8) >> 1); return ((kk >> 3) * 4 + (c >> 5)) * 512 + ((kk & 7) * 32 + (c & 31)) * 2; }
__device__ __forceinline__ int v_rd_base(int lane) { return ((lane & 3) << 3) | (((lane >> 2) & 3) << 6) | (((lane >> 4) & 1) << 5) | (((lane >> 5) & 1) << 8); }
__device__ __forceinline__ s16x4 tr_rd(const LAS unsigned char* a) { return __builtin_bit_cast(s16x4, __builtin_amdgcn_ds_read_tr16_b64_v4i16((LAS v4i16_t*)a)); }
__device__ __forceinline__ bf16x8 tr_frag(const LAS unsigned char* a, int d0, int ks) {
    const s16x4 l = tr_rd(a + d0 * 512 + ks * 4096), h = tr_rd(a + d0 * 512 + ks * 4096 + 2048);
    return (bf16x8){l[0], l[1], l[2], l[3], h[0], h[1], h[2], h[3]};
}
#define PK4(P, BASE, OUT) do { unsigned a0 = cvtpk(P[BASE + 0], P[BASE + 1]), a1 = cvtpk(P[BASE + 2], P[BASE + 3]);   \
    unsigned b0 = cvtpk(P[BASE + 4], P[BASE + 5]), b1 = cvtpk(P[BASE + 6], P[BASE + 7]);                              \
    auto r0 = __builtin_amdgcn_permlane32_swap(a0, b0, false, false); auto r1 = __builtin_amdgcn_permlane32_swap(a1, b1, false, false); \
    u32x4 w = {r0[0], r1[0], r0[1], r1[1]}; OUT = __builtin_bit_cast(bf16x8, w); } while (0)
__device__ __forceinline__ void pv_tile(f32x16 (&o)[4], const LAS unsigned char* vb, bf16x8 pa0, bf16x8 pa1, bf16x8 pa2, bf16x8 pa3) {
#pragma unroll
    for (int d0 = 0; d0 < 4; ++d0) {
        { const bf16x8 b0 = tr_frag(vb, d0, 0), b1 = tr_frag(vb, d0, 1);
          o[d0] = __builtin_amdgcn_mfma_f32_32x32x16_bf16(pa0, b0, o[d0], 0, 0, 0);
          o[d0] = __builtin_amdgcn_mfma_f32_32x32x16_bf16(pa1, b1, o[d0], 0, 0, 0); }
        { const bf16x8 b2 = tr_frag(vb, d0, 2), b3 = tr_frag(vb, d0, 3);
          o[d0] = __builtin_amdgcn_mfma_f32_32x32x16_bf16(pa2, b2, o[d0], 0, 0, 0);
          o[d0] = __builtin_amdgcn_mfma_f32_32x32x16_bf16(pa3, b3, o[d0], 0, 0, 0); }
    }
}
template <int OFF> __device__ __forceinline__ s16x4 tr_asm(unsigned vb) { s16x4 r; asm volatile("ds_read_b64_tr_b16 %0, %1 offset:%2" : "=&v"(r) : "v"(vb), "i"(OFF) : "memory"); return r; }
template <int G> __device__ __forceinline__ void pv_rd(unsigned vb, s16x4 (&r)[4]) {
    constexpr int B = (G >> 1) * 512 + (G & 1) * 8192;
    r[0] = tr_asm<B>(vb); r[1] = tr_asm<B + 2048>(vb); r[2] = tr_asm<B + 4096>(vb); r[3] = tr_asm<B + 6144>(vb);
}
#define PV_WAIT(N, R) asm volatile("s_waitcnt lgkmcnt(" #N ")" : "+v"(R[0]), "+v"(R[1]), "+v"(R[2]), "+v"(R[3]) :: "memory")
#define PKLH(L, H) (bf16x8){L[0], L[1], L[2], L[3], H[0], H[1], H[2], H[3]}
#define PV_MMA(G, R, PA, PB) do { o[(G) >> 1] = __builtin_amdgcn_mfma_f32_32x32x16_bf16(PA, PKLH(R[0], R[1]), o[(G) >> 1], 0, 0, 0); \
                                  o[(G) >> 1] = __builtin_amdgcn_mfma_f32_32x32x16_bf16(PB, PKLH(R[2], R[3]), o[(G) >> 1], 0, 0, 0); } while (0)
__device__ __forceinline__ void pv_tile_asm(f32x16 (&o)[4], unsigned vb, bf16x8 pa0, bf16x8 pa1, bf16x8 pa2, bf16x8 pa3) {
    s16x4 rA[4], rB[4], rC[4];
    pv_rd<0>(vb, rA); pv_rd<1>(vb, rB); pv_rd<2>(vb, rC);
    PV_WAIT(8, rA); PV_MMA(0, rA, pa0, pa1); pv_rd<3>(vb, rA);
    PV_WAIT(8, rB); PV_MMA(1, rB, pa2, pa3); pv_rd<4>(vb, rB);
    PV_WAIT(8, rC); PV_MMA(2, rC, pa0, pa1); pv_rd<5>(vb, rC);
    PV_WAIT(8, rA); PV_MMA(3, rA, pa2, pa3); pv_rd<6>(vb, rA);
    PV_WAIT(8, rB); PV_MMA(4, rB, pa0, pa1); pv_rd<7>(vb, rB);
    PV_WAIT(8, rC); PV_MMA(5, rC, pa2, pa3);
    PV_WAIT(4, rA); PV_MMA(6, rA, pa0, pa1);
    PV_WAIT(0, rB); PV_MMA(7, rB, pa2, pa3);
}
#undef PV_WAIT
#undef PV_MMA
#undef PKLH
template <bool SUFFIX, bool MAXOP> __device__ __forceinline__ float wave_scan(float v, int lane) {
#pragma unroll
    for (int o = 1; o < 64; o <<= 1) { const float t = SUFFIX ? __shfl_down(v, o, 64) : __shfl_up(v, o, 64); const bool in = SUFFIX ? (lane + o < 64) : (lane >= o);
        v = in ? (MAXOP ? fmaxf(v, t) : v + t) : v; }
    return v;
}
template <bool SUFFIX, bool MAXOP> __device__ __forceinline__ float scan128(const LAS float* a, int t) {
    float acc = MAXOP ? -3.0e38f : 0.f;
#pragma unroll 4
    for (int r4 = 0; r4 < 32; ++r4) { const f32x4 v = *(const LAS f32x4*)(a + r4 * 4);
#pragma unroll
        for (int e = 0; e < 4; ++e) { const int r = r4 * 4 + e; const bool in = SUFFIX ? (r >= t) : (r <= t); if (MAXOP) acc = in ? fmaxf(acc, v[e]) : acc; else acc += in ? v[e] : 0.f; } }
    return acc;
}
__device__ __forceinline__ void ld_rows16(const LAS float* A, int hi, float (&v)[16]) {
    f32x4 t[4];
#pragma unroll
    for (int g = 0; g < 4; ++g) t[g] = *(const LAS f32x4*)(A + 8 * g + 4 * hi);
#pragma unroll
    for (int g = 0; g < 4; ++g) { v[4 * g] = t[g][0]; v[4 * g + 1] = t[g][1]; v[4 * g + 2] = t[g][2]; v[4 * g + 3] = t[g][3]; }
}
constexpr int SC_ARR = 131072;

__device__ __forceinline__ void s1_unit(const Params& p, LAS unsigned char* lds, int u) {
    const int tid = threadIdx.x, wid = tid >> 6, lane = tid & 63, r32 = lane & 31, hi = lane >> 5;
    const int ch = u % NCH, t1 = u / NCH, h = t1 & 3, b = (t1 >> 2) & 3, mx = t1 >> 4;
    const int row0 = chunk_row0(b, ch);
    LAS unsigned char* KIMG = lds; LAS unsigned char* VF = lds + 32768; LAS unsigned char* VB = lds + 65536;
    LAS float* arr = (LAS float*)(lds + SC_ARR);
    LAS float *IF = arr, *IB = arr + 128, *FF = arr + 256, *FB = arr + 384, *WF = arr + 512, *WB = arr + 640, *SCL = arr + 768, *RED = arr + 1024;
    const u16* proj = (const u16*)(p.ws + WS_PROJ);
    const int kcol = (mx ? 2560 : 512) + h * 128, vcol = (mx ? 3072 : 1024) + h * 128;
    if (mx == 0) {
        float g_if = 0.f, g_ib = 0.f, bfw = 0.f, bbw = 0.f;
        if (tid < 128) { const float* g = (const float*)(p.ws + WS_GATES) + (size_t)(row0 + tid) * 16; g_if = g[h]; g_ib = g[4 + h];
            bfw = wave_scan<false, false>(g[8 + h], lane); bbw = wave_scan<true, false>(g[12 + h], lane);
            if (lane == 63) SCL[4 + wid] = bfw; if (lane == 0) SCL[6 + wid] = bbw; }
        __syncthreads();
        float wlf = 0.f, wlb = 0.f;
        if (tid < 128) { const float Bf = SCL[4] + SCL[5], Bb = SCL[6] + SCL[7];
            const float bf = bfw + (wid == 1 ? SCL[4] : 0.f), bb = bbw + (wid == 0 ? SCL[7] : 0.f);
            wlf = Bf - bf + g_if; wlb = Bb - bb + g_ib;
            const float mf = wave_max(wlf), mb = wave_max(wlb);
            if (lane == 0) { SCL[8 + wid] = mf; SCL[10 + wid] = mb; }
            if (tid == 0) { SCL[0] = Bf; SCL[1] = Bb; } }
        __syncthreads();
        const float af = fmaxf(SCL[8], SCL[9]), ab = fmaxf(SCL[10], SCL[11]);
        if (tid == 0) { float* st = (float*)(p.ws + WS_STATS); const int c0 = (b * 4 + h) * 2;
            st[((size_t)(c0 + 0) * NCH + ch) * 2 + 0] = SCL[0]; st[((size_t)(c0 + 0) * NCH + ch) * 2 + 1] = af;
            st[((size_t)(c0 + 1) * NCH + ch) * 2 + 0] = SCL[1]; st[((size_t)(c0 + 1) * NCH + ch) * 2 + 1] = ab; }
        if (tid < 128) { WF[tid] = __expf(wlf - af); WB[tid] = __expf(wlb - ab); }
    } else {
        const float lgf = p.in[11][h], lgb = p.in[11][4 + h];
        if (tid < 128) { WF[tid] = __expf(lgf * (float)(127 - tid)); WB[tid] = __expf(lgb * (float)tid); }
    }
    __syncthreads();
#pragma unroll
    for (int i = 0; i < 4; ++i) { const int pi = tid + i * NTHR, s = pi >> 4, c8 = (pi & 15) * 8;
        const u16* rp = proj + (size_t)(row0 + s) * 4096;
        const u32x4 kv = *(const u32x4*)(rp + kcol + c8), vv = *(const u32x4*)(rp + vcol + c8);
        const int off = (s >> 6) * 16384 + v_st(s & 63, c8);
        *(LAS u32x4*)(KIMG + off) = kv;
        const float wf = WF[s], wb = WB[s]; u32x4 of, ob;
#pragma unroll
        for (int e = 0; e < 4; ++e) { float lo = bflo(vv[e]), hh = bfhi(vv[e]); of[e] = cvtpk(lo * wf, hh * wf); ob[e] = cvtpk(lo * wb, hh * wb); }
        *(LAS u32x4*)(VF + off) = of; *(LAS u32x4*)(VB + off) = ob; }
    __syncthreads();
    {   const int dir = wid >> 2, kblk = wid & 3; const int vrb = v_rd_base(lane);
        const LAS unsigned char* ka = KIMG + vrb; const LAS unsigned char* va = (dir ? VB : VF) + vrb;
        f32x16 acc[4] = {};
#pragma unroll
        for (int ks16 = 0; ks16 < 8; ++ks16) { const int tile = ks16 >> 2, ks = ks16 & 3;
            const bf16x8 a = tr_frag(ka + tile * 16384, kblk, ks);
#pragma unroll
            for (int d0 = 0; d0 < 4; ++d0) { const bf16x8 bb = tr_frag(va + tile * 16384, d0, ks); acc[d0] = __builtin_amdgcn_mfma_f32_32x32x16_bf16(a, bb, acc[d0], 0, 0, 0); } }
        const int chain = ((mx * 4 + b) * 4 + h) * 2 + dir;
        u16* base = (u16*)(p.ws + WS_STATES) + ((size_t)chain * NCH + ch) * 16384;
#pragma unroll
        for (int d0 = 0; d0 < 4; ++d0)
#pragma unroll
            for (int g = 0; g < 4; ++g) { u32x2 w = {cvtpk(acc[d0][4 * g], acc[d0][4 * g + 1]), cvtpk(acc[d0][4 * g + 2], acc[d0][4 * g + 3])};
                *(u32x2*)(base + (d0 * 32 + r32) * 128 + kblk * 32 + 8 * g + 4 * hi) = w; }
    }
    if (mx == 0) {
        const int dir = tid >> 8, k = tid & 127, half = (tid >> 7) & 1; LAS float* W = dir ? WB : WF; float s = 0;
#pragma unroll
        for (int i0 = 0; i0 < 64; i0 += 16) { u16 kv[16]; f32x4 wv[4];
#pragma unroll
            for (int i = 0; i < 16; ++i) kv[i] = *(const LAS u16*)(KIMG + half * 16384 + v_st(i0 + i, k));
#pragma unroll
            for (int i = 0; i < 4; ++i) wv[i] = *(const LAS f32x4*)(W + half * 64 + i0 + 4 * i);
            SBAR();
#pragma unroll
            for (int i = 0; i < 16; ++i) s += wv[i >> 2][i & 3] * bf2f(kv[i]);
            SBAR(); }
        RED[(dir * 2 + half) * 128 + k] = s;
        __syncthreads();
        if (half == 0) { const int chain = (b * 4 + h) * 2 + dir; ((float*)(p.ws + WS_NV))[((size_t)chain * NCH + ch) * 128 + k] = RED[(dir * 2) * 128 + k] + RED[(dir * 2 + 1) * 128 + k]; }
    }
    __syncthreads();
}

__device__ __forceinline__ int chain_chunk(int dir, int i) { return dir == 0 ? i : (i < 2 ? 1 - i : 67 - i); }

__device__ __forceinline__ void phase_s2(const Params& p, int bid, int nblk) {
    const float* st = (const float*)(p.ws + WS_STATS);
    for (int gid = bid * NTHR + threadIdx.x; gid < 64 * 2048; gid += nblk * NTHR) {
        const int chain = gid >> 11, v = (gid >> 4) & 127, kc = gid & 15, dir = chain & 1, mx = chain >> 5, h = (chain >> 1) & 3;
        u16* base = (u16*)(p.ws + WS_STATES) + (size_t)chain * NCH * 16384 + v * 128 + kc * 8;
        float c[8] = {0, 0, 0, 0, 0, 0, 0, 0}; float nvc[8] = {0, 0, 0, 0, 0, 0, 0, 0};
        float m = 0.f; const float rdec = mx ? __expf(128.f * p.in[11][dir * 4 + h]) : 1.f;
        const bool do_n = (mx == 0 && v == 0);
        for (int i0 = 0; i0 < NCH; i0 += 6) {
            u32x4 dd[6]; float Bv[6], av[6];
#pragma unroll
            for (int k = 0; k < 6; ++k) { const int ch = chain_chunk(dir, i0 + k); dd[k] = *(const u32x4*)(base + (size_t)ch * 16384);
                if (mx == 0) { Bv[k] = st[((size_t)chain * NCH + ch) * 2]; av[k] = st[((size_t)chain * NCH + ch) * 2 + 1]; } else { Bv[k] = 0.f; av[k] = 0.f; } }
#pragma unroll
            for (int k = 0; k < 6; ++k) {
                const int ch = chain_chunk(dir, i0 + k);
                float dec, sc;
                if (mx == 0) { const float mn = fmaxf(Bv[k] + m, av[k]); dec = __expf(Bv[k] + m - mn); sc = __expf(av[k] - mn);
                    if (v == 0 && kc == 0) ((float*)(p.ws + WS_MST))[(size_t)chain * NCH + ch] = m;
                    m = mn;
                } else { dec = rdec; sc = 1.f; }
                const u32x4 d = dd[k];
                *(u32x4*)(base + (size_t)ch * 16384) = (u32x4){cvtpk(c[0], c[1]), cvtpk(c[2], c[3]), cvtpk(c[4], c[5]), cvtpk(c[6], c[7])};
#pragma unroll
                for (int e = 0; e < 4; ++e) { c[2 * e] = dec * c[2 * e] + sc * bflo(d[e]); c[2 * e + 1] = dec * c[2 * e + 1] + sc * bfhi(d[e]); }
                if (do_n) { float* nq = (float*)(p.ws + WS_NV) + ((size_t)chain * NCH + ch) * 128 + kc * 8;
#pragma unroll
                    for (int e = 0; e < 8; ++e) { float dn = nq[e]; nq[e] = nvc[e]; nvc[e] = dec * nvc[e] + sc * dn; } }
            }
        }
    }
}

template <int NQ>
__device__ __forceinline__ void qkt_init(f32x16& p0, f32x16& p1, const LAS unsigned char* Ks, const bf16x8* qr, int r32, int hi, int colB0, const f32x16& ini) {
    {   const int cb = colB0 + (hi * 8) * 2;
        const bf16x8 b0 = *(const LAS bf16x8*)(Ks + KSWZ(r32, cb)), b1 = *(const LAS bf16x8*)(Ks + KSWZ(32 + r32, cb));
        p0 = __builtin_amdgcn_mfma_f32_32x32x16_bf16(b0, qr[0], ini, 0, 0, 0);
        p1 = __builtin_amdgcn_mfma_f32_32x32x16_bf16(b1, qr[0], ini, 0, 0, 0); }
#pragma unroll
    for (int d0 = 1; d0 < NQ; ++d0) { const int cb = colB0 + (d0 * 16 + hi * 8) * 2;
        const bf16x8 b0 = *(const LAS bf16x8*)(Ks + KSWZ(r32, cb)), b1 = *(const LAS bf16x8*)(Ks + KSWZ(32 + r32, cb));
        p0 = __builtin_amdgcn_mfma_f32_32x32x16_bf16(b0, qr[d0], p0, 0, 0, 0);
        p1 = __builtin_amdgcn_mfma_f32_32x32x16_bf16(b1, qr[d0], p1, 0, 0, 0); }
}
template <int NQ>
__device__ __forceinline__ void qkt(f32x16& p0, f32x16& p1, const LAS unsigned char* Ks, const bf16x8* qr, int r32, int hi, int colB0) {
    p0 = f32x16{}; p1 = f32x16{};
#pragma unroll
    for (int d0 = 0; d0 < NQ; ++d0) { const int cb = colB0 + (d0 * 16 + hi * 8) * 2;
        const bf16x8 b0 = *(const LAS bf16x8*)(Ks + KSWZ(r32, cb)), b1 = *(const LAS bf16x8*)(Ks + KSWZ(32 + r32, cb));
        p0 = __builtin_amdgcn_mfma_f32_32x32x16_bf16(b0, qr[d0], p0, 0, 0, 0);
        p1 = __builtin_amdgcn_mfma_f32_32x32x16_bf16(b1, qr[d0], p1, 0, 0, 0); }
}

__device__ __forceinline__ void s3_unit(const Params& p, LAS unsigned char* lds, int u) {
    const int tid = threadIdx.x, wid = tid >> 6, lane = tid & 63, r32 = lane & 31, hi = lane >> 5;
    const int ch = u % NCH, t1 = u / NCH, h = t1 & 3, b = (t1 >> 2) & 3, mx = t1 >> 4;
    const int row0 = chunk_row0(b, ch);
    LAS unsigned char* KT = lds; LAS unsigned char* VI = lds + 32768; LAS unsigned char* CT = lds + 65536;
    LAS float* arr = (LAS float*)(lds + SC_ARR);
    LAS float *U = arr, *MXA = arr + 256, *WI = arr + 512, *FL = arr + 768, *NVL = arr + 1024, *HS = arr + 1280  , *TMP = arr + 1536  ;
    const u16* proj = (const u16*)(p.ws + WS_PROJ);
    const int qcol = (mx ? 2048 : 0) + h * 128, kcol = qcol + 512, vcol = qcol + 1024, gcol = qcol + 1536;
    const int chain0 = ((mx * 4 + b) * 4 + h) * 2;
    if (mx == 0) {
        float g_if = 0.f, g_ib = 0.f, bfw = 0.f, bbw = 0.f, bf = 0.f, bb = 0.f, pfw = 0.f, pbw = 0.f;
        if (tid < 128) { const float* g = (const float*)(p.ws + WS_GATES) + (size_t)(row0 + tid) * 16; g_if = g[h]; g_ib = g[4 + h];
            bfw = wave_scan<false, false>(g[8 + h], lane); bbw = wave_scan<true, false>(g[12 + h], lane);
            if (lane == 63) TMP[wid] = bfw; if (lane == 0) TMP[2 + wid] = bbw; }
        if (tid >= 256) { const int d = (tid >> 7) & 1, k = tid & 127; NVL[d * 128 + k] = ((const float*)(p.ws + WS_NV))[((size_t)(chain0 - 0 + d) * NCH + ch) * 128 + k]; }
        __syncthreads();
        if (tid < 128) { bf = bfw + (wid == 1 ? TMP[0] : 0.f); bb = bbw + (wid == 0 ? TMP[3] : 0.f);
            const float uf = g_if - bf, ub = g_ib - bb; U[tid] = uf; U[128 + tid] = ub;
            pfw = wave_scan<false, true>(uf, lane); pbw = wave_scan<true, true>(ub, lane);
            if (lane == 63) TMP[4 + wid] = pfw; if (lane == 0) TMP[6 + wid] = pbw; }
        __syncthreads();
        if (tid < 128) { const float pf = (wid == 1) ? fmaxf(pfw, TMP[4]) : pfw, pb = (wid == 0) ? fmaxf(pbw, TMP[7]) : pbw;
            const float mf = ((const float*)(p.ws + WS_MST))[(size_t)chain0 * NCH + ch], mb = ((const float*)(p.ws + WS_MST))[(size_t)(chain0 + 1) * NCH + ch];
            const float Mf = fmaxf(mf, pf), Mb = fmaxf(mb, pb);
            MXA[tid] = Mf; MXA[128 + tid] = Mb; WI[tid] = __expf(mf - Mf); WI[128 + tid] = __expf(mb - Mb);
            FL[tid] = __expf(-(bf + Mf)); FL[128 + tid] = __expf(-(bb + Mb)); }
    } else {
        const float lgf = p.in[11][h], lgb = p.in[11][4 + h];
        if (tid < 128) { const float t = (float)tid; U[tid] = -lgf * t; MXA[tid] = -lgf * t; WI[tid] = __expf(lgf * (t + 1.f));
            U[128 + tid] = lgb * t; MXA[128 + tid] = lgb * t; WI[128 + tid] = __expf(lgb * (128.f - t)); FL[tid] = 0.f; FL[128 + tid] = 0.f; }
        if (tid >= 256) NVL[tid - 256] = 0.f;
    }
    const u16* cf = (const u16*)(p.ws + WS_STATES) + ((size_t)chain0 * NCH + ch) * 16384;
    const u16* cbp = (const u16*)(p.ws + WS_STATES) + ((size_t)(chain0 + 1) * NCH + ch) * 16384;
#pragma unroll
    for (int i = 0; i < 4; ++i) { const int pi = tid + i * NTHR, s = pi >> 4, c8 = (pi & 15) * 8;
        const u16* rp = proj + (size_t)(row0 + s) * 4096;
        *(LAS u32x4*)(KT + KSWZ(s, c8 * 2)) = *(const u32x4*)(rp + kcol + c8);
        *(LAS u32x4*)(VI + (s >> 6) * 16384 + v_st(s & 63, c8)) = *(const u32x4*)(rp + vcol + c8);
        *(LAS u32x4*)(CT + KSWZ(s, c8 * 2)) = *(const u32x4*)(cf + s * 128 + c8);
        *(LAS u32x4*)(CT + 32768 + KSWZ(s, c8 * 2)) = *(const u32x4*)(cbp + s * 128 + c8); }
    const int dir = wid >> 2, tb = wid & 3, t = tb * 32 + r32;
    bf16x8 qr[8];
    { const u16* qp = proj + (size_t)(row0 + t) * 4096 + qcol + hi * 8;
#pragma unroll
      for (int d0 = 0; d0 < 8; ++d0) qr[d0] = *(const bf16x8*)(qp + d0 * 16); }
    __syncthreads();
    f32x16 o[4] = {};
    {
        const LAS unsigned char* C = CT + dir * 32768;
#pragma unroll
        for (int dv = 0; dv < 4; ++dv)
#pragma unroll
            for (int d0 = 0; d0 < 8; ++d0) { const bf16x8 bb = *(const LAS bf16x8*)(C + KSWZ(dv * 32 + r32, (d0 * 16 + hi * 8) * 2)); o[dv] = __builtin_amdgcn_mfma_f32_32x32x16_bf16(qr[d0], bb, o[dv], 0, 0, 0); }
        float wv[16]; ld_rows16(WI + dir * 128 + tb * 32, hi, wv);
#pragma unroll
        for (int r = 0; r < 16; ++r) {
#pragma unroll
            for (int dv = 0; dv < 4; ++dv) o[dv][r] *= wv[r]; }
    }
    float qn = 0.f;
#pragma unroll
    for (int d0 = 0; d0 < 8; ++d0) { const f32x4 n0 = *(const LAS f32x4*)(NVL + dir * 128 + d0 * 16 + hi * 8), n1 = *(const LAS f32x4*)(NVL + dir * 128 + d0 * 16 + hi * 8 + 4);
#pragma unroll
        for (int j = 0; j < 4; ++j) qn += bf2f((u16)qr[d0][j]) * n0[j] + bf2f((u16)qr[d0][4 + j]) * n1[j]; }
    qn = swap_add(qn);
    float rs = 0.f; const float Mt = MXA[dir * 128 + t];
    const int vrb = v_rd_base(lane);
#pragma unroll 1
    for (int kt = 0; kt < 2; ++kt) {
        f32x16 p0, p1; qkt<8>(p0, p1, KT + kt * 64 * 256, qr, r32, hi, 0);
        float u0[16], u1[16]; ld_rows16(U + dir * 128 + kt * 64, hi, u0); ld_rows16(U + dir * 128 + kt * 64 + 32, hi, u1);
#pragma unroll
        for (int r = 0; r < 16; ++r) { const int s0 = kt * 64 + crow(r, hi), s1 = s0 + 32;
            const bool v0 = dir ? (s0 >= t) : (s0 <= t), v1 = dir ? (s1 >= t) : (s1 <= t);
            const float f0 = v0 ? __builtin_amdgcn_exp2f((u0[r] - Mt) * LOG2E) : 0.f, f1 = v1 ? __builtin_amdgcn_exp2f((u1[r] - Mt) * LOG2E) : 0.f;
            p0[r] *= f0; p1[r] *= f1; rs += p0[r] + p1[r]; }
        bf16x8 pa0, pa1, pa2, pa3; PK4(p0, 0, pa0); PK4(p0, 8, pa1); PK4(p1, 0, pa2); PK4(p1, 8, pa3);
        pv_tile(o, VI + kt * 16384 + vrb, pa0, pa1, pa2, pa3);
    }
    rs = swap_add(rs);
    if (mx == 0) { const float den = rs + WI[dir * 128 + t] * qn; const float hs = 1.f / fmaxf(fabsf(den), FL[dir * 128 + t]);
        if (hi == 0) HS[wid * 32 + r32] = hs;
        WAIT_L(0);
        float sv[16]; ld_rows16(HS + wid * 32, hi, sv);
#pragma unroll
        for (int r = 0; r < 16; ++r) {
#pragma unroll
            for (int dv = 0; dv < 4; ++dv) o[dv][r] *= sv[r]; } }
    __syncthreads();
    LAS float* T = (LAS float*)lds;
    if (dir == 1) {
#pragma unroll
        for (int dv = 0; dv < 4; ++dv)
#pragma unroll
            for (int r = 0; r < 16; ++r) T[(tb * 32 + crow(r, hi)) * 132 + dv * 32 + r32] = o[dv][r]; }
    __syncthreads();
    if (dir == 0) {
#pragma unroll
        for (int dv = 0; dv < 4; ++dv) { float tv[16];
#pragma unroll
            for (int r = 0; r < 16; ++r) tv[r] = T[(tb * 32 + crow(r, hi)) * 132 + dv * 32 + r32];
            SBAR();
#pragma unroll
            for (int r = 0; r < 16; ++r) T[(tb * 32 + crow(r, hi)) * 132 + dv * 32 + r32] = tv[r] + o[dv][r];
            SBAR(); } }
    __syncthreads();
    {
        const int tt = tid >> 2, sg = tid & 3, row = row0 + tt;
        const float* G = (mx ? p.in[12] : p.in[10]) + h * 128 + sg * 32;
        const u16* gp = proj + (size_t)row * 4096 + gcol + sg * 32;
        u32x4 gw[4];
#pragma unroll
        for (int i = 0; i < 4; ++i) gw[i] = *(const u32x4*)(gp + i * 8);
        float x[32], s1 = 0.f, s2 = 0.f;
#pragma unroll
        for (int i = 0; i < 8; ++i) { const f32x4 v = *(const LAS f32x4*)(T + tt * 132 + sg * 32 + i * 4); x[4 * i] = v[0]; x[4 * i + 1] = v[1]; x[4 * i + 2] = v[2]; x[4 * i + 3] = v[3]; }
        float gt[32];
#pragma unroll
        for (int i = 0; i < 4; ++i)
#pragma unroll
            for (int e = 0; e < 4; ++e) { gt[i * 8 + 2 * e] = bflo(gw[i][e]); gt[i * 8 + 2 * e + 1] = bfhi(gw[i][e]); }
#pragma unroll
        for (int i = 0; i < 32; ++i) { if (mx == 0) x[i] *= gt[i]; s1 += x[i]; s2 += x[i] * x[i]; }
        s1 += dpp_f<0xB1>(s1); s1 += dpp_f<0x4E>(s1); s2 += dpp_f<0xB1>(s2); s2 += dpp_f<0x4E>(s2);
        const float mu = s1 * (1.f / 128.f), var = fmaxf(s2 * (1.f / 128.f) - mu * mu, 0.f), rstd = rsqrtf(var + EPS);
        u16* op = (u16*)(p.ws + WS_X1) + (size_t)row * 1024 + mx * 512 + h * 128 + sg * 32;
#pragma unroll
        for (int i = 0; i < 4; ++i) { const f32x4 g0 = *(const f32x4*)(G + i * 8), g1 = *(const f32x4*)(G + i * 8 + 4); float y[8];
#pragma unroll
            for (int e = 0; e < 8; ++e) { y[e] = (x[i * 8 + e] - mu) * rstd * (e < 4 ? g0[e] : g1[e - 4]); if (mx) y[e] *= gt[i * 8 + e]; }
            *(u32x4*)(op + i * 8) = (u32x4){cvtpk(y[0], y[1]), cvtpk(y[2], y[3]), cvtpk(y[4], y[5]), cvtpk(y[6], y[7])}; }
    }
    __syncthreads();
}

constexpr int R_WT = 0;
constexpr int R_PITCH = 1028;
constexpr int MOE_ARR = 148480;
__device__ __forceinline__ void reduce36(float (&a)[36], float (&t)[9]) {
    float s[18];
#pragma unroll
    for (int j = 0; j < 18; ++j) { auto rr = __builtin_amdgcn_permlane32_swap(__float_as_uint(a[j]), __float_as_uint(a[j + 18]), false, false); s[j] = __uint_as_float(rr[0]) + __uint_as_float(rr[1]); }
#pragma unroll
    for (int j = 0; j < 9; ++j) { auto rr = __builtin_amdgcn_permlane16_swap(__float_as_uint(s[j]), __float_as_uint(s[j + 9]), false, false); t[j] = row_sum16(__uint_as_float(rr[0]) + __uint_as_float(rr[1])); }
}
template <int L>
__device__ __forceinline__ void route_row(const Params& p, const LAS float* lg, int r, int slot, LAS int* LCNT, LAS int* SLOT, int lane) {
    const f32x4 gq = *(const LAS f32x4*)lg;
    const float g0 = gq[0], g1 = gq[1], g2 = gq[2], g3 = gq[3];
    int grp = 0; float gm = g0; if (g1 > gm) { gm = g1; grp = 1; } if (g2 > gm) { gm = g2; grp = 2; } if (g3 > gm) { gm = g3; grp = 3; }
    const float pg = 1.f / (__expf(g0 - gm) + __expf(g1 - gm) + __expf(g2 - gm) + __expf(g3 - gm));
    int i0 = 0, i1 = -1; float m0 = -3.0e38f, m1 = -3.0e38f;
    const f32x4 ea4 = *(const LAS f32x4*)(lg + 4 + grp * 8), eb4 = *(const LAS f32x4*)(lg + 8 + grp * 8);
#pragma unroll
    for (int j = 0; j < 8; ++j) { const float v = j < 4 ? ea4[j & 3] : eb4[j & 3];
        if (v > m0) { m1 = m0; i1 = i0; m0 = v; i0 = j; } else if (v > m1) { m1 = v; i1 = j; } }
    const float e1 = __expf(m1 - m0), den = 1.f / (1.f + e1);
    const float w0 = pg * den, w1 = pg * e1 * den;
    if (lane == 0) { const int ea = grp * 8 + i0, eb = grp * 8 + i1;
        const int la = (int)__hip_atomic_fetch_add((LAS unsigned*)&LCNT[ea], 1u, __ATOMIC_RELAXED, __HIP_MEMORY_SCOPE_WORKGROUP), lb = (int)__hip_atomic_fetch_add((LAS unsigned*)&LCNT[eb], 1u, __ATOMIC_RELAXED, __HIP_MEMORY_SCOPE_WORKGROUP);
        LAS int* sl = SLOT + slot * 4; sl[0] = ea; sl[1] = eb; sl[2] = la; sl[3] = lb;
        int* asge = (int*)(p.ws + WS_ASGE); float* asgg = (float*)(p.ws + WS_ASGG);
        asge[2 * r] = ea; asge[2 * r + 1] = eb; asgg[2 * r] = w0; asgg[2 * r + 1] = w1; }
}
template <int L>
__device__ __forceinline__ void phase_router(const Params& p, LAS unsigned char* lds, int bid, int nblk) {
    const int tid = threadIdx.x, wid = tid >> 6, lane = tid & 63;
    LAS float* wt = (LAS float*)(lds + R_WT);
    for (int i = tid; i < 4 * 1024; i += NTHR) { const int k = i >> 2, j = i & 3; wt[j * R_PITCH + k] = p.in[18][(size_t)L * 4096 + i]; }
    for (int i = tid; i < 32 * 1024; i += NTHR) { const int k = i >> 5, j = i & 31; wt[(4 + j) * R_PITCH + k] = p.in[20][(size_t)L * 32768 + i]; }
    const float* mod = (const float*)(p.ws + WS_MOD);
    unsigned* cnt = (unsigned*)(p.ws + WS_CTL) + CW_CNT + L * 64;
    int* asgr = (int*)(p.ws + WS_ASGR); int* list = (int*)(p.ws + WS_LIST);
    LAS int* LCNT = (LAS int*)(lds + MOE_ARR); LAS int* LBASE = LCNT + 32; LAS int* SLOT = LCNT + 64;
    LAS float* LG = (LAS float*)(lds + MOE_ARR + 4096) + wid * 80;
    if (tid < 32) LCNT[tid] = 0;
    __syncthreads();
    const int base = (L == 0 ? 0 : NCTX), nr = NROW - base, gwv = bid * 8 + __builtin_amdgcn_readfirstlane(wid), nwv = nblk * 8;
    const int rs = base + (int)(((long)gwv * nr) / nwv), re = base + (int)(((long)(gwv + 1) * nr) / nwv);
    const int qperm = ((lane >> 4) == 1) ? 2 : ((lane >> 4) == 2) ? 1 : (lane >> 4);
    LAS float* BQ = (LAS float*)(lds + MOE_ARR + 4096) + 8 * 80;
    if (tid < 36) BQ[tid] = tid < 4 ? p.in[19][L * 4 + tid] : p.in[21][L * 32 + tid - 4];
    __syncthreads();
    AdaC ac; int curmv = -1;
    f32x4 xa[4], xb[4];
    load_row(h_row(p, rs), lane, xa); load_row(h_row(p, rs + 1 < re ? rs + 1 : rs), lane, xb);
#define R_FMA4(acc, x, w, o) acc += x[0][0] * w[o][0] + x[0][1] * w[o][1] + x[0][2] * w[o][2] + x[0][3] * w[o][3] + x[1][0] * w[o + 1][0] + x[1][1] * w[o + 1][1] + x[1][2] * w[o + 1][2] + x[1][3] * w[o + 1][3] \
        + x[2][0] * w[o + 2][0] + x[2][1] * w[o + 2][1] + x[2][2] * w[o + 2][2] + x[2][3] * w[o + 2][3] + x[3][0] * w[o + 3][0] + x[3][1] * w[o + 3][1] + x[3][2] * w[o + 3][2] + x[3][3] * w[o + 3][3]
#define R_RED4(a0, a1, a2, a3, DST) do { \
        auto r01 = __builtin_amdgcn_permlane32_swap(__float_as_uint(a0), __float_as_uint(a1), false, false); const float s01 = __uint_as_float(r01[0]) + __uint_as_float(r01[1]); \
        auto r23 = __builtin_amdgcn_permlane32_swap(__float_as_uint(a2), __float_as_uint(a3), false, false); const float s23 = __uint_as_float(r23[0]) + __uint_as_float(r23[1]); \
        auto rq = __builtin_amdgcn_permlane16_swap(__float_as_uint(s01), __float_as_uint(s23), false, false); const float tg = row_sum16(__uint_as_float(rq[0]) + __uint_as_float(rq[1])); \
        if ((lane & 15) == 0) (DST)[4 * g + qperm] = tg + BQ[4 * g + qperm]; } while (0)
#define R_STEP2(R, x, y) do { const int r = (R); const bool hasB = (r + 1) < re; const int rb = hasB ? r + 1 : r; \
        { const int mv = row_modvec(r); if (mv != curmv) { const float* m = mod + (size_t)(L * 5 + mv) * 6144; adac_load(ac, p.in[7] + L * 1024, m + 3 * 1024, m + 4 * 1024, lane); curmv = mv; } \
          const float rstd = row_rstd(x); adaln_apply(x, rstd, ac); store_row_bf16((u16*)(p.ws + WS_X1) + (size_t)r * D, lane, x); } \
        { const int mv = row_modvec(rb); if (mv != curmv) { const float* m = mod + (size_t)(L * 5 + mv) * 6144; adac_load(ac, p.in[7] + L * 1024, m + 3 * 1024, m + 4 * 1024, lane); curmv = mv; } \
          const float rstd = row_rstd(y); adaln_apply(y, rstd, ac); store_row_bf16((u16*)(p.ws + WS_X1) + (size_t)rb * D, lane, y); } \
        _Pragma("unroll") for (int g = 0; g < 9; ++g) { float a0 = 0.f, a1 = 0.f, a2 = 0.f, a3 = 0.f, b0 = 0.f, b1 = 0.f, b2 = 0.f, b3 = 0.f; \
            { f32x4 w[8];        \
              _Pragma("unroll") for (int t = 0; t < 8; ++t) w[t] = *(const LAS f32x4*)(wt + (4 * g + (t >> 2)) * R_PITCH + (t & 3) * 256 + lane * 4); \
              SBAR(); R_FMA4(a0, x, w, 0); R_FMA4(a1, x, w, 4); R_FMA4(b0, y, w, 0); R_FMA4(b1, y, w, 4); SBAR(); } \
            { f32x4 w[8]; \
              _Pragma("unroll") for (int t = 0; t < 8; ++t) w[t] = *(const LAS f32x4*)(wt + (4 * g + 2 + (t >> 2)) * R_PITCH + (t & 3) * 256 + lane * 4); \
              SBAR(); R_FMA4(a2, x, w, 0); R_FMA4(a3, x, w, 4); R_FMA4(b2, y, w, 0); R_FMA4(b3, y, w, 4); SBAR(); } \
            R_RED4(a0, a1, a2, a3, LG); R_RED4(b0, b1, b2, b3, LG + 40); SBAR(); } \
        { const int n0 = r + 2 < re ? r + 2 : re - 1, n1 = r + 3 < re ? r + 3 : re - 1; load_row(h_row(p, n0), lane, x); load_row(h_row(p, n1), lane, y); }        \
        route_row<L>(p, LG, r, (r - rs) * 8 + wid, LCNT, SLOT, lane); \
        if (hasB) route_row<L>(p, LG + 40, rb, (rb - rs) * 8 + wid, LCNT, SLOT, lane); } while (0)
    for (int r0 = rs; r0 < re; r0 += 2) R_STEP2(r0, xa, xb);
#undef R_STEP2
#undef R_RED4
#undef R_FMA4
    __syncthreads();
    if (tid < 32) { const unsigned n = (unsigned)LCNT[tid]; LBASE[tid] = n ? (int)atomicAdd(&cnt[tid], n) : 0; }
    __syncthreads();
    for (int r = rs; r < re; ++r) if (lane < 2) {
        const LAS int* sl = SLOT + ((r - rs) * 8 + wid) * 4; const int e = sl[lane], rank = LBASE[e] + sl[2 + lane];
        list[(size_t)e * NROW + rank] = r; asgr[2 * r + lane] = rank; }
}
__device__ __forceinline__ void moe_tables(const Params& p, LAS unsigned char* lds, int L) {
    LAS int* CNT = (LAS int*)(lds + MOE_ARR); LAS int* OFF = CNT + 32; LAS int* TIL = CNT + 64;
    if (threadIdx.x < 32) CNT[threadIdx.x] = (int)xb_ld((unsigned*)(p.ws + WS_CTL) + CW_CNT + L * 64 + threadIdx.x);
    __syncthreads();
    if (threadIdx.x == 0) { int o = 0, t = 0; for (int e = 0; e < 32; ++e) { OFF[e] = o; TIL[e] = t; o += CNT[e]; t += (CNT[e] + 255) >> 8; } TIL[32] = t; }
    __syncthreads();
}
__device__ __forceinline__ int find_expert(const LAS int* TIL, int tile) { int e = 0;
#pragma unroll
    for (int j = 1; j < 32; ++j) e += (TIL[j] <= tile) ? 1 : 0;
    return e; }
__device__ __forceinline__ void phase_up(const Params& p, LAS unsigned char* lds, int bid, int nblk, int L) {
    moe_tables(p, lds, L);
    LAS int* CNT = (LAS int*)(lds + MOE_ARR); LAS int* OFF = CNT + 32; LAS int* TIL = CNT + 64;
    pg::MoeSched<true> S; S.A = (const char*)(p.ws + WS_X1); S.Bt = (const char*)(p.ws + WS_W13); S.CNT = CNT; S.OFF = OFF; S.TIL = TIL; S.list = (const int*)(p.ws + WS_LIST);
    S.RIDX = CNT + 128; S.nwg = __builtin_amdgcn_readfirstlane(TIL[32]) * 4; S.G = nblk; S.c = bid; S.K = 1024; S.fallback = (L == 0 ? 0 : NCTX);
    EpiUp E{(u16*)(p.ws + WS_H), OFF};
    pg::gemm_phase<true>(lds, 1024, S, E);
}
__device__ __forceinline__ void phase_down(const Params& p, LAS unsigned char* lds, int bid, int nblk, int L) {
    moe_tables(p, lds, L);
    LAS int* CNT = (LAS int*)(lds + MOE_ARR); LAS int* OFF = CNT + 32; LAS int* TIL = CNT + 64;
    pg::MoeSched<false> S; S.A = (const char*)(p.ws + WS_H); S.Bt = (const char*)(p.ws + WS_W2); S.CNT = CNT; S.OFF = OFF; S.TIL = TIL; S.list = nullptr;
    S.RIDX = CNT + 128; S.nwg = __builtin_amdgcn_readfirstlane(TIL[32]) * 4; S.G = nblk; S.c = bid; S.K = 512; S.fallback = 0;
    EpiDown E{(u16*)(p.ws + WS_YB), OFF};
    pg::gemm_phase<true>(lds, 512, S, E);
}
template <int L>
__device__ __forceinline__ void phase_combine(const Params& p, LAS unsigned char* lds, int bid, int nblk) {
    moe_tables(p, lds, L);
    LAS int* OFF = (LAS int*)(lds + MOE_ARR) + 32;
    const int tid = threadIdx.x, wid = tid >> 6, lane = tid & 63;
    const float* mod = (const float*)(p.ws + WS_MOD);
    const int* asge = (const int*)(p.ws + WS_ASGE); const int* asgr = (const int*)(p.ws + WS_ASGR); const float* asgg = (const float*)(p.ws + WS_ASGG);
    const u16* yb = (const u16*)(p.ws + WS_YB);
    const int r0 = (L == 0 ? 0 : NCTX) + bid * 8 + wid, stride = nblk * 8;
    f32x4 x[4]; u32x2 ya[4], yq[4]; float ga = 0.f, gb = 0.f;
#define C_LOAD(rr, X, YA, YQ, GA, GB) do { load_row(h_row(p, rr), lane, X); const int ea_ = asge[2 * (rr)], eb_ = asge[2 * (rr) + 1]; GA = asgg[2 * (rr)]; GB = asgg[2 * (rr) + 1]; \
        const u16* pa_ = yb + (size_t)(OFF[ea_] + asgr[2 * (rr)]) * 1024 + lane * 4; const u16* pb_ = yb + (size_t)(OFF[eb_] + asgr[2 * (rr) + 1]) * 1024 + lane * 4; \
        _Pragma("unroll") for (int i = 0; i < 4; ++i) { YA[i] = *(const u32x2*)(pa_ + i * 256); YQ[i] = *(const u32x2*)(pb_ + i * 256); } } while (0)
    if (r0 < NROW) C_LOAD(r0, x, ya, yq, ga, gb);
    for (int r = r0; r < NROW; r += stride) {
        float* hp = h_row(p, r);
        const float* m = mod + (size_t)(L * 5 + row_modvec(r)) * 6144;
        f32x4 g2[4]; AdaC ac;
#pragma unroll
        for (int i = 0; i < 4; ++i) g2[i] = *(const f32x4*)(m + 5 * 1024 + i * 256 + lane * 4);
        if (L == 0) { const float* m1 = mod + (size_t)(1 * 5 + row_modvec(r)) * 6144; adac_load(ac, p.in[6] + 1024, m1, m1 + 1024, lane); }
        else {
#pragma unroll
            for (int i = 0; i < 4; ++i) ac.g[i] = *(const f32x4*)(p.in[25] + i * 256 + lane * 4); }
        SBAR();
        const int rn = r + stride; f32x4 nx[4]; u32x2 nya[4], nyq[4]; float nga = 0.f, ngb = 0.f;
        if (rn < NROW) C_LOAD(rn, nx, nya, nyq, nga, ngb);
        SBAR();
#pragma unroll
        for (int i = 0; i < 4; ++i) { const u32x2 a = ya[i], bq = yq[i]; const f32x4 g = g2[i];
            x[i][0] += g[0] * (ga * bflo(a[0]) + gb * bflo(bq[0])); x[i][1] += g[1] * (ga * bfhi(a[0]) + gb * bfhi(bq[0]));
            x[i][2] += g[2] * (ga * bflo(a[1]) + gb * bflo(bq[1])); x[i][3] += g[3] * (ga * bfhi(a[1]) + gb * bfhi(bq[1])); }
        const float rstd = row_rstd(x);
        if (L == 0) {
#pragma unroll
            for (int i = 0; i < 4; ++i) *(f32x4*)(hp + i * 256 + lane * 4) = x[i];
            adaln_apply(x, rstd, ac);
            store_row_bf16((u16*)(p.ws + WS_X1) + (size_t)r * D, lane, x);
        } else {
#pragma unroll
            for (int i = 0; i < 4; ++i) { const f32x4 g = ac.g[i]; f32x4 y = {x[i][0] * rstd * g[0], x[i][1] * rstd * g[1], x[i][2] * rstd * g[2], x[i][3] * rstd * g[3]}; *(f32x4*)(hp + i * 256 + lane * 4) = y; }
        }
        if (rn < NROW) { ga = nga; gb = ngb;
#pragma unroll
            for (int i = 0; i < 4; ++i) { x[i] = nx[i]; ya[i] = nya[i]; yq[i] = nyq[i]; } }
    }
#undef C_LOAD
}

constexpr int A_SHM_V = 16384, A_SHM_K = 16384;
constexpr float A_SCALE = 0.125f, A_THR = 8.f;
__device__ __forceinline__ void smA(f32x16& p0, f32x16& p1, float mC) {
#pragma unroll
    for (int r = 0; r < 16; ++r) p0[r] = __builtin_amdgcn_exp2f(p0[r]);
}
__device__ __forceinline__ void smB(f32x16& p0, f32x16& p1, float& l_reg, bf16x8& pa0, bf16x8& pa1, bf16x8& pa2, bf16x8& pa3) {
#pragma unroll
    for (int r = 0; r < 16; ++r) p1[r] = __builtin_amdgcn_exp2f(p1[r]);
    float ps = 0;
#pragma unroll
    for (int r = 0; r < 16; ++r) ps += p0[r];
#pragma unroll
    for (int r = 0; r < 16; ++r) ps += p1[r];
    l_reg += ps;
    PK4(p0, 0, pa0); PK4(p0, 8, pa1); PK4(p1, 0, pa2); PK4(p1, 8, pa3);
}
__device__ __forceinline__ void attn_unit(const Params& p, LAS unsigned char* lds, int u, float lam) {
    int tz0 = threadIdx.x; asm volatile("" : "+v"(tz0));
    const int tid = tz0, wid = __builtin_amdgcn_readfirstlane(tid >> 6), lane = tid & 63, r32 = lane & 31, hi = lane >> 5;
    const int qt = u & 63, h = (u >> 6) & 7, b = u >> 9, map = wid >> 2, tb = wid & 3;
    unsigned long long wsb = (unsigned long long)(p.ws + WS_PROJ); asm volatile("" : "+s"(wsb));
    const u16* proj = (const u16*)wsb;
    LAS float* li_l = (LAS float*)(lds + 131072) + wid * 64;
    const int qrow0 = NCTX + b * SEQ + qt * 128;
    float l_reg = 0; f32x16 o[4] = {}; bf16x8 qr[4];
    { const u16* qp = proj + (size_t)(qrow0 + tb * 32 + r32) * 3072 + h * 128 + map * 64 + hi * 8;
#pragma unroll
      for (int d0 = 0; d0 < 4; ++d0) qr[d0] = *(const bf16x8*)(qp + d0 * 16); }
    float mC;
    {   float qn2 = 0.f;
#pragma unroll
        for (int d0 = 0; d0 < 4; ++d0)
#pragma unroll
            for (int j = 0; j < 8; ++j) { const float x = bf2f((u16)qr[d0][j]); qn2 += x * x; }
        qn2 = swap32_add(qn2);
        unsigned* km = (unsigned*)(p.ws + WS_CTL) + CW_KMAX + (b * 8 + h) * 4 + map * 2;
        const float kb2 = __uint_as_float(xb_ld(km)) + __uint_as_float(xb_ld(km + 1));
        mC = sqrtf(qn2 * kb2) * (1.02f * A_SCALE * LOG2E);
#pragma unroll
        for (int d0 = 0; d0 < 4; ++d0) { u32x4 w = __builtin_bit_cast(u32x4, qr[d0]);
#pragma unroll
            for (int e = 0; e < 4; ++e) w[e] = cvtpk(bflo(w[e]) * (A_SCALE * LOG2E), bfhi(w[e]) * (A_SCALE * LOG2E));
            qr[d0] = __builtin_bit_cast(bf16x8, w); } }
    f32x16 negm;
#pragma unroll
    for (int r = 0; r < 16; ++r) negm[r] = -mC;
    constexpr int A_SLOT = 32768, NT = 132;
    const unsigned vrd = (unsigned)(unsigned long long)(lds + v_rd_base(lane));
    const int kcb = map * 128;
    unsigned koff0, voff0;
    {   const int P0 = tid;
        { const int row = P0 >> 4, c = ((P0 & 15) ^ (row & 15)) * 8; koff0 = (unsigned)(row * 3072 + 1024 + h * 128 + c); }
        { const int sub = P0 >> 5, kk = (sub >> 2) * 8 + ((P0 >> 2) & 7), c = (sub & 3) * 32 + (P0 & 3) * 8, k = (kk & ~0xC) | ((kk & 4) << 1) | ((kk & 8) >> 1); voff0 = (unsigned)(k * 3072 + 2048 + h * 128 + c); } }
#define KROW(j) ((j) < 4 ? b * 256 + (j) * 64 : NCTX + b * SEQ + ((j) - 4) * 64)
#define ADMA(j) do { const u16* g_ = proj + (size_t)KROW(j) * 3072; LAS unsigned char* s_ = lds + ((j) & 3) * A_SLOT + wid * 1024; \
        glds16(g_ + voff0, s_); glds16(g_ + voff0 + 32 * 3072, s_ + 8192); glds16(g_ + koff0, s_ + 16384); glds16(g_ + koff0 + 32 * 3072, s_ + 16384 + 8192); } while (0)
#define A_WAITBAR(N) do { asm volatile("s_waitcnt vmcnt(" #N ") lgkmcnt(0)" ::: "memory"); BAR(); } while (0)
#define A_ITER(j, PC0, PC1, PP0, PP1, N, DMA) do { A_WAITBAR(N); if (DMA) ADMA((j) + 2); SBAR(); \
        qkt_init<4>(PC0, PC1, lds + ((j) & 3) * A_SLOT + 16384, qr, r32, hi, kcb, negm); \
        smB(PP0, PP1, l_reg, pa0, pa1, pa2, pa3); SBAR(); \
        pv_tile_asm(o, vrd + (((j) - 1) & 3) * A_SLOT, pa0, pa1, pa2, pa3); \
        smA(PC0, PC1, mC); SBAR(); } while (0)
    f32x16 pA0, pA1, pB0, pB1; bf16x8 pa0, pa1, pa2, pa3;
    ADMA(0); ADMA(1);
    A_WAITBAR(4); ADMA(2);
    qkt_init<4>(pA0, pA1, lds + 16384, qr, r32, hi, kcb, negm); smA(pA0, pA1, mC);
    for (int j0 = 1; j0 < NT - 1; j0 += 2) {
        A_ITER(j0, pB0, pB1, pA0, pA1, 4, (j0 + 2 < NT)); A_ITER(j0 + 1, pA0, pA1, pB0, pB1, 4, (j0 + 3 < NT));
    }
    A_ITER(NT - 1, pB0, pB1, pA0, pA1, 0, false);
    smB(pB0, pB1, l_reg, pa0, pa1, pa2, pa3);
    pv_tile_asm(o, vrd + ((NT - 1) & 3) * A_SLOT, pa0, pa1, pa2, pa3);
    l_reg = swap32_add(l_reg);
    asm volatile("" : "+v"(tz0));
    const int lane_e = tz0 & 63, r32e = lane_e & 31, hie = lane_e >> 5;
    if (hie == 0) li_l[r32e] = l_reg; WAIT_L(0);
#pragma unroll
    for (int r = 0; r < 16; ++r) { const float rl = __builtin_amdgcn_rcpf(li_l[crow(r, hie)]);
#pragma unroll
        for (int d = 0; d < 4; ++d) o[d][r] *= rl; }
    __syncthreads();
    LAS float* EX = (LAS float*)lds;
    if (map == 1) {
#pragma unroll
        for (int d = 0; d < 4; ++d)
#pragma unroll
            for (int r = 0; r < 16; ++r) EX[((tb * 4 + d) * 16 + r) * 64 + lane_e] = o[d][r]; }
    __syncthreads();
    if (map == 0) {
        const float* G = p.in[16] + h * 128; float gv[4];
#pragma unroll
        for (int d = 0; d < 4; ++d) gv[d] = G[d * 32 + r32e] * (1.f - LAM_INIT);
#pragma unroll
        for (int r = 0; r < 16; ++r) { float x[4], s2 = 0.f;
#pragma unroll
            for (int d = 0; d < 4; ++d) { x[d] = o[d][r] - lam * EX[((tb * 4 + d) * 16 + r) * 64 + lane_e]; s2 += x[d] * x[d]; }
            s2 = half_sum(s2); const float rstd = rsqrtf(s2 * (1.f / 128.f) + EPS);
            u16* op = (u16*)(p.ws + WS_X1) + (size_t)(qrow0 + tb * 32 + crow(r, hie)) * 1024 + h * 128 + r32e;
#pragma unroll
            for (int d = 0; d < 4; ++d) op[d * 32] = f2bf(x[d] * rstd * gv[d]); }
    }
    __syncthreads();
#undef KROW
#undef ADMA
#undef A_WAITBAR
#undef A_ITER
}

constexpr int NPH = 18;
__global__ void __launch_bounds__(NTHR, 2) mega(Params p, int ph_lo, int ph_hi) {
    extern __shared__ __attribute__((aligned(16))) unsigned char smem_[];
    LAS unsigned char* lds = (LAS unsigned char*)smem_;
    const int bid = blockIdx.x, nblk = gridDim.x, tid = threadIdx.x;
    volatile LAS unsigned* xbw = (volatile LAS unsigned*)(lds + LDS_MISC);
    if (tid < 4) xbw[tid] = 0u;
    __syncthreads();
    XcdBarrier bar; bar.bar = (unsigned*)(p.ws + WS_CTL) + CW_BAR; bar.x = 0; bar.st = xbw;
    if (ph_hi - ph_lo > 1) bar = xcd_barrier_post((unsigned*)(p.ws + WS_CTL) + CW_BAR, xbw);
#ifndef PHMASK
#define PHMASK 0x3ffff
#endif
#define IN(k) (((PHMASK >> (k)) & 1) && ph_lo <= (k) && (k) < ph_hi)
#define SEAM(k) do { if (IN(k) && IN((k) + 1)) xcd_barrier(bar); } while (0)
#ifndef REPMASK
#define REPMASK 0
#endif
#define NREP(k) (1 + ((REPMASK >> (k)) & 1))
    if (IN(0)) for (int rep_ = 0; rep_ < NREP(0); ++rep_) { if (rep_) xcd_barrier(bar); phase0(p, lds, bid, nblk); } SEAM(0);
    if (IN(1)) for (int rep_ = 0; rep_ < NREP(1); ++rep_) { if (rep_) xcd_barrier(bar); phase1(p, lds, bid, nblk); } SEAM(1);
    if (IN(2)) for (int rep_ = 0; rep_ < NREP(2); ++rep_) { if (rep_) xcd_barrier(bar); phase2(p, lds, bid, nblk); } SEAM(2);
    if (IN(3)) for (int rep_ = 0; rep_ < NREP(3); ++rep_) { if (rep_) xcd_barrier(bar); for (int u = bid; u < 2 * 16 * NCH; u += nblk) s1_unit(p, lds, u); } SEAM(3);
    if (IN(4)) for (int rep_ = 0; rep_ < NREP(4); ++rep_) { if (rep_) xcd_barrier(bar); phase_s2(p, bid, nblk); } SEAM(4);
    if (IN(5)) for (int rep_ = 0; rep_ < NREP(5); ++rep_) { if (rep_) xcd_barrier(bar); for (int u = bid; u < 2 * 16 * NCH; u += nblk) s3_unit(p, lds, u); } SEAM(5);
    if (IN(6)) for (int rep_ = 0; rep_ < NREP(6); ++rep_) { if (rep_) xcd_barrier(bar); phase_outproj<0>(p, lds, bid, nblk); } SEAM(6);
    if (IN(7)) for (int rep_ = 0; rep_ < NREP(7); ++rep_) { if (rep_) xcd_barrier(bar); phase_router<0>(p, lds, bid, nblk); } SEAM(7);
    if (IN(8)) for (int rep_ = 0; rep_ < NREP(8); ++rep_) { if (rep_) xcd_barrier(bar); phase_up(p, lds, bid, nblk, 0); } SEAM(8);
    if (IN(9)) for (int rep_ = 0; rep_ < NREP(9); ++rep_) { if (rep_) xcd_barrier(bar); phase_down(p, lds, bid, nblk, 0); } SEAM(9);
    if (IN(10)) for (int rep_ = 0; rep_ < NREP(10); ++rep_) { if (rep_) xcd_barrier(bar); phase_combine<0>(p, lds, bid, nblk); } SEAM(10);
    if (IN(11)) for (int rep_ = 0; rep_ < NREP(11); ++rep_) { if (rep_) xcd_barrier(bar); phase_inproj1(p, lds, bid, nblk); } SEAM(11);
    if (IN(12)) for (int rep_ = 0; rep_ < NREP(12); ++rep_) { if (rep_) xcd_barrier(bar);
        float lam;
        { const float* lp = p.in[15]; float a = 0, c = 0; for (int i = 0; i < 64; ++i) { a += lp[i] * lp[64 + i]; c += lp[128 + i] * lp[192 + i]; } lam = __builtin_bit_cast(float, __builtin_amdgcn_readfirstlane(__builtin_bit_cast(int, __expf(a) - __expf(c) + LAM_INIT))); }
        if (nblk == 256) { const int xg = bid & 7, sl = bid >> 3;
            for (int k = 0; k < 8; ++k) attn_unit(p, lds, ((xg + 8 * (k >> 1)) << 6) | (sl + 32 * (k & 1)), lam); }
        else for (int u = bid; u < NB * 8 * 64; u += nblk) attn_unit(p, lds, u, lam);
    } SEAM(12);
    if (IN(13)) for (int rep_ = 0; rep_ < NREP(13); ++rep_) { if (rep_) xcd_barrier(bar); phase_outproj<1>(p, lds, bid, nblk); } SEAM(13);
    if (IN(14)) for (int rep_ = 0; rep_ < NREP(14); ++rep_) { if (rep_) xcd_barrier(bar); phase_router<1>(p, lds, bid, nblk); } SEAM(14);
    if (IN(15)) for (int rep_ = 0; rep_ < NREP(15); ++rep_) { if (rep_) xcd_barrier(bar); phase_up(p, lds, bid, nblk, 1); } SEAM(15);
    if (IN(16)) for (int rep_ = 0; rep_ < NREP(16); ++rep_) { if (rep_) xcd_barrier(bar); phase_down(p, lds, bid, nblk, 1); } SEAM(16);
    if (IN(17)) { phase_combine<1>(p, lds, bid, nblk); }
}

extern "C" void kernel_launch(void* const* d_in, const int* in_sizes, int n_in, void* d_out, int out_size, void* d_ws, size_t ws_size, hipStream_t stream) {
    static int grid = 0;
    if (!grid) {
        if (n_in != 26 || out_size != NLAT * D || ws_size < WS_END) { fprintf(stderr, "kernel_launch: shape/ws mismatch n_in %d out %d ws %zu need %zu\n", n_in, out_size, ws_size, (size_t)WS_END); return; }
        if (hipFuncSetAttribute((const void*)mega, hipFuncAttributeMaxDynamicSharedMemorySize, LDS_TOTAL) != hipSuccess) { fprintf(stderr, "kernel_launch: LDS attribute failed\n"); return; }
        int dev = 0, cus = 0, per_cu = 0; hipGetDevice(&dev); hipDeviceGetAttribute(&cus, hipDeviceAttributeMultiprocessorCount, dev);
        hipOccupancyMaxActiveBlocksPerMultiprocessor(&per_cu, mega, NTHR, LDS_TOTAL);
        if (per_cu < 1) { fprintf(stderr, "kernel_launch: occupancy 0\n"); return; }
        grid = cus;
    }
    Params p{};
    for (int i = 0; i < 26; ++i) p.in[i] = (const float*)d_in[i];
    p.out = (float*)d_out; p.ws = (unsigned char*)d_ws;
    hipMemsetAsync((unsigned char*)d_ws + WS_CTL, 0, CTL_BYTES, stream);
#if SPLIT_LAUNCH
    for (int k = 0; k < NPH; ++k) hipLaunchKernelGGL(mega, dim3(grid), dim3(NTHR), LDS_TOTAL, stream, p, k, k + 1);
#else
    hipLaunchKernelGGL(mega, dim3(grid), dim3(NTHR), LDS_TOTAL, stream, p, 0, NPH);
#endif
}
```

```cpp
#include <hip/hip_runtime.h>
#include <cstdio>
#include <cstdint>

#define LAS __attribute__((address_space(3)))
typedef unsigned short u16;
using bf16x8 = __attribute__((ext_vector_type(8))) short;
using s16x4  = __attribute__((ext_vector_type(4))) short;
typedef short v4i16_t __attribute__((ext_vector_type(4)));
using f32x4  = __attribute__((ext_vector_type(4))) float;
using f32x16 = __attribute__((ext_vector_type(16))) float;
using u32x4  = __attribute__((ext_vector_type(4))) unsigned;
using u32x2  = __attribute__((ext_vector_type(2))) unsigned;
typedef __bf16 bf16x2_t __attribute__((ext_vector_type(2)));
typedef float f32x2_t __attribute__((ext_vector_type(2)));

#ifndef SPLIT_LAUNCH
#define SPLIT_LAUNCH 0
#endif

constexpr int D = 1024, NB = 4, SEQ = 8192, CTXL = 256;
constexpr int NCTX = NB * CTXL, NLAT = NB * SEQ, NROW = NCTX + NLAT;
constexpr int NCH = 66;
constexpr int NE = 32;
constexpr int NTHR = 512;
constexpr float EPS = 1e-6f;
constexpr float LOG2E = 1.4426950408889634f;
constexpr float LAM_INIT = 0.35550906f;

constexpr size_t al256(size_t x) { return (x + 255) / 256 * 256; }
constexpr size_t WS_CTL = 0, CTL_BYTES = 32768;
constexpr int CW_BAR = 0;
constexpr int CW_KMAX = 5120;
constexpr int CW_CNT = 4096;
constexpr size_t WS_MOD   = CTL_BYTES;
constexpr size_t WS_ROPE1 = WS_MOD + al256(2 * 5 * 6144 * 4);
constexpr size_t WS_ROPE2 = WS_ROPE1 + al256((size_t)8448 * 64 * 8);
constexpr size_t WS_GATEW = WS_ROPE2 + al256(128 * 16 * 8);
constexpr size_t WS_GATES = WS_GATEW + al256(16 * 1024 * 4);
constexpr size_t WS_HCTX  = WS_GATES + al256((size_t)NROW * 16 * 4);
constexpr size_t WS_STATS = WS_HCTX + al256((size_t)NCTX * D * 4);
constexpr size_t WS_MST   = WS_STATS + al256(32 * NCH * 2 * 4);
constexpr size_t WS_NV    = WS_MST + al256(32 * NCH * 4);
constexpr size_t WS_ASGE  = WS_NV + al256((size_t)32 * NCH * 128 * 4);
constexpr size_t WS_ASGR  = WS_ASGE + al256((size_t)NROW * 2 * 4);
constexpr size_t WS_ASGG  = WS_ASGR + al256((size_t)NROW * 2 * 4);
constexpr size_t WS_LIST  = WS_ASGG + al256((size_t)NROW * 2 * 4);
constexpr size_t WS_WINE  = WS_LIST + al256((size_t)NE * NROW * 4);
constexpr size_t WS_WOUTE = WS_WINE + (size_t)4096 * 1024 * 2;
constexpr size_t WS_WINO  = WS_WOUTE + (size_t)1024 * 1024 * 2;
constexpr size_t WS_WOUTO = WS_WINO + (size_t)3072 * 1024 * 2;
constexpr size_t WS_X1    = WS_WOUTO + (size_t)1024 * 1024 * 2;
constexpr size_t WS_PROJ  = WS_X1 + (size_t)NROW * 1024 * 2;
constexpr size_t PROJ_BYTES = (size_t)NROW * 4096 * 2;
constexpr int    HROWS = 2 * NROW + 256;
constexpr size_t WS_H     = WS_PROJ;
constexpr size_t WS_YB    = WS_H + (size_t)HROWS * 512 * 2;
static_assert(WS_YB + (size_t)HROWS * 1024 * 2 <= WS_PROJ + PROJ_BYTES, "moe buffers fit in proj");
constexpr size_t WS_STATES = WS_PROJ + PROJ_BYTES;
constexpr size_t STATES_BYTES = (size_t)64 * NCH * 16384 * 2;
constexpr size_t WS_W13   = WS_STATES;
constexpr size_t WS_W2    = WS_W13 + (size_t)NE * 1024 * 1024 * 2;
static_assert(WS_W2 + (size_t)NE * 1024 * 512 * 2 <= WS_STATES + STATES_BYTES, "moe weights fit in states");
constexpr size_t WS_END   = WS_STATES + STATES_BYTES;

constexpr int LDS_TOTAL = 163840;
constexpr int LDS_MISC  = LDS_TOTAL - 64;

struct Params { const float* in[26]; float* out; unsigned char* ws; };

__device__ __forceinline__ unsigned cvtpk(float lo, float hi) { f32x2_t v = {lo, hi}; bf16x2_t b = __builtin_convertvector(v, bf16x2_t); return __builtin_bit_cast(unsigned, b); }
__device__ __forceinline__ u16 f2bf(float x) { __bf16 b = (__bf16)x; return __builtin_bit_cast(u16, b); }
__device__ __forceinline__ float bf2f(u16 x) { return __uint_as_float(((unsigned)x) << 16); }
__device__ __forceinline__ float bflo(unsigned w) { return __uint_as_float(w << 16); }
__device__ __forceinline__ float bfhi(unsigned w) { return __uint_as_float(w & 0xffff0000u); }
template <int CTRL> __device__ __forceinline__ float dpp_f(float v) { return __builtin_bit_cast(float, __builtin_amdgcn_update_dpp(0, __builtin_bit_cast(int, v), CTRL, 0xf, 0xf, true)); }
__device__ __forceinline__ float row_sum16(float v) { v += dpp_f<0xB1>(v); v += dpp_f<0x4E>(v); v += dpp_f<0x141>(v); v += dpp_f<0x140>(v); return v; }
__device__ __forceinline__ float row_max16(float v) { v = fmaxf(v, dpp_f<0xB1>(v)); v = fmaxf(v, dpp_f<0x4E>(v)); v = fmaxf(v, dpp_f<0x141>(v)); v = fmaxf(v, dpp_f<0x140>(v)); return v; }
__device__ __forceinline__ float swap16_add(float v) { auto rr = __builtin_amdgcn_permlane16_swap(__float_as_uint(v), __float_as_uint(v), false, false); return __uint_as_float(rr[0]) + __uint_as_float(rr[1]); }
__device__ __forceinline__ float swap16_max(float v) { auto rr = __builtin_amdgcn_permlane16_swap(__float_as_uint(v), __float_as_uint(v), false, false); return fmaxf(__uint_as_float(rr[0]), __uint_as_float(rr[1])); }
__device__ __forceinline__ float swap32_add(float v) { auto rr = __builtin_amdgcn_permlane32_swap(__float_as_uint(v), __float_as_uint(v), false, false); return __uint_as_float(rr[0]) + __uint_as_float(rr[1]); }
__device__ __forceinline__ float swap32_max(float v) { auto rr = __builtin_amdgcn_permlane32_swap(__float_as_uint(v), __float_as_uint(v), false, false); return fmaxf(__uint_as_float(rr[0]), __uint_as_float(rr[1])); }
__device__ __forceinline__ float wave_sum(float v) { return swap32_add(swap16_add(row_sum16(v))); }
__device__ __forceinline__ float wave_max(float v) { return swap32_max(swap16_max(row_max16(v))); }
__device__ __forceinline__ float half_sum(float v) { return swap16_add(row_sum16(v)); }
__device__ __forceinline__ float sigmoidf_(float x) { return __builtin_amdgcn_rcpf(1.f + __expf(-x)); }
__device__ __forceinline__ float siluf_(float x) { return x * __builtin_amdgcn_rcpf(1.f + __expf(-x)); }
__device__ __forceinline__ int crow(int r, int hi) { return (r & 3) + 8 * (r >> 2) + 4 * hi; }
__device__ __forceinline__ float swap_add(float v) { auto rr = __builtin_amdgcn_permlane32_swap(__float_as_uint(v), __float_as_uint(v), false, false); return __uint_as_float(rr[0]) + __uint_as_float(rr[1]); }
__device__ __forceinline__ float swap_max(float v) { auto rr = __builtin_amdgcn_permlane32_swap(__float_as_uint(v), __float_as_uint(v), false, false); return fmaxf(__uint_as_float(rr[0]), __uint_as_float(rr[1])); }
__device__ __forceinline__ void glds16(const void* g, LAS unsigned char* l) { __builtin_amdgcn_global_load_lds((const unsigned*)g, (LAS unsigned*)l, 16, 0, 0); }
#define WAIT_V(n) asm volatile("s_waitcnt vmcnt(" #n ")" ::: "memory")
#define WAIT_L(n) asm volatile("s_waitcnt lgkmcnt(" #n ")" ::: "memory")
#define BAR() __builtin_amdgcn_s_barrier()
#define SBAR() __builtin_amdgcn_sched_barrier(0)

__device__ __forceinline__ int row_modvec(int r) { return r < NCTX ? 4 : ((r - NCTX) >> 13); }
__device__ __forceinline__ int row_pos(int r) { return r < NCTX ? (r & 255) : 256 + ((r - NCTX) & 8191); }
__device__ __forceinline__ int chunk_row0(int b, int ch) { return ch < 2 ? b * 256 + ch * 128 : NCTX + b * SEQ + (ch - 2) * 128; }

#define XB_TMO      128
#define XB_XCNT(j)  (256  + 64 * (j))
#define XB_XSUB(j)  (1280 + 64 * (j))
#define XB_XGEN(j)  (2304 + 64 * (j))
#define XB_TOP      3328
#define XB_TOPGEN   3392
#define XCD_BAR_WORDS 3456
#define XB_SPIN_CAP (1u << 18)
__device__ __forceinline__ unsigned xb_ld(unsigned* p)              { return __hip_atomic_load(p, __ATOMIC_RELAXED, __HIP_MEMORY_SCOPE_AGENT); }
__device__ __forceinline__ unsigned xb_add(unsigned* p, unsigned v) { return __hip_atomic_fetch_add(p, v, __ATOMIC_RELAXED, __HIP_MEMORY_SCOPE_AGENT); }
__device__ __forceinline__ unsigned xb_xcc_id() { return (unsigned)__builtin_amdgcn_s_getreg((3 << 11) | 20) & 0xFu; }
#define XB_SPIN(cond, bar) do { unsigned _sp = 0; while (cond) { __builtin_amdgcn_s_sleep(1); \
    if ((++_sp & 255u) == 0u) { if (xb_ld(&(bar)[XB_TMO])) break; if (_sp > XB_SPIN_CAP) { atomicAdd(&(bar)[XB_TMO], 1u); break; } } } } while (0)
struct XcdBarrier { unsigned* bar; unsigned x; volatile LAS unsigned* st; };
__device__ __forceinline__ XcdBarrier xcd_barrier_post(unsigned* bar, volatile LAS unsigned* st) {
    XcdBarrier b; b.bar = bar; b.x = xb_xcc_id(); b.st = st;
    if (threadIdx.x == 0) (void)xb_add(&bar[XB_XCNT(b.x)], 1u);
    return b;
}
__device__ __forceinline__ void xcd_barrier_complete(unsigned* bar, unsigned x, unsigned& nloc, unsigned& nx) {
    const unsigned G = gridDim.x * gridDim.y * gridDim.z;
    unsigned sum, cnt, mine, sp = 0u;
    for (;;) {
        sum = 0u; cnt = 0u; mine = 0u;
#pragma unroll
        for (unsigned j = 0; j < 16; ++j) { const unsigned c = xb_ld(&bar[XB_XCNT(j)]); sum += c; cnt += (c > 0u) ? 1u : 0u; mine = (j == x) ? c : mine; }
        if (sum == G) break;
        __builtin_amdgcn_s_sleep(1);
        if ((++sp & 255u) == 0u) { if (xb_ld(&bar[XB_TMO])) break; if (sp > XB_SPIN_CAP) { atomicAdd(&bar[XB_TMO], 1u); break; } }
    }
    nloc = mine > 0u ? mine : 1u; nx = cnt > 0u ? cnt : 1u;
}
__device__ __forceinline__ void xcd_barrier(const XcdBarrier& b) {
    asm volatile("s_waitcnt vmcnt(0)" ::: "memory");
    __syncthreads();
    if (threadIdx.x == 0) {
        unsigned* bar = b.bar;
        __builtin_amdgcn_s_waitcnt(0);
        unsigned nloc = b.st[0], nx = b.st[1];
        if (nloc == 0u) { xcd_barrier_complete(bar, b.x, nloc, nx); b.st[0] = nloc; b.st[1] = nx; }
        const unsigned old = xb_add(&bar[XB_XSUB(b.x)], 1u);
        const unsigned gen = old / nloc;
        if (old + 1u == (gen + 1u) * nloc) {
            __builtin_amdgcn_fence(__ATOMIC_RELEASE, "agent");
            asm volatile("s_waitcnt vmcnt(0)" ::: "memory");
            const unsigned og = xb_add(&bar[XB_TOP], 1u);
            const unsigned tg = og / nx;
            if (og + 1u == (tg + 1u) * nx) xb_add(&bar[XB_TOPGEN], 1u);
            else XB_SPIN(xb_ld(&bar[XB_TOPGEN]) == tg, bar);
            __builtin_amdgcn_fence(__ATOMIC_ACQUIRE, "agent");
            xb_add(&bar[XB_XGEN(b.x)], 1u);
            asm volatile("s_waitcnt vmcnt(0)" ::: "memory");
        } else {
            XB_SPIN(xb_ld(&bar[XB_XGEN(b.x)]) == gen, bar);
            __builtin_amdgcn_fence(__ATOMIC_ACQUIRE, "agent");
            asm volatile("s_waitcnt vmcnt(0)" ::: "memory");
        }
    }
    __syncthreads();
}

struct ConvJob { const float* src; u16* dst; int ldn, ldk; float scale; };
__device__ __forceinline__ void conv_load(const ConvJob& j, f32x4 (&r)[4]) {
#pragma unroll
    for (int i = 0; i < 2; ++i) { const int idx = threadIdx.x + i * NTHR, kp = idx >> 4, n4 = idx & 15; const float* s = j.src + (size_t)(2 * kp) * j.ldn + n4 * 4;
        r[2 * i] = *(const f32x4*)s; r[2 * i + 1] = *(const f32x4*)(s + j.ldn); }
}
__device__ __forceinline__ void conv_store(const ConvJob& j, const f32x4 (&r)[4], LAS unsigned char* lds) {
    LAS unsigned* scr = (LAS unsigned*)lds;
#pragma unroll
    for (int i = 0; i < 2; ++i) { const int idx = threadIdx.x + i * NTHR, kp = idx >> 4, n4 = idx & 15;
#pragma unroll
        for (int e = 0; e < 4; ++e) scr[(n4 * 4 + e) * 65 + kp] = cvtpk(r[2 * i][e] * j.scale, r[2 * i + 1][e] * j.scale); }
    __syncthreads();
    { const int n = threadIdx.x >> 3, c8 = threadIdx.x & 7; const LAS unsigned* q = scr + n * 65 + c8 * 8;
      u32x4 w0 = {q[0], q[1], q[2], q[3]}, w1 = {q[4], q[5], q[6], q[7]};
      u16* o = j.dst + (size_t)n * j.ldk + c8 * 16; *(u32x4*)o = w0; *(u32x4*)(o + 8) = w1; }
    __syncthreads();
}
template <class JobFn>
__device__ __forceinline__ void conv_stream(int first, int stride, int total, const JobFn& jf, LAS unsigned char* lds) {
    if (first >= total) return;
    const int last = first + ((total - 1 - first) / stride) * stride;
    ConvJob ja = jf(first), jb = jf(first + stride <= last ? first + stride : last), jc = ja;
    f32x4 ra[4], rb[4], rc[4]; conv_load(ja, ra); conv_load(jb, rb);
    int u = first;
    for (; u + 2 * stride <= last; u += 3 * stride) {
        { const int n2 = u + 2 * stride; jc = jf(n2); conv_load(jc, rc); conv_store(ja, ra, lds); }
        { const int n2 = u + 3 * stride; ja = jf(n2 <= last ? n2 : last); conv_load(ja, ra); conv_store(jb, rb, lds); }
        { const int n2 = u + 4 * stride; jb = jf(n2 <= last ? n2 : last); conv_load(jb, rb); conv_store(jc, rc, lds); }
    }
    if (u <= last) { conv_store(ja, ra, lds); if (u + stride <= last) conv_store(jb, rb, lds); }
}
constexpr int MOE_CONV_UNITS = NE * 192;
struct MoeJob { const Params* p; int l;
    __device__ __forceinline__ ConvJob operator()(int u) const {
        const int e = u / 192, j = u % 192; ConvJob c; c.scale = 1.f;
        if (j < 128) { const int nt16 = j >> 3, kt = j & 7, pn = nt16 >> 2, part = (nt16 >> 1) & 1, half = nt16 & 1;
            c.src = (part ? p->in[23] : p->in[22]) + ((size_t)l * NE + e) * 1024 * 512 + (size_t)(kt * 128) * 512 + pn * 128 + half * 64; c.ldn = 512;
            c.dst = (u16*)(p->ws + WS_W13) + (size_t)e * 1024 * 1024 + (size_t)(nt16 * 64) * 1024 + kt * 128; c.ldk = 1024;
        } else { const int jj = j - 128, nt16 = jj >> 2, kt = jj & 3;
            c.src = p->in[24] + ((size_t)l * NE + e) * 512 * 1024 + (size_t)(kt * 128) * 1024 + nt16 * 64; c.ldn = 1024;
            c.dst = (u16*)(p->ws + WS_W2) + (size_t)e * 1024 * 512 + (size_t)(nt16 * 64) * 512 + kt * 128; c.ldk = 512; }
        return c; }
};
struct P0Job { const Params* p;
    __device__ __forceinline__ ConvJob operator()(int u) const { ConvJob c; c.scale = 1.f; c.ldk = 1024;
        if (u < 512) {
            const int nt = u >> 3, kt = u & 7, n0 = nt * 64, grp = n0 >> 9, w = n0 & 511;
            int s0 = n0; if (grp == 4 || grp == 5) s0 = grp * 512 + (2 * (w >> 8) + ((w >> 6) & 1)) * 128 + 64 * ((w >> 7) & 1);
            c.src = p->in[8] + (size_t)(kt * 128) * 4112 + s0 + (s0 >= 2048 ? 16 : 0); c.ldn = 4112; c.dst = (u16*)(p->ws + WS_WINE) + (size_t)n0 * 1024 + kt * 128;
            c.scale = (grp == 1 || grp == 5) ? 0.08838834764831845f : 1.f;
        } else if (u < 640) { const int v = u - 512; c.src = p->in[13] + (size_t)((v & 7) * 128) * 1024 + (v >> 3) * 64; c.ldn = 1024; c.dst = (u16*)(p->ws + WS_WOUTE) + (size_t)((v >> 3) * 64) * 1024 + (v & 7) * 128;
        } else if (u < 1024) { const int v = u - 640; c.src = p->in[14] + (size_t)((v & 7) * 128) * 3072 + (v >> 3) * 64; c.ldn = 3072; c.dst = (u16*)(p->ws + WS_WINO) + (size_t)((v >> 3) * 64) * 1024 + (v & 7) * 128;
        } else { const int v = u - 1024; c.src = p->in[17] + (size_t)((v & 7) * 128) * 1024 + (v >> 3) * 64; c.ldn = 1024; c.dst = (u16*)(p->ws + WS_WOUTO) + (size_t)((v >> 3) * 64) * 1024 + (v & 7) * 128; }
        return c; }
};
constexpr int P0_CONV = 512 + 128 + 384 + 128, P0_GATEW = P0_CONV, P0_MOD = P0_GATEW + 1, P0_ROPE1 = P0_MOD + 384, P0_ROPE2 = P0_ROPE1 + 132, P0_UNITS = P0_ROPE2 + 1;
__device__ __forceinline__ void phase0(const Params& p, LAS unsigned char* lds, int bid, int nblk) {
    const int tid = threadIdx.x;
    { P0Job jf{&p}; conv_stream(bid, nblk, P0_CONV, jf, lds); }
    for (int u = P0_CONV + bid; u < P0_UNITS; u += nblk) {
        if (u == P0_GATEW) {
            float* gw = (float*)(p.ws + WS_GATEW);
            for (int i = tid; i < 16 * 1024; i += NTHR) { int k = i >> 4, j = i & 15; gw[j * 1024 + k] = p.in[8][(size_t)k * 4112 + 2048 + j]; }
        } else if (u < P0_ROPE1) {
            const int v0 = u - P0_MOD, l = v0 / 192, cb = v0 % 192;
            LAS float* sc = (LAS float*)lds;
            LAS float* part = sc + 5 * 1024;
            for (int i = tid; i < 5 * 1024; i += NTHR) { int v = i >> 10, k = i & 1023; float c = v < 4 ? p.in[1][v * 1024 + k] : p.in[3][k]; sc[i] = siluf_(c); }
            __syncthreads();
            const int col = tid & 31, kq = tid >> 5;
            const float* w = p.in[4] + (size_t)l * 1024 * 6144 + cb * 32 + col;
            float a0 = 0, a1 = 0, a2 = 0, a3 = 0, a4 = 0;
#pragma unroll 16
            for (int k = kq * 64; k < kq * 64 + 64; ++k) { float wv = w[(size_t)k * 6144]; a0 += sc[k] * wv; a1 += sc[1024 + k] * wv; a2 += sc[2048 + k] * wv; a3 += sc[3072 + k] * wv; a4 += sc[4096 + k] * wv; }
            part[(kq * 5 + 0) * 32 + col] = a0; part[(kq * 5 + 1) * 32 + col] = a1; part[(kq * 5 + 2) * 32 + col] = a2; part[(kq * 5 + 3) * 32 + col] = a3; part[(kq * 5 + 4) * 32 + col] = a4;
            __syncthreads();
            if (tid < 5 * 32) { const int v = tid >> 5, c = tid & 31; float s = 0.f;
#pragma unroll
                for (int q = 0; q < 16; ++q) s += part[(q * 5 + v) * 32 + c];
                ((float*)(p.ws + WS_MOD))[((size_t)l * 5 + v) * 6144 + cb * 32 + c] = s + p.in[5][l * 6144 + cb * 32 + c]; }
            __syncthreads();
        } else if (u < P0_ROPE2) {
            const int v0 = u - P0_ROPE1; float2* tb = (float2*)(p.ws + WS_ROPE1);
            for (int j = 0; j < 8; ++j) { int e = v0 * 4096 + j * 512 + tid; int pos = e >> 6, f = e & 63;
                float inv = powf(10000.f, -(float)f / 64.f); float ang = (float)pos * inv; tb[e] = make_float2(cosf(ang), sinf(ang)); }
        } else {
            float2* tb = (float2*)(p.ws + WS_ROPE2);
            for (int e = tid; e < 128 * 16; e += NTHR) { int pos = e >> 4, f = e & 15; float inv = powf(10000.f, -(float)f / 16.f); float ang = (float)pos * inv; tb[e] = make_float2(cosf(ang), sinf(ang)); }
        }
    }
}

__device__ __forceinline__ void load_row(const float* rp, int lane, f32x4 (&x)[4]) {
#pragma unroll
    for (int i = 0; i < 4; ++i) x[i] = *(const f32x4*)(rp + i * 256 + lane * 4);
}
__device__ __forceinline__ float row_rstd(const f32x4 (&x)[4]) {
    float ss = 0;
#pragma unroll
    for (int i = 0; i < 4; ++i) ss += x[i][0] * x[i][0] + x[i][1] * x[i][1] + x[i][2] * x[i][2] + x[i][3] * x[i][3];
    ss = wave_sum(ss);
    return rsqrtf(ss * (1.f / 1024.f) + EPS);
}
__device__ __forceinline__ void adaln_row(f32x4 (&x)[4], float rstd, const float* g, const float* shift, const float* scale, int lane) {
#pragma unroll
    for (int i = 0; i < 4; ++i) { f32x4 gv = *(const f32x4*)(g + i * 256 + lane * 4), sh = *(const f32x4*)(shift + i * 256 + lane * 4), sc = *(const f32x4*)(scale + i * 256 + lane * 4);
#pragma unroll
        for (int e = 0; e < 4; ++e) x[i][e] = x[i][e] * rstd * gv[e] * (1.f + sc[e]) + sh[e]; }
}
struct AdaC { f32x4 g[4], sh[4]; };
__device__ __forceinline__ void adac_load(AdaC& c, const float* g, const float* shift, const float* scale, int lane) {
#pragma unroll
    for (int i = 0; i < 4; ++i) { const f32x4 gv = *(const f32x4*)(g + i * 256 + lane * 4), sc = *(const f32x4*)(scale + i * 256 + lane * 4); c.sh[i] = *(const f32x4*)(shift + i * 256 + lane * 4);
#pragma unroll
        for (int e = 0; e < 4; ++e) c.g[i][e] = gv[e] * (1.f + sc[e]); }
}
__device__ __forceinline__ void adaln_apply(f32x4 (&x)[4], float rstd, const AdaC& c) {
#pragma unroll
    for (int i = 0; i < 4; ++i)
#pragma unroll
        for (int e = 0; e < 4; ++e) x[i][e] = x[i][e] * rstd * c.g[i][e] + c.sh[i][e];
}
__device__ __forceinline__ void store_row_bf16(u16* rp, int lane, const f32x4 (&x)[4]) {
#pragma unroll
    for (int i = 0; i < 4; ++i) { u32x2 w = {cvtpk(x[i][0], x[i][1]), cvtpk(x[i][2], x[i][3])}; *(u32x2*)(rp + i * 256 + lane * 4) = w; }
}
__device__ __forceinline__ const float* l0_in_row(const Params& p, int r) { return r < NCTX ? p.in[2] + (size_t)r * D : p.in[0] + (size_t)(r - NCTX) * D; }
__device__ __forceinline__ float* h_row(const Params& p, int r) { return r < NCTX ? (float*)(p.ws + WS_HCTX) + (size_t)r * D : p.out + (size_t)(r - NCTX) * D; }

__device__ __forceinline__ void phase1(const Params& p, LAS unsigned char* lds, int bid, int nblk) {
    const int tid = threadIdx.x, wid = tid >> 6, lane = tid & 63;
    LAS float* gw = (LAS float*)lds;
    { const float* src = (const float*)(p.ws + WS_GATEW); for (int i = tid; i < 16 * 1024 / 4; i += NTHR) *(LAS f32x4*)(gw + i * 4) = *(const f32x4*)(src + i * 4); }
    __syncthreads();
    const float* mod = (const float*)(p.ws + WS_MOD);
    const int gwv = bid * 8 + __builtin_amdgcn_readfirstlane(wid), nwv = nblk * 8, rs = (int)(((long)gwv * NROW) / nwv), re = (int)(((long)(gwv + 1) * NROW) / nwv);
    AdaC ac; int curmv = -1;
    f32x4 gbias;
    { const int q = lane >> 4, dir = q & 1, kind = q >> 1;
#pragma unroll
      for (int h = 0; h < 4; ++h) gbias[h] = p.in[9][dir * 8 + kind * 4 + h]; }
    f32x4 xa[4], xb[4], xc[4];
    if (rs < re) load_row(l0_in_row(p, rs), lane, xa);
    if (rs + 1 < re) load_row(l0_in_row(p, rs + 1), lane, xb);
#define P1_STEP(R, x, PF) do { const int r = (R); if (r + 2 < re) load_row(l0_in_row(p, r + 2), lane, PF); \
        const int mv = row_modvec(r); \
        if (mv != curmv) { const float* m = mod + (size_t)(0 * 5 + mv) * 6144; adac_load(ac, p.in[6], m, m + 1024, lane); curmv = mv; } \
        const float rstd = row_rstd(x); \
        adaln_apply(x, rstd, ac); \
        store_row_bf16((u16*)(p.ws + WS_X1) + (size_t)r * D, lane, x); \
        float a[16]; \
        _Pragma("unroll") for (int jg = 0; jg < 4; ++jg) { f32x4 w[16];        \
            _Pragma("unroll") for (int t = 0; t < 16; ++t) w[t] = *(const LAS f32x4*)(gw + (jg * 4 + (t >> 2)) * 1024 + (t & 3) * 256 + lane * 4); \
            SBAR(); \
            _Pragma("unroll") for (int jj = 0; jj < 4; ++jj) { float s = 0.f; \
                _Pragma("unroll") for (int i = 0; i < 4; ++i) s += x[i][0] * w[jj * 4 + i][0] + x[i][1] * w[jj * 4 + i][1] + x[i][2] * w[jj * 4 + i][2] + x[i][3] * w[jj * 4 + i][3]; \
                a[jg * 4 + jj] = s; } \
            SBAR(); } \
        float s8[8], t4[4]; \
        _Pragma("unroll") for (int j = 0; j < 8; ++j) { auto rr = __builtin_amdgcn_permlane32_swap(__float_as_uint(a[j]), __float_as_uint(a[j + 8]), false, false); s8[j] = __uint_as_float(rr[0]) + __uint_as_float(rr[1]); } \
        _Pragma("unroll") for (int j = 0; j < 4; ++j) { auto rr = __builtin_amdgcn_permlane16_swap(__float_as_uint(s8[j]), __float_as_uint(s8[j + 4]), false, false); t4[j] = row_sum16(__uint_as_float(rr[0]) + __uint_as_float(rr[1])); } \
        if ((lane & 15) == 0) { const int q = lane >> 4; f32x4 o; \
            _Pragma("unroll") for (int h = 0; h < 4; ++h) { const float z = t4[h] + gbias[h]; o[h] = (q < 2) ? z : fminf(z, 0.f) - __logf(1.f + __expf(-fabsf(z))); }        \
            *(f32x4*)((float*)(p.ws + WS_GATES) + (size_t)r * 16 + q * 4) = o; } } while (0)
    for (int r0 = rs; r0 < re; r0 += 3) {
        P1_STEP(r0, xa, xc);
        if (r0 + 1 < re) P1_STEP(r0 + 1, xb, xa);
        if (r0 + 2 < re) P1_STEP(r0 + 2, xc, xb);
    }
#undef P1_STEP
}

namespace pg {
constexpr int BM = 256, BK = 64, HALF = 128, HTB = HALF * BK * 2, NXCD = 8, WGM = 8;
__device__ __forceinline__ int lds_byte(int r, int c) { const int st = (r >> 4) * 2 + (c >> 5), rr = r & 15, cc = c & 31, ob = rr * 64 + cc * 2; return st * 1024 + (ob ^ (((ob >> 9) & 1) << 5)); }
__device__ __forceinline__ void stage_rc(int b, int& R, int& C) { const int st = b / 1024, sb = b % 1024, swz = sb ^ (((sb >> 9) & 1) << 5); R = (st >> 1) * 16 + swz / 64; C = (st & 1) * 32 + (swz % 64) / 2; }
__device__ __forceinline__ int perm32(int rho) { const int n = rho >> 4, i = rho & 15; return 8 * (i >> 2) + 4 * n + (i & 3); }
struct Unit { int pm, pn, e, nv, off; };
__device__ __forceinline__ int xcd_remap(int wgid, int nwg) { const int q = nwg / NXCD, r = nwg % NXCD, xcd = wgid % NXCD, off = wgid / NXCD; return (xcd < r ? xcd * (q + 1) : r * (q + 1) + (xcd - r) * q) + off; }

struct DenseSched {
    static constexpr bool GATHER = false;
    const char* A; const char* Bt; int pm0, nM, nN, nwg, G, c; size_t tstep;
    __device__ __forceinline__ void init(const void* A_, const void* Bt_, int K, int pm0_, int nM_, int nN_, int G_, int c_) { A = (const char*)A_; Bt = (const char*)Bt_; pm0 = pm0_; nM = nM_; nN = nN_; nwg = nM * nN; G = G_; c = c_; tstep = (size_t)BM * K * 2; }
    __device__ __forceinline__ bool next(int i, Unit& u) const {
        const long L = (long)i * G + c; if (L >= nwg) return false;
        const int wgid = xcd_remap((int)L, nwg);
        const int nig = WGM * nN, gid = wgid / nig, fm = gid * WGM, gsz = (nM - fm) < WGM ? (nM - fm) : WGM;
        u.pm = pm0 + fm + ((wgid % nig) % gsz); u.pn = (wgid % nig) / gsz; u.e = 0; u.nv = 256; u.off = 0; return true;
    }
    __device__ __forceinline__ const char* abase(const Unit& u) const { return A + (size_t)u.pm * tstep; }
    __device__ __forceinline__ const char* bbase(const Unit& u) const { return Bt + (size_t)u.pn * tstep; }
    __device__ __forceinline__ void stage_rows(const Unit&) const {}
    __device__ __forceinline__ void aoffs(unsigned (&o)[2][2], int K) const {
#pragma unroll
        for (int h = 0; h < 2; ++h)
#pragma unroll
            for (int i = 0; i < 2; ++i) { int R, C; stage_rc(threadIdx.x * 16 + i * 8192, R, C); o[h][i] = (unsigned)((h * HALF + R) * K + C) * 2u; } }
};
template <bool GATHER_> struct MoeSched {
    static constexpr bool GATHER = GATHER_;
    const char* A; const char* Bt; const LAS int* CNT; const LAS int* OFF; const LAS int* TIL; LAS int* RIDX; const int* list; int nwg, G, c, K, fallback;
    __device__ __forceinline__ bool next(int i, Unit& u) const {
        const long L = (long)i * G + c; if (L >= nwg) return false;
        const int wgid = __builtin_amdgcn_readfirstlane(xcd_remap((int)L, nwg)), tile = wgid >> 2; int e = 0;
        {   u32x4 tv[8];
#pragma unroll
            for (int j = 0; j < 8; ++j) tv[j] = *(const LAS u32x4*)(TIL + 4 * j);
#pragma unroll
            for (int j = 1; j < 32; ++j) e += ((int)tv[j >> 2][j & 3] <= tile) ? 1 : 0; }
        e = __builtin_amdgcn_readfirstlane(e);
        u.e = e; u.pm = __builtin_amdgcn_readfirstlane(tile - TIL[e]); u.pn = wgid & 3; const int left = __builtin_amdgcn_readfirstlane(CNT[e]) - u.pm * 256; u.nv = left < 256 ? left : 256;
        u.off = __builtin_amdgcn_readfirstlane(OFF[e]); return true;
    }
    __device__ __forceinline__ const char* abase(const Unit& u) const { return GATHER ? A : A + (size_t)(u.off + u.pm * 256) * K * 2; }
    __device__ __forceinline__ const char* bbase(const Unit& u) const { return Bt + ((size_t)u.e * 1024 + u.pn * 256) * K * 2; }
    __device__ __forceinline__ void stage_rows(const Unit& u) const {
        if (GATHER) { const int t = threadIdx.x; if (t < 256) RIDX[t] = t < u.nv ? list[(size_t)u.e * NROW + u.pm * 256 + t] : fallback; } }
    __device__ __forceinline__ void aoffs(unsigned (&o)[2][2], int K_) const {
#pragma unroll
        for (int h = 0; h < 2; ++h)
#pragma unroll
            for (int i = 0; i < 2; ++i) { int R, C; int tz = threadIdx.x; asm volatile("" : "+v"(tz)); stage_rc(tz * 16 + i * 8192, R, C); const int rr = h * HALF + R;
                if (GATHER) o[h][i] = (unsigned)(RIDX[rr] * K_ + C) * 2u; else o[h][i] = (unsigned)(rr * K_ + C) * 2u; } }
};

template <bool PERM, class Sched, class Epi>
__device__ __forceinline__ void gemm_phase(LAS unsigned char* lds, const int K, const Sched& S, const Epi& E) {
    const int tid = threadIdx.x, wid = __builtin_amdgcn_readfirstlane(tid >> 6), lane = tid & 63, wr = wid >> 2, wc = wid & 3, fr = lane & 15, fq = lane >> 4;
    const int nt = K / BK;
    unsigned voffB[2];
#pragma unroll
    for (int i = 0; i < 2; ++i) { int R, C; stage_rc(tid * 16 + i * 8192, R, C); const int Rb = PERM ? ((R & ~31) + perm32(R & 31)) : R; voffB[i] = (unsigned)(Rb * K + C) * 2u; }
    const size_t kstep = (size_t)(BK * 2);
    const size_t hstep = (size_t)HALF * K * 2;
    const unsigned ldsw = (unsigned)wid * 1024u;
    const int aoff = lds_byte(wr * 64 + fr, fq * 8), boff = lds_byte(wc * 32 + fr, fq * 8);
#define PG_SA(b, h) (((b) * 2 + (h)) * HTB)
#define PG_SB(b, h) ((4 + (b) * 2 + (h)) * HTB)
#define PG_STG(bufoff, gbase, o0, o1) do { __builtin_amdgcn_global_load_lds((const unsigned*)((const char*)(gbase) + (o0)), (LAS unsigned*)(lds + (bufoff) + ldsw), 16, 0, 0); \
        __builtin_amdgcn_global_load_lds((const unsigned*)((const char*)(gbase) + (o1)), (LAS unsigned*)(lds + (bufoff) + ldsw + 8192), 16, 0, 0); } while (0)
#define PG_STGB(bufoff, gbase) PG_STG(bufoff, gbase, voffB[0], voffB[1])
#define PG_LDA(dst, b, h) do { _Pragma("unroll") for (int m = 0; m < 4; ++m) _Pragma("unroll") for (int k = 0; k < 2; ++k) dst[m][k] = *(const LAS bf16x8*)(lds + PG_SA(b, h) + aoff + m * 2048 + k * 1024); } while (0)
#define PG_LDB(dst, b, h) do { _Pragma("unroll") for (int n = 0; n < 2; ++n) _Pragma("unroll") for (int k = 0; k < 2; ++k) dst[n][k] = *(const LAS bf16x8*)(lds + PG_SB(b, h) + boff + n * 2048 + k * 1024); } while (0)
#define PG_MMA(ai, bj, At, Bt) do { __builtin_amdgcn_s_setprio(1); _Pragma("unroll") for (int m = 0; m < 4; ++m) _Pragma("unroll") for (int n = 0; n < 2; ++n) _Pragma("unroll") for (int k = 0; k < 2; ++k) \
        acc[ai][bj][m][n] = __builtin_amdgcn_mfma_f32_16x16x32_bf16(Bt[n][k], At[m][k], acc[ai][bj][m][n], 0, 0, 0); __builtin_amdgcn_s_setprio(0); } while (0)
#define PG_BAR __builtin_amdgcn_s_barrier()
#define PG_SCHED __builtin_amdgcn_sched_barrier(0)
    Unit cur, nxt; int ui = 0;
    if (!S.next(0, cur)) return;
    f32x4 acc[2][2][4][2];
#pragma unroll
    for (int a = 0; a < 2; ++a)
#pragma unroll
        for (int b = 0; b < 2; ++b)
#pragma unroll
            for (int m = 0; m < 4; ++m)
#pragma unroll
                for (int n = 0; n < 2; ++n) acc[a][b][m][n] = (f32x4){0.f, 0.f, 0.f, 0.f};
    bf16x8 At[4][2], B0[2][2], B1[2][2];
    const char* cA = S.abase(cur); const char* cB = S.bbase(cur);
    unsigned oc[2][2];
    if (Sched::GATHER) { S.stage_rows(cur); __syncthreads(); }
    S.aoffs(oc, K);
    PG_STGB(PG_SB(0, 0), cB); PG_STGB(PG_SB(0, 1), cB + hstep); PG_STG(PG_SA(0, 0), cA, oc[0][0], oc[0][1]); PG_STG(PG_SA(0, 1), cA, oc[1][0], oc[1][1]);
    if (wr == 1) PG_BAR;
    WAIT_V(2); PG_BAR;
    PG_STGB(PG_SB(1, 0), cB + kstep); PG_STG(PG_SA(1, 0), cA + kstep, oc[0][0], oc[0][1]); PG_STGB(PG_SB(1, 1), cB + hstep + kstep);
    WAIT_V(6); PG_BAR;
    for (;;) {
        const bool has_next = S.next(ui + 1, nxt);
        const char* nA = cA; const char* nB = cB;
        if (has_next) { nA = S.abase(nxt); nB = S.bbase(nxt); if (Sched::GATHER) S.stage_rows(nxt); }
        for (int t = 0; t < nt; t += 2) {
            const bool last = (t == nt - 2);
            const char* a1 = cA + (size_t)(t + 1) * kstep;
            const char* a2 = last ? nA : cA + (size_t)(t + 2) * kstep; const char* b2 = last ? nB : cB + (size_t)(t + 2) * kstep;
            const char* a3 = a2 + kstep; const char* b3 = b2 + kstep;
            PG_LDB(B0, 0, 0); PG_LDB(B1, 0, 1); PG_SCHED; PG_LDA(At, 0, 0); PG_STG(PG_SA(1, 1), a1, oc[1][0], oc[1][1]);
            if (Sched::GATHER) { if (last && has_next) S.aoffs(oc, K); }
            WAIT_V(8); WAIT_L(0); PG_BAR; PG_MMA(0, 0, At, B0); PG_MMA(0, 1, At, B1); PG_BAR; PG_SCHED;
            PG_LDA(At, 0, 1); PG_STGB(PG_SB(0, 0), b2); PG_STGB(PG_SB(0, 1), b2 + hstep); PG_STG(PG_SA(0, 0), a2, oc[0][0], oc[0][1]);
            WAIT_V(8); WAIT_L(0); PG_BAR; PG_MMA(1, 0, At, B0); PG_MMA(1, 1, At, B1); PG_BAR; PG_SCHED;
            PG_LDB(B0, 1, 0); PG_LDB(B1, 1, 1); PG_SCHED; PG_LDA(At, 1, 0); PG_STG(PG_SA(0, 1), a2, oc[1][0], oc[1][1]);
            WAIT_V(8); WAIT_L(0); PG_BAR; PG_MMA(0, 0, At, B0); PG_MMA(0, 1, At, B1); PG_BAR; PG_SCHED;
            PG_LDA(At, 1, 1); PG_STGB(PG_SB(1, 0), b3); PG_STGB(PG_SB(1, 1), b3 + hstep); PG_STG(PG_SA(1, 0), a3, oc[0][0], oc[0][1]);
            WAIT_V(8); WAIT_L(0); PG_BAR; PG_MMA(1, 0, At, B0); PG_MMA(1, 1, At, B1); PG_BAR; PG_SCHED;
        }
        if (wr == 0) PG_BAR;
        E(acc, cur, wr, wc, fr, fq);
        if (!has_next) break;
#pragma unroll
        for (int a = 0; a < 2; ++a)
#pragma unroll
            for (int b = 0; b < 2; ++b)
#pragma unroll
                for (int m = 0; m < 4; ++m)
#pragma unroll
                    for (int n = 0; n < 2; ++n) acc[a][b][m][n] = (f32x4){0.f, 0.f, 0.f, 0.f};
        cur = nxt; cA = nA; cB = nB; ++ui;
        if (wr == 1) PG_BAR;
    }
    WAIT_V(0);
    PG_BAR;
#undef PG_SA
#undef PG_SB
#undef PG_STG
#undef PG_STGB
#undef PG_LDA
#undef PG_LDB
#undef PG_MMA
#undef PG_BAR
#undef PG_SCHED
}
}

__device__ __forceinline__ u32x4 pack8(const f32x4& a, const f32x4& b) { return (u32x4){cvtpk(a[0], a[1]), cvtpk(a[2], a[3]), cvtpk(b[0], b[1]), cvtpk(b[2], b[3])}; }

struct EpiIn0 { u16* O; const float2* rope;
    __device__ __forceinline__ void operator()(const f32x4 (&acc)[2][2][4][2], const pg::Unit& u, int wr_, int wc_, int fr_, int fq_) const {
        int tz = threadIdx.x; asm volatile("" : "+v"(tz)); const int wr = tz >> 8, wc = (tz >> 6) & 3, fr = tz & 15, fq = (tz >> 4) & 3;
        const int g8 = u.pn >> 1, row0 = u.pm * 256 + wr * 64 + fr, qq0 = wc * 32 + fq * 8;
        if (g8 == 4 || g8 == 5) {
            const int head = 2 * (u.pn & 1) + (qq0 >> 6), f0 = qq0 & 63;
#pragma unroll
            for (int ai = 0; ai < 2; ++ai) { f32x4 tt[4][4];
#pragma unroll
                for (int m = 0; m < 4; ++m) { const f32x4* tb = (const f32x4*)(rope + (size_t)row_pos(row0 + ai * 128 + m * 16) * 64 + f0); tt[m][0] = tb[0]; tt[m][1] = tb[1]; tt[m][2] = tb[2]; tt[m][3] = tb[3]; }
                SBAR();
#pragma unroll
                for (int m = 0; m < 4; ++m) { const int row = row0 + ai * 128 + m * 16;
                    const f32x4 t0 = tt[m][0], t1 = tt[m][1], t2 = tt[m][2], t3 = tt[m][3];
                    const f32x4 xa = acc[ai][0][m][0], xb = acc[ai][0][m][1], ya = acc[ai][1][m][0], yb = acc[ai][1][m][1];
                    f32x4 o1a = {xa[0] * t0[0] - ya[0] * t0[1], xa[1] * t0[2] - ya[1] * t0[3], xa[2] * t1[0] - ya[2] * t1[1], xa[3] * t1[2] - ya[3] * t1[3]};
                    f32x4 o1b = {xb[0] * t2[0] - yb[0] * t2[1], xb[1] * t2[2] - yb[1] * t2[3], xb[2] * t3[0] - yb[2] * t3[1], xb[3] * t3[2] - yb[3] * t3[3]};
                    f32x4 o2a = {xa[0] * t0[1] + ya[0] * t0[0], xa[1] * t0[3] + ya[1] * t0[2], xa[2] * t1[1] + ya[2] * t1[0], xa[3] * t1[3] + ya[3] * t1[2]};
                    f32x4 o2b = {xb[0] * t2[1] + yb[0] * t2[0], xb[1] * t2[3] + yb[1] * t2[2], xb[2] * t3[1] + yb[2] * t3[0], xb[3] * t3[3] + yb[3] * t3[2]};
                    u16* op = O + (size_t)row * 4096 + g8 * 512 + head * 128 + f0;
                    *(u32x4*)op = pack8(o1a, o1b); *(u32x4*)(op + 64) = pack8(o2a, o2b); }
                SBAR(); }
        } else {
#pragma unroll
            for (int ai = 0; ai < 2; ++ai)
#pragma unroll
                for (int m = 0; m < 4; ++m)
#pragma unroll
                    for (int bj = 0; bj < 2; ++bj) { f32x4 v0 = acc[ai][bj][m][0], v1 = acc[ai][bj][m][1];
                        if (g8 == 3) {
#pragma unroll
                            for (int e = 0; e < 4; ++e) { v0[e] = sigmoidf_(v0[e]); v1[e] = sigmoidf_(v1[e]); } }
                        else if (g8 == 7) {
#pragma unroll
                            for (int e = 0; e < 4; ++e) { v0[e] = siluf_(v0[e]); v1[e] = siluf_(v1[e]); } }
                        *(u32x4*)(O + (size_t)(row0 + ai * 128 + m * 16) * 4096 + u.pn * 256 + bj * 128 + qq0) = pack8(v0, v1); }
        }
    }
};
struct EpiIn1 { u16* O; const float2* rope; unsigned* kmax;
    __device__ __forceinline__ void operator()(const f32x4 (&acc)[2][2][4][2], const pg::Unit& u, int wr_, int wc_, int fr_, int fq_) const {
        int tz = threadIdx.x; asm volatile("" : "+v"(tz)); const int wr = tz >> 8, wc = (tz >> 6) & 3, fr = tz & 15, fq = (tz >> 4) & 3;
        const int row0 = u.pm * 256 + wr * 64 + fr; const bool rot = (u.pn < 8) && (u.pm >= 4);
        if (u.pn >= 4 && u.pn < 8) {
            float mx0 = 0.f, mx1 = 0.f;
#pragma unroll
            for (int ai = 0; ai < 2; ++ai)
#pragma unroll
                for (int m = 0; m < 4; ++m) {
                    float s0 = 0.f, s1 = 0.f;
#pragma unroll
                    for (int n = 0; n < 2; ++n)
#pragma unroll
                        for (int e = 0; e < 4; ++e) { s0 += acc[ai][0][m][n][e] * acc[ai][0][m][n][e]; s1 += acc[ai][1][m][n][e] * acc[ai][1][m][n][e]; }
                    s0 = swap32_add(swap16_add(s0)); s1 = swap32_add(swap16_add(s1)); mx0 = fmaxf(mx0, s0); mx1 = fmaxf(mx1, s1); }
            mx0 = row_max16(mx0); mx1 = row_max16(mx1);
            if ((tz & 63) == 0) { const int b = u.pm < 4 ? u.pm : ((u.pm - 4) >> 5), hd = 2 * (u.pn - 4);
                atomicMax(kmax + (b * 8 + hd) * 4 + wc, __float_as_uint(mx0)); atomicMax(kmax + (b * 8 + hd + 1) * 4 + wc, __float_as_uint(mx1)); }
        }
#pragma unroll
        for (int ai = 0; ai < 2; ++ai) { f32x4 tt[4][2];
#pragma unroll
            for (int m = 0; m < 4; ++m) { const int row = row0 + ai * 128 + m * 16, t = (row - NCTX) & 8191, pos = rot ? ((wc & 1) ? (t & 63) : (t >> 6)) : 0; const f32x4* tb = (const f32x4*)(rope + pos * 16 + fq * 4); tt[m][0] = tb[0]; tt[m][1] = tb[1]; }
            SBAR();
#pragma unroll
            for (int m = 0; m < 4; ++m) { const int row = row0 + ai * 128 + m * 16; u16* op = O + (size_t)row * 3072 + u.pn * 256 + wc * 32 + fq * 4;
                const f32x4 t0 = tt[m][0], t1 = tt[m][1];
#pragma unroll
                for (int bj = 0; bj < 2; ++bj) { const f32x4 x = acc[ai][bj][m][0], y = acc[ai][bj][m][1];
                    f32x4 o1 = {x[0] * t0[0] - y[0] * t0[1], x[1] * t0[2] - y[1] * t0[3], x[2] * t1[0] - y[2] * t1[1], x[3] * t1[2] - y[3] * t1[3]};
                    f32x4 o2 = {x[0] * t0[1] + y[0] * t0[0], x[1] * t0[3] + y[1] * t0[2], x[2] * t1[1] + y[2] * t1[0], x[3] * t1[3] + y[3] * t1[2]};
                    *(u32x2*)(op + bj * 128) = (u32x2){cvtpk(o1[0], o1[1]), cvtpk(o1[2], o1[3])}; *(u32x2*)(op + bj * 128 + 16) = (u32x2){cvtpk(o2[0], o2[1]), cvtpk(o2[2], o2[3])}; } }
            SBAR(); }
    }
};
template <int L> struct EpiOut { const Params* p;
    __device__ __forceinline__ void operator()(const f32x4 (&acc)[2][2][4][2], const pg::Unit& u, int wr_, int wc_, int fr_, int fq_) const {
        int tz = threadIdx.x; asm volatile("" : "+v"(tz)); const int wr = tz >> 8, wc = (tz >> 6) & 3, fr = tz & 15, fq = (tz >> 4) & 3;
        const int row0 = u.pm * 256 + wr * 64 + fr, c0 = u.pn * 256 + wc * 32 + fq * 8;
        const float* gate = (const float*)(p->ws + WS_MOD) + (size_t)(L * 5 + row_modvec(u.pm * 256)) * 6144 + 2 * 1024 + c0;
        const f32x4 g00 = *(const f32x4*)gate, g01 = *(const f32x4*)(gate + 4), g10 = *(const f32x4*)(gate + 128), g11 = *(const f32x4*)(gate + 132);
#pragma unroll
        for (int ai = 0; ai < 2; ++ai) { f32x4 hv[4][4];
#pragma unroll
            for (int m = 0; m < 4; ++m) { const int r = row0 + ai * 128 + m * 16; const float* src = (L == 0 ? l0_in_row(*p, r) : (const float*)h_row(*p, r)) + c0;
                hv[m][0] = *(const f32x4*)src; hv[m][1] = *(const f32x4*)(src + 4); hv[m][2] = *(const f32x4*)(src + 128); hv[m][3] = *(const f32x4*)(src + 132); }
            SBAR();
#pragma unroll
            for (int m = 0; m < 4; ++m) { const int r = row0 + ai * 128 + m * 16; float* dst = h_row(*p, r) + c0;
                *(f32x4*)dst = hv[m][0] + g00 * acc[ai][0][m][0]; *(f32x4*)(dst + 4) = hv[m][1] + g01 * acc[ai][0][m][1];
                *(f32x4*)(dst + 128) = hv[m][2] + g10 * acc[ai][1][m][0]; *(f32x4*)(dst + 132) = hv[m][3] + g11 * acc[ai][1][m][1]; }
            SBAR(); }
    }
};
struct EpiUp { u16* H; const LAS int* OFF;
    __device__ __forceinline__ void operator()(const f32x4 (&acc)[2][2][4][2], const pg::Unit& u, int wr_, int wc_, int fr_, int fq_) const {
        int tz = threadIdx.x; asm volatile("" : "+v"(tz)); const int wr = tz >> 8, wc = (tz >> 6) & 3, fr = tz & 15, fq = (tz >> 4) & 3;
        const int rl0 = wr * 64 + fr; u16* base = H + (size_t)(u.off + u.pm * 256) * 512 + u.pn * 128 + wc * 32 + fq * 8;
#pragma unroll
        for (int ai = 0; ai < 2; ++ai)
#pragma unroll
            for (int m = 0; m < 4; ++m) { const int rl = rl0 + ai * 128 + m * 16;
                if (rl < u.nv) { f32x4 a = acc[ai][0][m][0], b = acc[ai][0][m][1]; const f32x4 c = acc[ai][1][m][0], d = acc[ai][1][m][1];
#pragma unroll
                    for (int e = 0; e < 4; ++e) { a[e] = siluf_(a[e]) * c[e]; b[e] = siluf_(b[e]) * d[e]; }
                    *(u32x4*)(base + (size_t)rl * 512) = pack8(a, b); } }
    }
};
struct EpiDown { u16* Y; const LAS int* OFF;
    __device__ __forceinline__ void operator()(const f32x4 (&acc)[2][2][4][2], const pg::Unit& u, int wr_, int wc_, int fr_, int fq_) const {
        int tz = threadIdx.x; asm volatile("" : "+v"(tz)); const int wr = tz >> 8, wc = (tz >> 6) & 3, fr = tz & 15, fq = (tz >> 4) & 3;
        const int rl0 = wr * 64 + fr; u16* base = Y + (size_t)(u.off + u.pm * 256) * 1024 + u.pn * 256 + wc * 32 + fq * 8;
#pragma unroll
        for (int ai = 0; ai < 2; ++ai)
#pragma unroll
            for (int m = 0; m < 4; ++m) { const int rl = rl0 + ai * 128 + m * 16;
                if (rl < u.nv) {
#pragma unroll
                    for (int bj = 0; bj < 2; ++bj) *(u32x4*)(base + (size_t)rl * 1024 + bj * 128) = pack8(acc[ai][bj][m][0], acc[ai][bj][m][1]); } }
    }
};

__device__ __forceinline__ void phase2(const Params& p, LAS unsigned char* lds, int bid, int nblk) {
    pg::DenseSched S; S.init(p.ws + WS_X1, p.ws + WS_WINE, 1024, 0, 132, 16, nblk, bid);
    EpiIn0 E{(u16*)(p.ws + WS_PROJ), (const float2*)(p.ws + WS_ROPE1)};
    pg::gemm_phase<true>(lds, 1024, S, E);
}
__device__ __forceinline__ void phase_inproj1(const Params& p, LAS unsigned char* lds, int bid, int nblk) {
    pg::DenseSched S; S.init(p.ws + WS_X1, p.ws + WS_WINO, 1024, 0, 132, 12, nblk, bid);
    EpiIn1 E{(u16*)(p.ws + WS_PROJ), (const float2*)(p.ws + WS_ROPE2), (unsigned*)(p.ws + WS_CTL) + CW_KMAX};
    pg::gemm_phase<false>(lds, 1024, S, E);
}
template <int L> __device__ __forceinline__ void phase_outproj(const Params& p, LAS unsigned char* lds, int bid, int nblk) {
    pg::DenseSched S; S.init(p.ws + WS_X1, p.ws + (L == 0 ? WS_WOUTE : WS_WOUTO), 1024, L == 0 ? 0 : 4, L == 0 ? 132 : 128, 4, nblk, bid);
    EpiOut<L> E{&p};
    pg::gemm_phase<true>(lds, 1024, S, E);
    __syncthreads();
    const int ngemm = (L == 0 ? 132 : 128) * 4, extra = ngemm % nblk;
    const int nconv = nblk - extra, cid = bid - extra;
    if (cid >= 0) { MoeJob jf{&p, L}; conv_stream(cid, nconv, MOE_CONV_UNITS, jf, lds); }
}

#define KSWZ(row, colB) ((row) * 256 + ((colB) ^ (((row) & 15) << 4)))
__device__ __forceinline__ int v_st(int k, int c) { const int kk = (k & ~0xC) | ((k & 4) << 1) | ((k & 8) >> 1); return ((kk >> 3) * 4 + (c >> 5)) * 512 + ((kk & 7) * 32 + (c & 31)) * 2; }
__device__ __forceinline__ int v_rd_base(int lane) { return ((lane & 3) << 3) | (((lane >> 2) & 3) << 6) | (((lane >> 4) & 1) << 5) | (((lane >> 5) & 1) << 8); }
__device__ __forceinline__ s16x4 tr_rd(const LAS unsigned char* a) { return __builtin_bit_cast(s16x4, __builtin_amdgcn_ds_read_tr16_b64_v4i16((LAS v4i16_t*)a)); }
__device__ __forceinline__ bf16x8 tr_frag(const LAS unsigned char* a, int d0, int ks) {
    const s16x4 l = tr_rd(a + d0 * 512 + ks * 4096), h = tr_rd(a + d0 * 512 + ks * 4096 + 2048);
    return (bf16x8){l[0], l[1], l[2], l[3], h[0], h[1], h[2], h[3]};
}
#define PK4(P, BASE, OUT) do { unsigned a0 = cvtpk(P[BASE + 0], P[BASE + 1]), a1 = cvtpk(P[BASE + 2], P[BASE + 3]);   \
    unsigned b0 = cvtpk(P[BASE + 4], P[BASE + 5]), b1 = cvtpk(P[BASE + 6], P[BASE + 7]);                              \
    auto r0 = __builtin_amdgcn_permlane32_swap(a0, b0, false, false); auto r1 = __builtin_amdgcn_permlane32_swap(a1, b1, false, false); \
    u32x4 w = {r0[0], r1[0], r0[1], r1[1]}; OUT = __builtin_bit_cast(bf16x8, w); } while (0)
__device__ __forceinline__ void pv_tile(f32x16 (&o)[4], const LAS unsigned char* vb, bf16x8 pa0, bf16x8 pa1, bf16x8 pa2, bf16x8 pa3) {
#pragma unroll
    for (int d0 = 0; d0 < 4; ++d0) {
        { const bf16x8 b0 = tr_frag(vb, d0, 0), b1 = tr_frag(vb, d0, 1);
          o[d0] = __builtin_amdgcn_mfma_f32_32x32x16_bf16(pa0, b0, o[d0], 0, 0, 0);
          o[d0] = __builtin_amdgcn_mfma_f32_32x32x16_bf16(pa1, b1, o[d0], 0, 0, 0); }
        { const bf16x8 b2 = tr_frag(vb, d0, 2), b3 = tr_frag(vb, d0, 3);
          o[d0] = __builtin_amdgcn_mfma_f32_32x32x16_bf16(pa2, b2, o[d0], 0, 0, 0);
          o[d0] = __builtin_amdgcn_mfma_f32_32x32x16_bf16(pa3, b3, o[d0], 0, 0, 0); }
    }
}
template <int OFF> __device__ __forceinline__ s16x4 tr_asm(unsigned vb) { s16x4 r; asm volatile("ds_read_b64_tr_b16 %0, %1 offset:%2" : "=&v"(r) : "v"(vb), "i"(OFF) : "memory"); return r; }
template <int G> __device__ __forceinline__ void pv_rd(unsigned vb, s16x4 (&r)[4]) {
    constexpr int B = (G >> 1) * 512 + (G & 1) * 8192;
    r[0] = tr_asm<B>(vb); r[1] = tr_asm<B + 2048>(vb); r[2] = tr_asm<B + 4096>(vb); r[3] = tr_asm<B + 6144>(vb);
}
#define PV_WAIT(N, R) asm volatile("s_waitcnt lgkmcnt(" #N ")" : "+v"(R[0]), "+v"(R[1]), "+v"(R[2]), "+v"(R[3]) :: "memory")
#define PKLH(L, H) (bf16x8){L[0], L[1], L[2], L[3], H[0], H[1], H[2], H[3]}
#define PV_MMA(G, R, PA, PB) do { o[(G) >> 1] = __builtin_amdgcn_mfma_f32_32x32x16_bf16(PA, PKLH(R[0], R[1]), o[(G) >> 1], 0, 0, 0); \
                                  o[(G) >> 1] = __builtin_amdgcn_mfma_f32_32x32x16_bf16(PB, PKLH(R[2], R[3]), o[(G) >> 1], 0, 0, 0); } while (0)
__device__ __forceinline__ void pv_tile_asm(f32x16 (&o)[4], unsigned vb, bf16x8 pa0, bf16x8 pa1, bf16x8 pa2, bf16x8 pa3) {
    s16x4 rA[4], rB[4], rC[4];
    pv_rd<0>(vb, rA); pv_rd<1>(vb, rB); pv_rd<2>(vb, rC);
    PV_WAIT(8, rA); PV_MMA(0, rA, pa0, pa1); pv_rd<3>(vb, rA);
    PV_WAIT(8, rB); PV_MMA(1, rB, pa2, pa3); pv_rd<4>(vb, rB);
    PV_WAIT(8, rC); PV_MMA(2, rC, pa0, pa1); pv_rd<5>(vb, rC);
    PV_WAIT(8, rA); PV_MMA(3, rA, pa2, pa3); pv_rd<6>(vb, rA);
    PV_WAIT(8, rB); PV_MMA(4, rB, pa0, pa1); pv_rd<7>(vb, rB);
    PV_WAIT(8, rC); PV_MMA(5, rC, pa2, pa3);
    PV_WAIT(4, rA); PV_MMA(6, rA, pa0, pa1);
    PV_WAIT(0, rB); PV_MMA(7, rB, pa2, pa3);
}
#undef PV_WAIT
#undef PV_MMA
#undef PKLH
template <bool SUFFIX, bool MAXOP> __device__ __forceinline__ float wave_scan(float v, int lane) {
#pragma unroll
    for (int o = 1; o < 64; o <<= 1) { const float t = SUFFIX ? __shfl_down(v, o, 64) : __shfl_up(v, o, 64); const bool in = SUFFIX ? (lane + o < 64) : (lane >= o);
        v = in ? (MAXOP ? fmaxf(v, t) : v + t) : v; }
    return v;
}
template <bool SUFFIX, bool MAXOP> __device__ __forceinline__ float scan128(const LAS float* a, int t) {
    float acc = MAXOP ? -3.0e38f : 0.f;
#pragma unroll 4
    for (int r4 = 0; r4 < 32; ++r4) { const f32x4 v = *(const LAS f32x4*)(a + r4 * 4);
#pragma unroll
        for (int e = 0; e < 4; ++e) { const int r = r4 * 4 + e; const bool in = SUFFIX ? (r >= t) : (r <= t); if (MAXOP) acc = in ? fmaxf(acc, v[e]) : acc; else acc += in ? v[e] : 0.f; } }
    return acc;
}
__device__ __forceinline__ void ld_rows16(const LAS float* A, int hi, float (&v)[16]) {
    f32x4 t[4];
#pragma unroll
    for (int g = 0; g < 4; ++g) t[g] = *(const LAS f32x4*)(A + 8 * g + 4 * hi);
#pragma unroll
    for (int g = 0; g < 4; ++g) { v[4 * g] = t[g][0]; v[4 * g + 1] = t[g][1]; v[4 * g + 2] = t[g][2]; v[4 * g + 3] = t[g][3]; }
}
constexpr int SC_ARR = 131072;

__device__ __forceinline__ void s1_unit(const Params& p, LAS unsigned char* lds, int u) {
    const int tid = threadIdx.x, wid = tid >> 6, lane = tid & 63, r32 = lane & 31, hi = lane >> 5;
    const int ch = u % NCH, t1 = u / NCH, h = t1 & 3, b = (t1 >> 2) & 3, mx = t1 >> 4;
    const int row0 = chunk_row0(b, ch);
    LAS unsigned char* KIMG = lds; LAS unsigned char* VF = lds + 32768; LAS unsigned char* VB = lds + 65536;
    LAS float* arr = (LAS float*)(lds + SC_ARR);
    LAS float *IF = arr, *IB = arr + 128, *FF = arr + 256, *FB = arr + 384, *WF = arr + 512, *WB = arr + 640, *SCL = arr + 768, *RED = arr + 1024;
    const u16* proj = (const u16*)(p.ws + WS_PROJ);
    const int kcol = (mx ? 2560 : 512) + h * 128, vcol = (mx ? 3072 : 1024) + h * 128;
    if (mx == 0) {
        float g_if = 0.f, g_ib = 0.f, bfw = 0.f, bbw = 0.f;
        if (tid < 128) { const float* g = (const float*)(p.ws + WS_GATES) + (size_t)(row0 + tid) * 16; g_if = g[h]; g_ib = g[4 + h];
            bfw = wave_scan<false, false>(g[8 + h], lane); bbw = wave_scan<true, false>(g[12 + h], lane);
            if (lane == 63) SCL[4 + wid] = bfw; if (lane == 0) SCL[6 + wid] = bbw; }
        __syncthreads();
        float wlf = 0.f, wlb = 0.f;
        if (tid < 128) { const float Bf = SCL[4] + SCL[5], Bb = SCL[6] + SCL[7];
            const float bf = bfw + (wid == 1 ? SCL[4] : 0.f), bb = bbw + (wid == 0 ? SCL[7] : 0.f);
            wlf = Bf - bf + g_if; wlb = Bb - bb + g_ib;
            const float mf = wave_max(wlf), mb = wave_max(wlb);
            if (lane == 0) { SCL[8 + wid] = mf; SCL[10 + wid] = mb; }
            if (tid == 0) { SCL[0] = Bf; SCL[1] = Bb; } }
        __syncthreads();
        const float af = fmaxf(SCL[8], SCL[9]), ab = fmaxf(SCL[10], SCL[11]);
        if (tid == 0) { float* st = (float*)(p.ws + WS_STATS); const int c0 = (b * 4 + h) * 2;
            st[((size_t)(c0 + 0) * NCH + ch) * 2 + 0] = SCL[0]; st[((size_t)(c0 + 0) * NCH + ch) * 2 + 1] = af;
            st[((size_t)(c0 + 1) * NCH + ch) * 2 + 0] = SCL[1]; st[((size_t)(c0 + 1) * NCH + ch) * 2 + 1] = ab; }
        if (tid < 128) { WF[tid] = __expf(wlf - af); WB[tid] = __expf(wlb - ab); }
    } else {
        const float lgf = p.in[11][h], lgb = p.in[11][4 + h];
        if (tid < 128) { WF[tid] = __expf(lgf * (float)(127 - tid)); WB[tid] = __expf(lgb * (float)tid); }
    }
    __syncthreads();
#pragma unroll
    for (int i = 0; i < 4; ++i) { const int pi = tid + i * NTHR, s = pi >> 4, c8 = (pi & 15) * 8;
        const u16* rp = proj + (size_t)(row0 + s) * 4096;
        const u32x4 kv = *(const u32x4*)(rp + kcol + c8), vv = *(const u32x4*)(rp + vcol + c8);
        const int off = (s >> 6) * 16384 + v_st(s & 63, c8);
        *(LAS u32x4*)(KIMG + off) = kv;
        const float wf = WF[s], wb = WB[s]; u32x4 of, ob;
#pragma unroll
        for (int e = 0; e < 4; ++e) { float lo = bflo(vv[e]), hh = bfhi(vv[e]); of[e] = cvtpk(lo * wf, hh * wf); ob[e] = cvtpk(lo * wb, hh * wb); }
        *(LAS u32x4*)(VF + off) = of; *(LAS u32x4*)(VB + off) = ob; }
    __syncthreads();
    {   const int dir = wid >> 2, kblk = wid & 3; const int vrb = v_rd_base(lane);
        const LAS unsigned char* ka = KIMG + vrb; const LAS unsigned char* va = (dir ? VB : VF) + vrb;
        f32x16 acc[4] = {};
#pragma unroll
        for (int ks16 = 0; ks16 < 8; ++ks16) { const int tile = ks16 >> 2, ks = ks16 & 3;
            const bf16x8 a = tr_frag(ka + tile * 16384, kblk, ks);
#pragma unroll
            for (int d0 = 0; d0 < 4; ++d0) { const bf16x8 bb = tr_frag(va + tile * 16384, d0, ks); acc[d0] = __builtin_amdgcn_mfma_f32_32x32x16_bf16(a, bb, acc[d0], 0, 0, 0); } }
        const int chain = ((mx * 4 + b) * 4 + h) * 2 + dir;
        u16* base = (u16*)(p.ws + WS_STATES) + ((size_t)chain * NCH + ch) * 16384;
#pragma unroll
        for (int d0 = 0; d0 < 4; ++d0)
#pragma unroll
            for (int g = 0; g < 4; ++g) { u32x2 w = {cvtpk(acc[d0][4 * g], acc[d0][4 * g + 1]), cvtpk(acc[d0][4 * g + 2], acc[d0][4 * g + 3])};
                *(u32x2*)(base + (d0 * 32 + r32) * 128 + kblk * 32 + 8 * g + 4 * hi) = w; }
    }
    if (mx == 0) {
        const int dir = tid >> 8, k = tid & 127, half = (tid >> 7) & 1; LAS float* W = dir ? WB : WF; float s = 0;
#pragma unroll
        for (int i0 = 0; i0 < 64; i0 += 16) { u16 kv[16]; f32x4 wv[4];
#pragma unroll
            for (int i = 0; i < 16; ++i) kv[i] = *(const LAS u16*)(KIMG + half * 16384 + v_st(i0 + i, k));
#pragma unroll
            for (int i = 0; i < 4; ++i) wv[i] = *(const LAS f32x4*)(W + half * 64 + i0 + 4 * i);
            SBAR();
#pragma unroll
            for (int i = 0; i < 16; ++i) s += wv[i >> 2][i & 3] * bf2f(kv[i]);
            SBAR(); }
        RED[(dir * 2 + half) * 128 + k] = s;
        __syncthreads();
        if (half == 0) { const int chain = (b * 4 + h) * 2 + dir; ((float*)(p.ws + WS_NV))[((size_t)chain * NCH + ch) * 128 + k] = RED[(dir * 2) * 128 + k] + RED[(dir * 2 + 1) * 128 + k]; }
    }
    __syncthreads();
}

__device__ __forceinline__ int chain_chunk(int dir, int i) { return dir == 0 ? i : (i < 2 ? 1 - i : 67 - i); }

__device__ __forceinline__ void phase_s2(const Params& p, int bid, int nblk) {
    const float* st = (const float*)(p.ws + WS_STATS);
    for (int gid = bid * NTHR + threadIdx.x; gid < 64 * 2048; gid += nblk * NTHR) {
        const int chain = gid >> 11, v = (gid >> 4) & 127, kc = gid & 15, dir = chain & 1, mx = chain >> 5, h = (chain >> 1) & 3;
        u16* base = (u16*)(p.ws + WS_STATES) + (size_t)chain * NCH * 16384 + v * 128 + kc * 8;
        float c[8] = {0, 0, 0, 0, 0, 0, 0, 0}; float nvc[8] = {0, 0, 0, 0, 0, 0, 0, 0};
        float m = 0.f; const float rdec = mx ? __expf(128.f * p.in[11][dir * 4 + h]) : 1.f;
        const bool do_n = (mx == 0 && v == 0);
        for (int i0 = 0; i0 < NCH; i0 += 6) {
            u32x4 dd[6]; float Bv[6], av[6];
#pragma unroll
            for (int k = 0; k < 6; ++k) { const int ch = chain_chunk(dir, i0 + k); dd[k] = *(const u32x4*)(base + (size_t)ch * 16384);
                if (mx == 0) { Bv[k] = st[((size_t)chain * NCH + ch) * 2]; av[k] = st[((size_t)chain * NCH + ch) * 2 + 1]; } else { Bv[k] = 0.f; av[k] = 0.f; } }
#pragma unroll
            for (int k = 0; k < 6; ++k) {
                const int ch = chain_chunk(dir, i0 + k);
                float dec, sc;
                if (mx == 0) { const float mn = fmaxf(Bv[k] + m, av[k]); dec = __expf(Bv[k] + m - mn); sc = __expf(av[k] - mn);
                    if (v == 0 && kc == 0) ((float*)(p.ws + WS_MST))[(size_t)chain * NCH + ch] = m;
                    m = mn;
                } else { dec = rdec; sc = 1.f; }
                const u32x4 d = dd[k];
                *(u32x4*)(base + (size_t)ch * 16384) = (u32x4){cvtpk(c[0], c[1]), cvtpk(c[2], c[3]), cvtpk(c[4], c[5]), cvtpk(c[6], c[7])};
#pragma unroll
                for (int e = 0; e < 4; ++e) { c[2 * e] = dec * c[2 * e] + sc * bflo(d[e]); c[2 * e + 1] = dec * c[2 * e + 1] + sc * bfhi(d[e]); }
                if (do_n) { float* nq = (float*)(p.ws + WS_NV) + ((size_t)chain * NCH + ch) * 128 + kc * 8;
#pragma unroll
                    for (int e = 0; e < 8; ++e) { float dn = nq[e]; nq[e] = nvc[e]; nvc[e] = dec * nvc[e] + sc * dn; } }
            }
        }
    }
}

template <int NQ>
__device__ __forceinline__ void qkt_init(f32x16& p0, f32x16& p1, const LAS unsigned char* Ks, const bf16x8* qr, int r32, int hi, int colB0, const f32x16& ini) {
    {   const int cb = colB0 + (hi * 8) * 2;
        const bf16x8 b0 = *(const LAS bf16x8*)(Ks + KSWZ(r32, cb)), b1 = *(const LAS bf16x8*)(Ks + KSWZ(32 + r32, cb));
        p0 = __builtin_amdgcn_mfma_f32_32x32x16_bf16(b0, qr[0], ini, 0, 0, 0);
        p1 = __builtin_amdgcn_mfma_f32_32x32x16_bf16(b1, qr[0], ini, 0, 0, 0); }
#pragma unroll
    for (int d0 = 1; d0 < NQ; ++d0) { const int cb = colB0 + (d0 * 16 + hi * 8) * 2;
        const bf16x8 b0 = *(const LAS bf16x8*)(Ks + KSWZ(r32, cb)), b1 = *(const LAS bf16x8*)(Ks + KSWZ(32 + r32, cb));
        p0 = __builtin_amdgcn_mfma_f32_32x32x16_bf16(b0, qr[d0], p0, 0, 0, 0);
        p1 = __builtin_amdgcn_mfma_f32_32x32x16_bf16(b1, qr[d0], p1, 0, 0, 0); }
}
template <int NQ>
__device__ __forceinline__ void qkt_pre(f32x16& p0, f32x16& p1, const LAS unsigned char* Ks, const bf16x8* qr, int r32, int hi, int colB0, const f32x16& ini, bf16x8 k0, bf16x8 k1) {
    p0 = __builtin_amdgcn_mfma_f32_32x32x16_bf16(k0, qr[0], ini, 0, 0, 0);
    p1 = __builtin_amdgcn_mfma_f32_32x32x16_bf16(k1, qr[0], ini, 0, 0, 0);
#pragma unroll
    for (int d0 = 1; d0 < NQ; ++d0) { const int cb = colB0 + (d0 * 16 + hi * 8) * 2;
        const bf16x8 b0 = *(const LAS bf16x8*)(Ks + KSWZ(r32, cb)), b1 = *(const LAS bf16x8*)(Ks + KSWZ(32 + r32, cb));
        p0 = __builtin_amdgcn_mfma_f32_32x32x16_bf16(b0, qr[d0], p0, 0, 0, 0);
        p1 = __builtin_amdgcn_mfma_f32_32x32x16_bf16(b1, qr[d0], p1, 0, 0, 0); }
}
template <int NQ>
__device__ __forceinline__ void qkt(f32x16& p0, f32x16& p1, const LAS unsigned char* Ks, const bf16x8* qr, int r32, int hi, int colB0) {
    p0 = f32x16{}; p1 = f32x16{};
#pragma unroll
    for (int d0 = 0; d0 < NQ; ++d0) { const int cb = colB0 + (d0 * 16 + hi * 8) * 2;
        const bf16x8 b0 = *(const LAS bf16x8*)(Ks + KSWZ(r32, cb)), b1 = *(const LAS bf16x8*)(Ks + KSWZ(32 + r32, cb));
        p0 = __builtin_amdgcn_mfma_f32_32x32x16_bf16(b0, qr[d0], p0, 0, 0, 0);
        p1 = __builtin_amdgcn_mfma_f32_32x32x16_bf16(b1, qr[d0], p1, 0, 0, 0); }
}

__device__ __forceinline__ void s3_unit(const Params& p, LAS unsigned char* lds, int u) {
    const int tid = threadIdx.x, wid = tid >> 6, lane = tid & 63, r32 = lane & 31, hi = lane >> 5;
    const int ch = u % NCH, t1 = u / NCH, h = t1 & 3, b = (t1 >> 2) & 3, mx = t1 >> 4;
    const int row0 = chunk_row0(b, ch);
    LAS unsigned char* KT = lds; LAS unsigned char* VI = lds + 32768; LAS unsigned char* CT = lds + 65536;
    LAS float* arr = (LAS float*)(lds + SC_ARR);
    LAS float *U = arr, *MXA = arr + 256, *WI = arr + 512, *FL = arr + 768, *NVL = arr + 1024, *HS = arr + 1280  , *TMP = arr + 1536  ;
    const u16* proj = (const u16*)(p.ws + WS_PROJ);
    const int qcol = (mx ? 2048 : 0) + h * 128, kcol = qcol + 512, vcol = qcol + 1024, gcol = qcol + 1536;
    const int chain0 = ((mx * 4 + b) * 4 + h) * 2;
    if (mx == 0) {
        float g_if = 0.f, g_ib = 0.f, bfw = 0.f, bbw = 0.f, bf = 0.f, bb = 0.f, pfw = 0.f, pbw = 0.f;
        if (tid < 128) { const float* g = (const float*)(p.ws + WS_GATES) + (size_t)(row0 + tid) * 16; g_if = g[h]; g_ib = g[4 + h];
            bfw = wave_scan<false, false>(g[8 + h], lane); bbw = wave_scan<true, false>(g[12 + h], lane);
            if (lane == 63) TMP[wid] = bfw; if (lane == 0) TMP[2 + wid] = bbw; }
        if (tid >= 256) { const int d = (tid >> 7) & 1, k = tid & 127; NVL[d * 128 + k] = ((const float*)(p.ws + WS_NV))[((size_t)(chain0 - 0 + d) * NCH + ch) * 128 + k]; }
        __syncthreads();
        if (tid < 128) { bf = bfw + (wid == 1 ? TMP[0] : 0.f); bb = bbw + (wid == 0 ? TMP[3] : 0.f);
            const float uf = g_if - bf, ub = g_ib - bb; U[tid] = uf; U[128 + tid] = ub;
            pfw = wave_scan<false, true>(uf, lane); pbw = wave_scan<true, true>(ub, lane);
            if (lane == 63) TMP[4 + wid] = pfw; if (lane == 0) TMP[6 + wid] = pbw; }
        __syncthreads();
        if (tid < 128) { const float pf = (wid == 1) ? fmaxf(pfw, TMP[4]) : pfw, pb = (wid == 0) ? fmaxf(pbw, TMP[7]) : pbw;
            const float mf = ((const float*)(p.ws + WS_MST))[(size_t)chain0 * NCH + ch], mb = ((const float*)(p.ws + WS_MST))[(size_t)(chain0 + 1) * NCH + ch];
            const float Mf = fmaxf(mf, pf), Mb = fmaxf(mb, pb);
            MXA[tid] = Mf; MXA[128 + tid] = Mb; WI[tid] = __expf(mf - Mf); WI[128 + tid] = __expf(mb - Mb);
            FL[tid] = __expf(-(bf + Mf)); FL[128 + tid] = __expf(-(bb + Mb)); }
    } else {
        const float lgf = p.in[11][h], lgb = p.in[11][4 + h];
        if (tid < 128) { const float t = (float)tid; U[tid] = -lgf * t; MXA[tid] = -lgf * t; WI[tid] = __expf(lgf * (t + 1.f));
            U[128 + tid] = lgb * t; MXA[128 + tid] = lgb * t; WI[128 + tid] = __expf(lgb * (128.f - t)); FL[tid] = 0.f; FL[128 + tid] = 0.f; }
        if (tid >= 256) NVL[tid - 256] = 0.f;
    }
    const u16* cf = (const u16*)(p.ws + WS_STATES) + ((size_t)chain0 * NCH + ch) * 16384;
    const u16* cbp = (const u16*)(p.ws + WS_STATES) + ((size_t)(chain0 + 1) * NCH + ch) * 16384;
#pragma unroll
    for (int i = 0; i < 4; ++i) { const int pi = tid + i * NTHR, s = pi >> 4, c8 = (pi & 15) * 8;
        const u16* rp = proj + (size_t)(row0 + s) * 4096;
        *(LAS u32x4*)(KT + KSWZ(s, c8 * 2)) = *(const u32x4*)(rp + kcol + c8);
        *(LAS u32x4*)(VI + (s >> 6) * 16384 + v_st(s & 63, c8)) = *(const u32x4*)(rp + vcol + c8);
        *(LAS u32x4*)(CT + KSWZ(s, c8 * 2)) = *(const u32x4*)(cf + s * 128 + c8);
        *(LAS u32x4*)(CT + 32768 + KSWZ(s, c8 * 2)) = *(const u32x4*)(cbp + s * 128 + c8); }
    const int dir = wid >> 2, tb = wid & 3, t = tb * 32 + r32;
    bf16x8 qr[8];
    { const u16* qp = proj + (size_t)(row0 + t) * 4096 + qcol + hi * 8;
#pragma unroll
      for (int d0 = 0; d0 < 8; ++d0) qr[d0] = *(const bf16x8*)(qp + d0 * 16); }
    __syncthreads();
    f32x16 o[4] = {};
    {
        const LAS unsigned char* C = CT + dir * 32768;
#pragma unroll
        for (int dv = 0; dv < 4; ++dv)
#pragma unroll
            for (int d0 = 0; d0 < 8; ++d0) { const bf16x8 bb = *(const LAS bf16x8*)(C + KSWZ(dv * 32 + r32, (d0 * 16 + hi * 8) * 2)); o[dv] = __builtin_amdgcn_mfma_f32_32x32x16_bf16(qr[d0], bb, o[dv], 0, 0, 0); }
        float wv[16]; ld_rows16(WI + dir * 128 + tb * 32, hi, wv);
#pragma unroll
        for (int r = 0; r < 16; ++r) {
#pragma unroll
            for (int dv = 0; dv < 4; ++dv) o[dv][r] *= wv[r]; }
    }
    float qn = 0.f;
#pragma unroll
    for (int d0 = 0; d0 < 8; ++d0) { const f32x4 n0 = *(const LAS f32x4*)(NVL + dir * 128 + d0 * 16 + hi * 8), n1 = *(const LAS f32x4*)(NVL + dir * 128 + d0 * 16 + hi * 8 + 4);
#pragma unroll
        for (int j = 0; j < 4; ++j) qn += bf2f((u16)qr[d0][j]) * n0[j] + bf2f((u16)qr[d0][4 + j]) * n1[j]; }
    qn = swap_add(qn);
    float rs = 0.f; const float Mt = MXA[dir * 128 + t];
    const int vrb = v_rd_base(lane);
#pragma unroll 1
    for (int kt = 0; kt < 2; ++kt) {
        f32x16 p0, p1; qkt<8>(p0, p1, KT + kt * 64 * 256, qr, r32, hi, 0);
        float u0[16], u1[16]; ld_rows16(U + dir * 128 + kt * 64, hi, u0); ld_rows16(U + dir * 128 + kt * 64 + 32, hi, u1);
#pragma unroll
        for (int r = 0; r < 16; ++r) { const int s0 = kt * 64 + crow(r, hi), s1 = s0 + 32;
            const bool v0 = dir ? (s0 >= t) : (s0 <= t), v1 = dir ? (s1 >= t) : (s1 <= t);
            const float f0 = v0 ? __builtin_amdgcn_exp2f((u0[r] - Mt) * LOG2E) : 0.f, f1 = v1 ? __builtin_amdgcn_exp2f((u1[r] - Mt) * LOG2E) : 0.f;
            p0[r] *= f0; p1[r] *= f1; rs += p0[r] + p1[r]; }
        bf16x8 pa0, pa1, pa2, pa3; PK4(p0, 0, pa0); PK4(p0, 8, pa1); PK4(p1, 0, pa2); PK4(p1, 8, pa3);
        pv_tile(o, VI + kt * 16384 + vrb, pa0, pa1, pa2, pa3);
    }
    rs = swap_add(rs);
    if (mx == 0) { const float den = rs + WI[dir * 128 + t] * qn; const float hs = 1.f / fmaxf(fabsf(den), FL[dir * 128 + t]);
        if (hi == 0) HS[wid * 32 + r32] = hs;
        WAIT_L(0);
        float sv[16]; ld_rows16(HS + wid * 32, hi, sv);
#pragma unroll
        for (int r = 0; r < 16; ++r) {
#pragma unroll
            for (int dv = 0; dv < 4; ++dv) o[dv][r] *= sv[r]; } }
    __syncthreads();
    LAS float* T = (LAS float*)lds;
    if (dir == 1) {
#pragma unroll
        for (int dv = 0; dv < 4; ++dv)
#pragma unroll
            for (int r = 0; r < 16; ++r) T[(tb * 32 + crow(r, hi)) * 132 + dv * 32 + r32] = o[dv][r]; }
    __syncthreads();
    if (dir == 0) {
#pragma unroll
        for (int dv = 0; dv < 4; ++dv) { float tv[16];
#pragma unroll
            for (int r = 0; r < 16; ++r) tv[r] = T[(tb * 32 + crow(r, hi)) * 132 + dv * 32 + r32];
            SBAR();
#pragma unroll
            for (int r = 0; r < 16; ++r) T[(tb * 32 + crow(r, hi)) * 132 + dv * 32 + r32] = tv[r] + o[dv][r];
            SBAR(); } }
    __syncthreads();
    {
        const int tt = tid >> 2, sg = tid & 3, row = row0 + tt;
        const float* G = (mx ? p.in[12] : p.in[10]) + h * 128 + sg * 32;
        const u16* gp = proj + (size_t)row * 4096 + gcol + sg * 32;
        u32x4 gw[4];
#pragma unroll
        for (int i = 0; i < 4; ++i) gw[i] = *(const u32x4*)(gp + i * 8);
        float x[32], s1 = 0.f, s2 = 0.f;
#pragma unroll
        for (int i = 0; i < 8; ++i) { const f32x4 v = *(const LAS f32x4*)(T + tt * 132 + sg * 32 + i * 4); x[4 * i] = v[0]; x[4 * i + 1] = v[1]; x[4 * i + 2] = v[2]; x[4 * i + 3] = v[3]; }
        float gt[32];
#pragma unroll
        for (int i = 0; i < 4; ++i)
#pragma unroll
            for (int e = 0; e < 4; ++e) { gt[i * 8 + 2 * e] = bflo(gw[i][e]); gt[i * 8 + 2 * e + 1] = bfhi(gw[i][e]); }
#pragma unroll
        for (int i = 0; i < 32; ++i) { if (mx == 0) x[i] *= gt[i]; s1 += x[i]; s2 += x[i] * x[i]; }
        s1 += dpp_f<0xB1>(s1); s1 += dpp_f<0x4E>(s1); s2 += dpp_f<0xB1>(s2); s2 += dpp_f<0x4E>(s2);
        const float mu = s1 * (1.f / 128.f), var = fmaxf(s2 * (1.f / 128.f) - mu * mu, 0.f), rstd = rsqrtf(var + EPS);
        u16* op = (u16*)(p.ws + WS_X1) + (size_t)row * 1024 + mx * 512 + h * 128 + sg * 32;
#pragma unroll
        for (int i = 0; i < 4; ++i) { const f32x4 g0 = *(const f32x4*)(G + i * 8), g1 = *(const f32x4*)(G + i * 8 + 4); float y[8];
#pragma unroll
            for (int e = 0; e < 8; ++e) { y[e] = (x[i * 8 + e] - mu) * rstd * (e < 4 ? g0[e] : g1[e - 4]); if (mx) y[e] *= gt[i * 8 + e]; }
            *(u32x4*)(op + i * 8) = (u32x4){cvtpk(y[0], y[1]), cvtpk(y[2], y[3]), cvtpk(y[4], y[5]), cvtpk(y[6], y[7])}; }
    }
    __syncthreads();
}

constexpr int R_WT = 0;
constexpr int R_PITCH = 1028;
constexpr int MOE_ARR = 148480;
__device__ __forceinline__ void reduce36(float (&a)[36], float (&t)[9]) {
    float s[18];
#pragma unroll
    for (int j = 0; j < 18; ++j) { auto rr = __builtin_amdgcn_permlane32_swap(__float_as_uint(a[j]), __float_as_uint(a[j + 18]), false, false); s[j] = __uint_as_float(rr[0]) + __uint_as_float(rr[1]); }
#pragma unroll
    for (int j = 0; j < 9; ++j) { auto rr = __builtin_amdgcn_permlane16_swap(__float_as_uint(s[j]), __float_as_uint(s[j + 9]), false, false); t[j] = row_sum16(__uint_as_float(rr[0]) + __uint_as_float(rr[1])); }
}
template <int L>
__device__ __forceinline__ void route_row(const Params& p, const LAS float* lg, int r, int slot, LAS int* LCNT, LAS int* SLOT, int lane) {
    const f32x4 gq = *(const LAS f32x4*)lg;
    const float g0 = gq[0], g1 = gq[1], g2 = gq[2], g3 = gq[3];
    int grp = 0; float gm = g0; if (g1 > gm) { gm = g1; grp = 1; } if (g2 > gm) { gm = g2; grp = 2; } if (g3 > gm) { gm = g3; grp = 3; }
    const float pg = 1.f / (__expf(g0 - gm) + __expf(g1 - gm) + __expf(g2 - gm) + __expf(g3 - gm));
    int i0 = 0, i1 = -1; float m0 = -3.0e38f, m1 = -3.0e38f;
    const f32x4 ea4 = *(const LAS f32x4*)(lg + 4 + grp * 8), eb4 = *(const LAS f32x4*)(lg + 8 + grp * 8);
#pragma unroll
    for (int j = 0; j < 8; ++j) { const float v = j < 4 ? ea4[j & 3] : eb4[j & 3];
        if (v > m0) { m1 = m0; i1 = i0; m0 = v; i0 = j; } else if (v > m1) { m1 = v; i1 = j; } }
    const float e1 = __expf(m1 - m0), den = 1.f / (1.f + e1);
    const float w0 = pg * den, w1 = pg * e1 * den;
    if (lane == 0) { const int ea = grp * 8 + i0, eb = grp * 8 + i1;
        const int la = (int)__hip_atomic_fetch_add((LAS unsigned*)&LCNT[ea], 1u, __ATOMIC_RELAXED, __HIP_MEMORY_SCOPE_WORKGROUP), lb = (int)__hip_atomic_fetch_add((LAS unsigned*)&LCNT[eb], 1u, __ATOMIC_RELAXED, __HIP_MEMORY_SCOPE_WORKGROUP);
        LAS int* sl = SLOT + slot * 4; sl[0] = ea; sl[1] = eb; sl[2] = la; sl[3] = lb;
        int* asge = (int*)(p.ws + WS_ASGE); float* asgg = (float*)(p.ws + WS_ASGG);
        asge[2 * r] = ea; asge[2 * r + 1] = eb; asgg[2 * r] = w0; asgg[2 * r + 1] = w1; }
}
template <int L>
__device__ __forceinline__ void phase_router(const Params& p, LAS unsigned char* lds, int bid, int nblk) {
    const int tid = threadIdx.x, wid = tid >> 6, lane = tid & 63;
    LAS float* wt = (LAS float*)(lds + R_WT);
    for (int i = tid; i < 4 * 1024; i += NTHR) { const int k = i >> 2, j = i & 3; wt[j * R_PITCH + k] = p.in[18][(size_t)L * 4096 + i]; }
    for (int i = tid; i < 32 * 1024; i += NTHR) { const int k = i >> 5, j = i & 31; wt[(4 + j) * R_PITCH + k] = p.in[20][(size_t)L * 32768 + i]; }
    const float* mod = (const float*)(p.ws + WS_MOD);
    unsigned* cnt = (unsigned*)(p.ws + WS_CTL) + CW_CNT + L * 64;
    int* asgr = (int*)(p.ws + WS_ASGR); int* list = (int*)(p.ws + WS_LIST);
    LAS int* LCNT = (LAS int*)(lds + MOE_ARR); LAS int* LBASE = LCNT + 32; LAS int* SLOT = LCNT + 64;
    LAS float* LG = (LAS float*)(lds + MOE_ARR + 4096) + wid * 80;
    if (tid < 32) LCNT[tid] = 0;
    __syncthreads();
    const int base = (L == 0 ? 0 : NCTX), nr = NROW - base, gwv = bid * 8 + __builtin_amdgcn_readfirstlane(wid), nwv = nblk * 8;
    const int rs = base + (int)(((long)gwv * nr) / nwv), re = base + (int)(((long)(gwv + 1) * nr) / nwv);
    const int qperm = ((lane >> 4) == 1) ? 2 : ((lane >> 4) == 2) ? 1 : (lane >> 4);
    LAS float* BQ = (LAS float*)(lds + MOE_ARR + 4096) + 8 * 80;
    if (tid < 36) BQ[tid] = tid < 4 ? p.in[19][L * 4 + tid] : p.in[21][L * 32 + tid - 4];
    __syncthreads();
    AdaC ac; int curmv = -1;
    f32x4 xa[4], xb[4];
    load_row(h_row(p, rs), lane, xa); load_row(h_row(p, rs + 1 < re ? rs + 1 : rs), lane, xb);
#define R_FMA4(acc, x, w, o) acc += x[0][0] * w[o][0] + x[0][1] * w[o][1] + x[0][2] * w[o][2] + x[0][3] * w[o][3] + x[1][0] * w[o + 1][0] + x[1][1] * w[o + 1][1] + x[1][2] * w[o + 1][2] + x[1][3] * w[o + 1][3] \
        + x[2][0] * w[o + 2][0] + x[2][1] * w[o + 2][1] + x[2][2] * w[o + 2][2] + x[2][3] * w[o + 2][3] + x[3][0] * w[o + 3][0] + x[3][1] * w[o + 3][1] + x[3][2] * w[o + 3][2] + x[3][3] * w[o + 3][3]
#define R_RED4(a0, a1, a2, a3, DST) do { \
        auto r01 = __builtin_amdgcn_permlane32_swap(__float_as_uint(a0), __float_as_uint(a1), false, false); const float s01 = __uint_as_float(r01[0]) + __uint_as_float(r01[1]); \
        auto r23 = __builtin_amdgcn_permlane32_swap(__float_as_uint(a2), __float_as_uint(a3), false, false); const float s23 = __uint_as_float(r23[0]) + __uint_as_float(r23[1]); \
        auto rq = __builtin_amdgcn_permlane16_swap(__float_as_uint(s01), __float_as_uint(s23), false, false); const float tg = row_sum16(__uint_as_float(rq[0]) + __uint_as_float(rq[1])); \
        if ((lane & 15) == 0) (DST)[4 * g + qperm] = tg + BQ[4 * g + qperm]; } while (0)
#define R_STEP2(R, x, y) do { const int r = (R); const bool hasB = (r + 1) < re; const int rb = hasB ? r + 1 : r; \
        { const int mv = row_modvec(r); if (mv != curmv) { const float* m = mod + (size_t)(L * 5 + mv) * 6144; adac_load(ac, p.in[7] + L * 1024, m + 3 * 1024, m + 4 * 1024, lane); curmv = mv; } \
          const float rstd = row_rstd(x); adaln_apply(x, rstd, ac); store_row_bf16((u16*)(p.ws + WS_X1) + (size_t)r * D, lane, x); } \
        { const int mv = row_modvec(rb); if (mv != curmv) { const float* m = mod + (size_t)(L * 5 + mv) * 6144; adac_load(ac, p.in[7] + L * 1024, m + 3 * 1024, m + 4 * 1024, lane); curmv = mv; } \
          const float rstd = row_rstd(y); adaln_apply(y, rstd, ac); store_row_bf16((u16*)(p.ws + WS_X1) + (size_t)rb * D, lane, y); } \
        _Pragma("unroll") for (int g = 0; g < 9; ++g) { float a0 = 0.f, a1 = 0.f, a2 = 0.f, a3 = 0.f, b0 = 0.f, b1 = 0.f, b2 = 0.f, b3 = 0.f; \
            { f32x4 w[8];        \
              _Pragma("unroll") for (int t = 0; t < 8; ++t) w[t] = *(const LAS f32x4*)(wt + (4 * g + (t >> 2)) * R_PITCH + (t & 3) * 256 + lane * 4); \
              SBAR(); R_FMA4(a0, x, w, 0); R_FMA4(a1, x, w, 4); R_FMA4(b0, y, w, 0); R_FMA4(b1, y, w, 4); SBAR(); } \
            { f32x4 w[8]; \
              _Pragma("unroll") for (int t = 0; t < 8; ++t) w[t] = *(const LAS f32x4*)(wt + (4 * g + 2 + (t >> 2)) * R_PITCH + (t & 3) * 256 + lane * 4); \
              SBAR(); R_FMA4(a2, x, w, 0); R_FMA4(a3, x, w, 4); R_FMA4(b2, y, w, 0); R_FMA4(b3, y, w, 4); SBAR(); } \
            R_RED4(a0, a1, a2, a3, LG); R_RED4(b0, b1, b2, b3, LG + 40); SBAR(); } \
        { const int n0 = r + 2 < re ? r + 2 : re - 1, n1 = r + 3 < re ? r + 3 : re - 1; load_row(h_row(p, n0), lane, x); load_row(h_row(p, n1), lane, y); }        \
        route_row<L>(p, LG, r, (r - rs) * 8 + wid, LCNT, SLOT, lane); \
        if (hasB) route_row<L>(p, LG + 40, rb, (rb - rs) * 8 + wid, LCNT, SLOT, lane); } while (0)
    for (int r0 = rs; r0 < re; r0 += 2) R_STEP2(r0, xa, xb);
#undef R_STEP2
#undef R_RED4
#undef R_FMA4
    __syncthreads();
    if (tid < 32) { const unsigned n = (unsigned)LCNT[tid]; LBASE[tid] = n ? (int)atomicAdd(&cnt[tid], n) : 0; }
    __syncthreads();
    for (int r = rs; r < re; ++r) if (lane < 2) {
        const LAS int* sl = SLOT + ((r - rs) * 8 + wid) * 4; const int e = sl[lane], rank = LBASE[e] + sl[2 + lane];
        list[(size_t)e * NROW + rank] = r; asgr[2 * r + lane] = rank; }
}
__device__ __forceinline__ void moe_tables(const Params& p, LAS unsigned char* lds, int L) {
    LAS int* CNT = (LAS int*)(lds + MOE_ARR); LAS int* OFF = CNT + 32; LAS int* TIL = CNT + 64;
    if (threadIdx.x < 32) CNT[threadIdx.x] = (int)xb_ld((unsigned*)(p.ws + WS_CTL) + CW_CNT + L * 64 + threadIdx.x);
    __syncthreads();
    if (threadIdx.x == 0) { int o = 0, t = 0; for (int e = 0; e < 32; ++e) { OFF[e] = o; TIL[e] = t; o += CNT[e]; t += (CNT[e] + 255) >> 8; } TIL[32] = t; }
    __syncthreads();
}
__device__ __forceinline__ int find_expert(const LAS int* TIL, int tile) { int e = 0;
#pragma unroll
    for (int j = 1; j < 32; ++j) e += (TIL[j] <= tile) ? 1 : 0;
    return e; }
__device__ __forceinline__ void phase_up(const Params& p, LAS unsigned char* lds, int bid, int nblk, int L) {
    moe_tables(p, lds, L);
    LAS int* CNT = (LAS int*)(lds + MOE_ARR); LAS int* OFF = CNT + 32; LAS int* TIL = CNT + 64;
    pg::MoeSched<true> S; S.A = (const char*)(p.ws + WS_X1); S.Bt = (const char*)(p.ws + WS_W13); S.CNT = CNT; S.OFF = OFF; S.TIL = TIL; S.list = (const int*)(p.ws + WS_LIST);
    S.RIDX = CNT + 128; S.nwg = __builtin_amdgcn_readfirstlane(TIL[32]) * 4; S.G = nblk; S.c = bid; S.K = 1024; S.fallback = (L == 0 ? 0 : NCTX);
    EpiUp E{(u16*)(p.ws + WS_H), OFF};
    pg::gemm_phase<true>(lds, 1024, S, E);
}
__device__ __forceinline__ void phase_down(const Params& p, LAS unsigned char* lds, int bid, int nblk, int L) {
    moe_tables(p, lds, L);
    LAS int* CNT = (LAS int*)(lds + MOE_ARR); LAS int* OFF = CNT + 32; LAS int* TIL = CNT + 64;
    pg::MoeSched<false> S; S.A = (const char*)(p.ws + WS_H); S.Bt = (const char*)(p.ws + WS_W2); S.CNT = CNT; S.OFF = OFF; S.TIL = TIL; S.list = nullptr;
    S.RIDX = CNT + 128; S.nwg = __builtin_amdgcn_readfirstlane(TIL[32]) * 4; S.G = nblk; S.c = bid; S.K = 512; S.fallback = 0;
    EpiDown E{(u16*)(p.ws + WS_YB), OFF};
    pg::gemm_phase<true>(lds, 512, S, E);
}
template <int L>
__device__ __forceinline__ void phase_combine(const Params& p, LAS unsigned char* lds, int bid, int nblk) {
    moe_tables(p, lds, L);
    LAS int* OFF = (LAS int*)(lds + MOE_ARR) + 32;
    const int tid = threadIdx.x, wid = tid >> 6, lane = tid & 63;
    const float* mod = (const float*)(p.ws + WS_MOD);
    const int* asge = (const int*)(p.ws + WS_ASGE); const int* asgr = (const int*)(p.ws + WS_ASGR); const float* asgg = (const float*)(p.ws + WS_ASGG);
    const u16* yb = (const u16*)(p.ws + WS_YB);
    const int r0 = (L == 0 ? 0 : NCTX) + bid * 8 + wid, stride = nblk * 8;
    f32x4 x[4]; u32x2 ya[4], yq[4]; float ga = 0.f, gb = 0.f;
#define C_LOAD(rr, X, YA, YQ, GA, GB) do { load_row(h_row(p, rr), lane, X); const int ea_ = asge[2 * (rr)], eb_ = asge[2 * (rr) + 1]; GA = asgg[2 * (rr)]; GB = asgg[2 * (rr) + 1]; \
        const u16* pa_ = yb + (size_t)(OFF[ea_] + asgr[2 * (rr)]) * 1024 + lane * 4; const u16* pb_ = yb + (size_t)(OFF[eb_] + asgr[2 * (rr) + 1]) * 1024 + lane * 4; \
        _Pragma("unroll") for (int i = 0; i < 4; ++i) { YA[i] = *(const u32x2*)(pa_ + i * 256); YQ[i] = *(const u32x2*)(pb_ + i * 256); } } while (0)
    if (r0 < NROW) C_LOAD(r0, x, ya, yq, ga, gb);
    for (int r = r0; r < NROW; r += stride) {
        float* hp = h_row(p, r);
        const float* m = mod + (size_t)(L * 5 + row_modvec(r)) * 6144;
        f32x4 g2[4]; AdaC ac;
#pragma unroll
        for (int i = 0; i < 4; ++i) g2[i] = *(const f32x4*)(m + 5 * 1024 + i * 256 + lane * 4);
        if (L == 0) { const float* m1 = mod + (size_t)(1 * 5 + row_modvec(r)) * 6144; adac_load(ac, p.in[6] + 1024, m1, m1 + 1024, lane); }
        else {
#pragma unroll
            for (int i = 0; i < 4; ++i) ac.g[i] = *(const f32x4*)(p.in[25] + i * 256 + lane * 4); }
        SBAR();
        const int rn = r + stride; f32x4 nx[4]; u32x2 nya[4], nyq[4]; float nga = 0.f, ngb = 0.f;
        if (rn < NROW) C_LOAD(rn, nx, nya, nyq, nga, ngb);
        SBAR();
#pragma unroll
        for (int i = 0; i < 4; ++i) { const u32x2 a = ya[i], bq = yq[i]; const f32x4 g = g2[i];
            x[i][0] += g[0] * (ga * bflo(a[0]) + gb * bflo(bq[0])); x[i][1] += g[1] * (ga * bfhi(a[0]) + gb * bfhi(bq[0]));
            x[i][2] += g[2] * (ga * bflo(a[1]) + gb * bflo(bq[1])); x[i][3] += g[3] * (ga * bfhi(a[1]) + gb * bfhi(bq[1])); }
        const float rstd = row_rstd(x);
        if (L == 0) {
#pragma unroll
            for (int i = 0; i < 4; ++i) *(f32x4*)(hp + i * 256 + lane * 4) = x[i];
            adaln_apply(x, rstd, ac);
            store_row_bf16((u16*)(p.ws + WS_X1) + (size_t)r * D, lane, x);
        } else {
#pragma unroll
            for (int i = 0; i < 4; ++i) { const f32x4 g = ac.g[i]; f32x4 y = {x[i][0] * rstd * g[0], x[i][1] * rstd * g[1], x[i][2] * rstd * g[2], x[i][3] * rstd * g[3]}; *(f32x4*)(hp + i * 256 + lane * 4) = y; }
        }
        if (rn < NROW) { ga = nga; gb = ngb;
#pragma unroll
            for (int i = 0; i < 4; ++i) { x[i] = nx[i]; ya[i] = nya[i]; yq[i] = nyq[i]; } }
    }
#undef C_LOAD
}

constexpr int A_SHM_V = 16384, A_SHM_K = 16384;
constexpr float A_SCALE = 0.125f, A_THR = 8.f;
__device__ __forceinline__ void smA(f32x16& p0, f32x16& p1, float mC) {
#pragma unroll
    for (int r = 0; r < 16; ++r) p0[r] = __builtin_amdgcn_exp2f(p0[r]);
}
__device__ __forceinline__ void smB(f32x16& p0, f32x16& p1, float& l_reg, bf16x8& pa0, bf16x8& pa1, bf16x8& pa2, bf16x8& pa3) {
#pragma unroll
    for (int r = 0; r < 16; ++r) p1[r] = __builtin_amdgcn_exp2f(p1[r]);
    float ps = 0;
#pragma unroll
    for (int r = 0; r < 16; ++r) ps += p0[r];
#pragma unroll
    for (int r = 0; r < 16; ++r) ps += p1[r];
    l_reg += ps;
    PK4(p0, 0, pa0); PK4(p0, 8, pa1); PK4(p1, 0, pa2); PK4(p1, 8, pa3);
}
__device__ __forceinline__ void attn_unit(const Params& p, LAS unsigned char* lds, int u, float lam) {
    int tz0 = threadIdx.x; asm volatile("" : "+v"(tz0));
    const int tid = tz0, wid = __builtin_amdgcn_readfirstlane(tid >> 6), lane = tid & 63, r32 = lane & 31, hi = lane >> 5;
    const int qt = u & 63, h = (u >> 6) & 7, b = u >> 9, map = wid >> 2, tb = wid & 3;
    unsigned long long wsb = (unsigned long long)(p.ws + WS_PROJ); asm volatile("" : "+s"(wsb));
    const u16* proj = (const u16*)wsb;
    LAS float* li_l = (LAS float*)(lds + 131072) + wid * 64;
    const int qrow0 = NCTX + b * SEQ + qt * 128;
    float l_reg = 0; f32x16 o[4] = {}; bf16x8 qr[4];
    { const u16* qp = proj + (size_t)(qrow0 + tb * 32 + r32) * 3072 + h * 128 + map * 64 + hi * 8;
#pragma unroll
      for (int d0 = 0; d0 < 4; ++d0) qr[d0] = *(const bf16x8*)(qp + d0 * 16); }
    float mC;
    {   float qn2 = 0.f;
#pragma unroll
        for (int d0 = 0; d0 < 4; ++d0)
#pragma unroll
            for (int j = 0; j < 8; ++j) { const float x = bf2f((u16)qr[d0][j]); qn2 += x * x; }
        qn2 = swap32_add(qn2);
        unsigned* km = (unsigned*)(p.ws + WS_CTL) + CW_KMAX + (b * 8 + h) * 4 + map * 2;
        const float kb2 = __uint_as_float(xb_ld(km)) + __uint_as_float(xb_ld(km + 1));
        mC = sqrtf(qn2 * kb2) * (1.02f * A_SCALE * LOG2E);
#pragma unroll
        for (int d0 = 0; d0 < 4; ++d0) { u32x4 w = __builtin_bit_cast(u32x4, qr[d0]);
#pragma unroll
            for (int e = 0; e < 4; ++e) w[e] = cvtpk(bflo(w[e]) * (A_SCALE * LOG2E), bfhi(w[e]) * (A_SCALE * LOG2E));
            qr[d0] = __builtin_bit_cast(bf16x8, w); } }
    f32x16 negm;
#pragma unroll
    for (int r = 0; r < 16; ++r) negm[r] = -mC;
    constexpr int A_SLOT = 32768, NT = 132;
    const unsigned vrd = (unsigned)(unsigned long long)(lds + v_rd_base(lane));
    const int kcb = map * 128;
    unsigned koff0, voff0;
    {   const int P0 = tid;
        { const int row = P0 >> 4, c = ((P0 & 15) ^ (row & 15)) * 8; koff0 = (unsigned)(row * 3072 + 1024 + h * 128 + c); }
        { const int sub = P0 >> 5, kk = (sub >> 2) * 8 + ((P0 >> 2) & 7), c = (sub & 3) * 32 + (P0 & 3) * 8, k = (kk & ~0xC) | ((kk & 4) << 1) | ((kk & 8) >> 1); voff0 = (unsigned)(k * 3072 + 2048 + h * 128 + c); } }
#define KROW(j) ((j) < 4 ? b * 256 + (j) * 64 : NCTX + b * SEQ + ((j) - 4) * 64)
#define ADMA(j) do { const u16* g_ = proj + (size_t)KROW(j) * 3072; LAS unsigned char* s_ = lds + ((j) & 3) * A_SLOT + wid * 1024; \
        glds16(g_ + voff0, s_); glds16(g_ + voff0 + 32 * 3072, s_ + 8192); glds16(g_ + koff0, s_ + 16384); glds16(g_ + koff0 + 32 * 3072, s_ + 16384 + 8192); } while (0)
#define A_WAITBAR(N) do { asm volatile("s_waitcnt vmcnt(" #N ") lgkmcnt(0)" ::: "memory"); BAR(); } while (0)
#define A_KPRE(j) do { const LAS unsigned char* kn_ = lds + ((j) & 3) * A_SLOT + 16384; const int cb_ = kcb + hi * 16; kp0 = *(const LAS bf16x8*)(kn_ + KSWZ(r32, cb_)); kp1 = *(const LAS bf16x8*)(kn_ + KSWZ(32 + r32, cb_)); } while (0)
#define A_ITER(j, PC0, PC1, PP0, PP1, DMA) do { A_WAITBAR(0); if (DMA) ADMA((j) + 2); SBAR(); \
        qkt_pre<4>(PC0, PC1, lds + ((j) & 3) * A_SLOT + 16384, qr, r32, hi, kcb, negm, kp0, kp1); \
        smB(PP0, PP1, l_reg, pa0, pa1, pa2, pa3); SBAR(); \
        pv_tile_asm(o, vrd + (((j) - 1) & 3) * A_SLOT, pa0, pa1, pa2, pa3); \
        smA(PC0, PC1, mC); A_KPRE((j) + 1); SBAR(); } while (0)
    f32x16 pA0, pA1, pB0, pB1; bf16x8 pa0, pa1, pa2, pa3, kp0, kp1;
    ADMA(0); ADMA(1);
    A_WAITBAR(0); ADMA(2);
    qkt_init<4>(pA0, pA1, lds + 16384, qr, r32, hi, kcb, negm); smA(pA0, pA1, mC); A_KPRE(1); SBAR();
    for (int j0 = 1; j0 < NT - 1; j0 += 2) {
        A_ITER(j0, pB0, pB1, pA0, pA1, (j0 + 2 < NT)); A_ITER(j0 + 1, pA0, pA1, pB0, pB1, (j0 + 3 < NT));
    }
    A_ITER(NT - 1, pB0, pB1, pA0, pA1, false);
    smB(pB0, pB1, l_reg, pa0, pa1, pa2, pa3);
    pv_tile_asm(o, vrd + ((NT - 1) & 3) * A_SLOT, pa0, pa1, pa2, pa3);
    l_reg = swap32_add(l_reg);
    asm volatile("" : "+v"(tz0));
    const int lane_e = tz0 & 63, r32e = lane_e & 31, hie = lane_e >> 5;
    if (hie == 0) li_l[r32e] = l_reg; WAIT_L(0);
#pragma unroll
    for (int r = 0; r < 16; ++r) { const float rl = __builtin_amdgcn_rcpf(li_l[crow(r, hie)]);
#pragma unroll
        for (int d = 0; d < 4; ++d) o[d][r] *= rl; }
    __syncthreads();
    LAS float* EX = (LAS float*)lds;
    if (map == 1) {
#pragma unroll
        for (int d = 0; d < 4; ++d)
#pragma unroll
            for (int r = 0; r < 16; ++r) EX[((tb * 4 + d) * 16 + r) * 64 + lane_e] = o[d][r]; }
    __syncthreads();
    if (map == 0) {
        const float* G = p.in[16] + h * 128; float gv[4];
#pragma unroll
        for (int d = 0; d < 4; ++d) gv[d] = G[d * 32 + r32e] * (1.f - LAM_INIT);
#pragma unroll
        for (int r = 0; r < 16; ++r) { float x[4], s2 = 0.f;
#pragma unroll
            for (int d = 0; d < 4; ++d) { x[d] = o[d][r] - lam * EX[((tb * 4 + d) * 16 + r) * 64 + lane_e]; s2 += x[d] * x[d]; }
            s2 = half_sum(s2); const float rstd = rsqrtf(s2 * (1.f / 128.f) + EPS);
            u16* op = (u16*)(p.ws + WS_X1) + (size_t)(qrow0 + tb * 32 + crow(r, hie)) * 1024 + h * 128 + r32e;
#pragma unroll
            for (int d = 0; d < 4; ++d) op[d * 32] = f2bf(x[d] * rstd * gv[d]); }
    }
    __syncthreads();
#undef KROW
#undef ADMA
#undef A_WAITBAR
#undef A_ITER
#undef A_KPRE
}

constexpr int NPH = 18;
__global__ void __launch_bounds__(NTHR, 2) mega(Params p, int ph_lo, int ph_hi) {
    extern __shared__ __attribute__((aligned(16))) unsigned char smem_[];
    LAS unsigned char* lds = (LAS unsigned char*)smem_;
    const int bid = blockIdx.x, nblk = gridDim.x, tid = threadIdx.x;
    volatile LAS unsigned* xbw = (volatile LAS unsigned*)(lds + LDS_MISC);
    if (tid < 4) xbw[tid] = 0u;
    __syncthreads();
    XcdBarrier bar; bar.bar = (unsigned*)(p.ws + WS_CTL) + CW_BAR; bar.x = 0; bar.st = xbw;
    if (ph_hi - ph_lo > 1) bar = xcd_barrier_post((unsigned*)(p.ws + WS_CTL) + CW_BAR, xbw);
#ifndef PHMASK
#define PHMASK 0x3ffff
#endif
#define IN(k) (((PHMASK >> (k)) & 1) && ph_lo <= (k) && (k) < ph_hi)
#define SEAM(k) do { if (IN(k) && IN((k) + 1)) xcd_barrier(bar); } while (0)
#ifndef REPMASK
#define REPMASK 0
#endif
#define NREP(k) (1 + ((REPMASK >> (k)) & 1))
    if (IN(0)) for (int rep_ = 0; rep_ < NREP(0); ++rep_) { if (rep_) xcd_barrier(bar); phase0(p, lds, bid, nblk); } SEAM(0);
    if (IN(1)) for (int rep_ = 0; rep_ < NREP(1); ++rep_) { if (rep_) xcd_barrier(bar); phase1(p, lds, bid, nblk); } SEAM(1);
    if (IN(2)) for (int rep_ = 0; rep_ < NREP(2); ++rep_) { if (rep_) xcd_barrier(bar); phase2(p, lds, bid, nblk); } SEAM(2);
    if (IN(3)) for (int rep_ = 0; rep_ < NREP(3); ++rep_) { if (rep_) xcd_barrier(bar); for (int u = bid; u < 2 * 16 * NCH; u += nblk) s1_unit(p, lds, u); } SEAM(3);
    if (IN(4)) for (int rep_ = 0; rep_ < NREP(4); ++rep_) { if (rep_) xcd_barrier(bar); phase_s2(p, bid, nblk); } SEAM(4);
    if (IN(5)) for (int rep_ = 0; rep_ < NREP(5); ++rep_) { if (rep_) xcd_barrier(bar); for (int u = bid; u < 2 * 16 * NCH; u += nblk) s3_unit(p, lds, u); } SEAM(5);
    if (IN(6)) for (int rep_ = 0; rep_ < NREP(6); ++rep_) { if (rep_) xcd_barrier(bar); phase_outproj<0>(p, lds, bid, nblk); } SEAM(6);
    if (IN(7)) for (int rep_ = 0; rep_ < NREP(7); ++rep_) { if (rep_) xcd_barrier(bar); phase_router<0>(p, lds, bid, nblk); } SEAM(7);
    if (IN(8)) for (int rep_ = 0; rep_ < NREP(8); ++rep_) { if (rep_) xcd_barrier(bar); phase_up(p, lds, bid, nblk, 0); } SEAM(8);
    if (IN(9)) for (int rep_ = 0; rep_ < NREP(9); ++rep_) { if (rep_) xcd_barrier(bar); phase_down(p, lds, bid, nblk, 0); } SEAM(9);
    if (IN(10)) for (int rep_ = 0; rep_ < NREP(10); ++rep_) { if (rep_) xcd_barrier(bar); phase_combine<0>(p, lds, bid, nblk); } SEAM(10);
    if (IN(11)) for (int rep_ = 0; rep_ < NREP(11); ++rep_) { if (rep_) xcd_barrier(bar); phase_inproj1(p, lds, bid, nblk); } SEAM(11);
    if (IN(12)) for (int rep_ = 0; rep_ < NREP(12); ++rep_) { if (rep_) xcd_barrier(bar);
        float lam;
        { const float* lp = p.in[15]; float a = 0, c = 0; for (int i = 0; i < 64; ++i) { a += lp[i] * lp[64 + i]; c += lp[128 + i] * lp[192 + i]; } lam = __builtin_bit_cast(float, __builtin_amdgcn_readfirstlane(__builtin_bit_cast(int, __expf(a) - __expf(c) + LAM_INIT))); }
        if (nblk == 256) { const int xg = bid & 7, sl = bid >> 3;
            for (int k = 0; k < 8; ++k) attn_unit(p, lds, ((xg + 8 * (k >> 1)) << 6) | (sl + 32 * (k & 1)), lam); }
        else for (int u = bid; u < NB * 8 * 64; u += nblk) attn_unit(p, lds, u, lam);
    } SEAM(12);
    if (IN(13)) for (int rep_ = 0; rep_ < NREP(13); ++rep_) { if (rep_) xcd_barrier(bar); phase_outproj<1>(p, lds, bid, nblk); } SEAM(13);
    if (IN(14)) for (int rep_ = 0; rep_ < NREP(14); ++rep_) { if (rep_) xcd_barrier(bar); phase_router<1>(p, lds, bid, nblk); } SEAM(14);
    if (IN(15)) for (int rep_ = 0; rep_ < NREP(15); ++rep_) { if (rep_) xcd_barrier(bar); phase_up(p, lds, bid, nblk, 1); } SEAM(15);
    if (IN(16)) for (int rep_ = 0; rep_ < NREP(16); ++rep_) { if (rep_) xcd_barrier(bar); phase_down(p, lds, bid, nblk, 1); } SEAM(16);
    if (IN(17)) { phase_combine<1>(p, lds, bid, nblk); }
}

extern "C" void kernel_launch(void* const* d_in, const int* in_sizes, int n_in, void* d_out, int out_size, void* d_ws, size_t ws_size, hipStream_t stream) {
    static int grid = 0;
    if (!grid) {
        if (n_in != 26 || out_size != NLAT * D || ws_size < WS_END) { fprintf(stderr, "kernel_launch: shape/ws mismatch n_in %d out %d ws %zu need %zu\n", n_in, out_size, ws_size, (size_t)WS_END); return; }
        if (hipFuncSetAttribute((const void*)mega, hipFuncAttributeMaxDynamicSharedMemorySize, LDS_TOTAL) != hipSuccess) { fprintf(stderr, "kernel_launch: LDS attribute failed\n"); return; }
        int dev = 0, cus = 0, per_cu = 0; hipGetDevice(&dev); hipDeviceGetAttribute(&cus, hipDeviceAttributeMultiprocessorCount, dev);
        hipOccupancyMaxActiveBlocksPerMultiprocessor(&per_cu, mega, NTHR, LDS_TOTAL);
        if (per_cu < 1) { fprintf(stderr, "kernel_launch: occupancy 0\n"); return; }
        grid = cus;
    }
    Params p{};
    for (int i = 0; i < 26; ++i) p.in[i] = (const float*)d_in[i];
    p.out = (float*)d_out; p.ws = (unsigned char*)d_ws;
    hipMemsetAsync((unsigned char*)d_ws + WS_CTL, 0, CTL_BYTES, stream);
#if SPLIT_LAUNCH
    for (int k = 0; k < NPH; ++k) hipLaunchKernelGGL(mega, dim3(grid), dim3(NTHR), LDS_TOTAL, stream, p, k, k + 1);
#else
    hipLaunchKernelGGL(mega, dim3(grid), dim3(NTHR), LDS_TOTAL, stream, p, 0, NPH);
#endif
}
```
